# Optimizing an MI355X kernel written in HIP

```python
import math
import jax, jax.numpy as jnp
from jax import lax
import numpy as np

D_MODEL = 2048
BATCH = 2
SEQ = 8192
DEPTH = 1

CHUNK = 64
EPS = 1e-6
DA_HEADS = 8
DA_QK_DIM = 64
DA_V_DIM = 2 * DA_QK_DIM
DA_WIDTH = DA_HEADS * DA_V_DIM
Q_BLOCK = 128
ML_HEADS = 8
ML_HEAD_DIM = 128
ML_WIDTH = ML_HEADS * ML_HEAD_DIM
CONV_WIDTH = 4
PEER_HEADS = 8
N_KEYS = 128
N_EXPERTS = N_KEYS * N_KEYS
PEER_TOPK = 16
PEER_QDIM = 256
PEER_HALF = PEER_QDIM // 2
PEER_BLOCK = 128
IN_SIZES = (DA_WIDTH, DA_WIDTH, DA_WIDTH,
            ML_WIDTH, ML_WIDTH, ML_WIDTH, ML_WIDTH,
            2 * ML_HEADS,
            2 * D_MODEL)
IN_WIDTH = sum(IN_SIZES)
IN_SPLITS = tuple(int(s) for s in np.cumsum(IN_SIZES)[:-1])

kernel_name = "hybrid_diffattn_mlstm_peer_block"


def rmsnorm(x, g):
    xf = x.astype(jnp.float32)
    y = xf * lax.rsqrt(jnp.mean(xf * xf, axis=-1, keepdims=True) + EPS)
    return (y * g.astype(jnp.float32)).astype(x.dtype)


def diff_attention(q, k, v, lam, sub_g, lambda_init):
    B, S = q.shape[0], q.shape[1]
    q = jnp.transpose(q, (0, 2, 3, 1, 4)) * (DA_QK_DIM ** -0.5)
    k = jnp.transpose(k, (0, 2, 3, 1, 4))
    v = jnp.transpose(v, (0, 2, 1, 3))
    slopes = 2.0 ** (-8.0 * jnp.arange(1, DA_HEADS + 1, dtype=jnp.float32) / DA_HEADS)
    kpos = jnp.arange(S)
    n_blk = S // Q_BLOCK

    def block(i):
        start = i * Q_BLOCK
        qb = lax.dynamic_slice_in_dim(q, start, Q_BLOCK, axis=3)
        qpos = start + jnp.arange(Q_BLOCK)
        s = jnp.einsum('bhmqd,bhmkd->bhmqk', qb, k).astype(jnp.float32)
        dist = jnp.abs(qpos[:, None] - kpos[None, :]).astype(jnp.float32)
        allowed = (kpos[None, :] // CHUNK) <= (qpos[:, None] // CHUNK)
        bias = jnp.where(allowed[None], -slopes[:, None, None] * dist[None], -jnp.inf)
        p = jax.nn.softmax(s + bias[None, :, None], axis=-1)
        a = p[:, :, 0] - lam * p[:, :, 1]
        return jnp.einsum('bhqk,bhkd->bhqd', a.astype(v.dtype), v)

    o = lax.map(block, jnp.arange(n_blk))
    o = jnp.transpose(o, (1, 0, 3, 2, 4)).reshape(B, S, DA_HEADS, DA_V_DIM)
    o = rmsnorm(o, sub_g) * (1.0 - lambda_init)
    return o.reshape(B, S, DA_WIDTH)


def causal_conv(x, w, b):
    S = x.shape[1]
    xp = jnp.pad(x, ((0, 0), (CONV_WIDTH - 1, 0), (0, 0)))
    return sum(w[j] * xp[:, j:j + S] for j in range(CONV_WIDTH)) + b


def mlstm(q, k, v, i_raw, f_raw):
    B, S, H, d = q.shape
    nc = S // CHUNK
    f32 = jnp.float32

    def to_chunks(t):
        t = t.reshape((B, nc, CHUNK, H) + t.shape[3:])
        return jnp.moveaxis(jnp.moveaxis(t, 1, 0), 3, 2)

    qc = to_chunks(q.astype(f32))
    kc = to_chunks(k.astype(f32) * (d ** -0.5))
    vc = to_chunks(v.astype(f32))
    lic = to_chunks(i_raw.astype(f32))
    lfc = to_chunks(jax.nn.log_sigmoid(f_raw.astype(f32)))
    causal = jnp.tril(jnp.ones((CHUNK, CHUNK), dtype=bool))

    def step(carry, inp):
        C, n, m = carry
        qb, kb, vb, lib, lfb = inp
        b = jnp.cumsum(lfb, axis=-1)
        D = jnp.where(causal, b[..., :, None] - b[..., None, :] + lib[..., None, :], -jnp.inf)
        inter = b + m[..., None]
        m_t = jnp.maximum(jnp.max(D, axis=-1), inter)
        W = jnp.exp(D - m_t[..., None])
        sc = jnp.exp(inter - m_t)
        Wqk = W * jnp.einsum('bhtd,bhsd->bhts', qb, kb)
        num = sc[..., None] * jnp.einsum('bhtd,bhde->bhte', qb, C) + jnp.einsum('bhts,bhse->bhte', Wqk, vb)
        den = sc * jnp.einsum('bhtd,bhd->bht', qb, n) + jnp.sum(Wqk, axis=-1)
        den = jnp.maximum(jnp.abs(den), jnp.exp(-m_t))
        h = num / den[..., None]
        bL = b[..., -1]
        g = bL[..., None] - b + lib
        m_new = jnp.maximum(bL + m, jnp.max(g, axis=-1))
        decay = jnp.exp(bL + m - m_new)
        w = jnp.exp(g - m_new[..., None])
        C_new = decay[..., None, None] * C + jnp.einsum('bhs,bhsd,bhse->bhde', w, kb, vb)
        n_new = decay[..., None] * n + jnp.einsum('bhs,bhsd->bhd', w, kb)
        return (C_new, n_new, m_new), h

    init = (jnp.zeros((B, H, d, d), f32), jnp.zeros((B, H, d), f32), jnp.zeros((B, H), f32))
    _, hs = lax.scan(step, init, (qc, kc, vc, lic, lfc))
    return jnp.transpose(hs, (1, 0, 3, 2, 4)).reshape(B, S, H, d).astype(v.dtype)


def peer(x, w_query, sub_keys, expert_u, expert_v):
    B, S, D = x.shape
    T = B * S
    nb = T // PEER_BLOCK
    xb = x.reshape(nb, PEER_BLOCK, D)

    def block(xi):
        q = (xi @ w_query).reshape(PEER_BLOCK, PEER_HEADS, 2, PEER_HALF)
        s = jnp.einsum('thcd,hcnd->thcn', q, sub_keys).astype(jnp.float32)
        top_s, top_i = lax.top_k(s, PEER_TOPK)
        cand_s = (top_s[:, :, 0, :, None] + top_s[:, :, 1, None, :]).reshape(PEER_BLOCK, PEER_HEADS, PEER_TOPK * PEER_TOPK)
        cand_i = (top_i[:, :, 0, :, None] * N_KEYS + top_i[:, :, 1, None, :]).reshape(PEER_BLOCK, PEER_HEADS, PEER_TOPK * PEER_TOPK)
        best_s, pos = lax.top_k(cand_s, PEER_TOPK)
        idx = jnp.take_along_axis(cand_i, pos, axis=-1).reshape(PEER_BLOCK, PEER_HEADS * PEER_TOPK)
        g = jax.nn.softmax(best_s, axis=-1).reshape(PEER_BLOCK, PEER_HEADS * PEER_TOPK)
        u = expert_u[idx]
        a = jnp.einsum('pd,pkd->pk', xi, u).astype(jnp.float32)
        act = (jax.nn.gelu(a) * g).astype(xi.dtype)
        return jnp.einsum('pk,pkd->pd', act, expert_v[idx])

    return lax.map(block, xb).reshape(B, S, D)


def setup_inputs(seed: int = 0) -> dict:
    key = jax.random.key(seed)
    ks = jax.random.split(key, 20)
    f32 = jnp.float32
    nrm = lambda k, shape, s: jax.random.normal(k, shape, f32) * s
    x = jax.random.normal(ks[0], (BATCH, SEQ, D_MODEL), f32)
    norm_mix = 1.0 + nrm(ks[1], (DEPTH, D_MODEL), 0.02)
    w_in = nrm(ks[2], (DEPTH, D_MODEL, IN_WIDTH), D_MODEL ** -0.5)
    conv_w = nrm(ks[3], (DEPTH, CONV_WIDTH, 2 * ML_WIDTH), CONV_WIDTH ** -0.5)
    conv_b = nrm(ks[4], (DEPTH, 2 * ML_WIDTH), 0.02)
    gate_i_bias = nrm(ks[5], (DEPTH, ML_HEADS), 0.1)
    gate_f_bias = jnp.linspace(3.0, 6.0, ML_HEADS, dtype=f32)[None] + nrm(ks[6], (DEPTH, ML_HEADS), 0.1)
    ml_gate_bias = jnp.concatenate([gate_i_bias, gate_f_bias], axis=-1)
    da_lambda = nrm(ks[7], (DEPTH, 4, DA_QK_DIM), 0.1)
    da_subln = 1.0 + nrm(ks[8], (DEPTH, DA_V_DIM), 0.02)
    ml_headnorm = 1.0 + nrm(ks[9], (DEPTH, ML_WIDTH), 0.02)
    w_branch_a = nrm(ks[10], (DEPTH, DA_WIDTH, D_MODEL), DA_WIDTH ** -0.5)
    w_branch_b = nrm(ks[11], (DEPTH, ML_WIDTH, D_MODEL), ML_WIDTH ** -0.5)
    w_out = nrm(ks[12], (DEPTH, D_MODEL, D_MODEL), D_MODEL ** -0.5)
    norm_ffn = 1.0 + nrm(ks[13], (DEPTH, D_MODEL), 0.02)
    peer_query = nrm(ks[14], (DEPTH, D_MODEL, PEER_HEADS * PEER_QDIM), D_MODEL ** -0.5)
    peer_subkeys = nrm(ks[15], (DEPTH, PEER_HEADS, 2, N_KEYS, PEER_HALF), PEER_HALF ** -0.5)
    expert_u = nrm(ks[16], (DEPTH, N_EXPERTS, D_MODEL), D_MODEL ** -0.5)
    expert_v = nrm(ks[17], (DEPTH, N_EXPERTS, D_MODEL), 0.5)
    norm_final = 1.0 + nrm(ks[18], (D_MODEL,), 0.02)
    return {"x": x, "norm_mix": norm_mix, "w_in": w_in, "conv_w": conv_w, "conv_b": conv_b,
            "ml_gate_bias": ml_gate_bias, "da_lambda": da_lambda, "da_subln": da_subln,
            "ml_headnorm": ml_headnorm, "w_branch_a": w_branch_a, "w_branch_b": w_branch_b,
            "w_out": w_out, "norm_ffn": norm_ffn, "peer_query": peer_query,
            "peer_subkeys": peer_subkeys, "expert_u": expert_u, "expert_v": expert_v,
            "norm_final": norm_final}


def reference(x, norm_mix, w_in, conv_w, conv_b, ml_gate_bias, da_lambda, da_subln,
              ml_headnorm, w_branch_a, w_branch_b, w_out, norm_ffn, peer_query,
              peer_subkeys, expert_u, expert_v, norm_final):
    B, S, D = x.shape
    for l in range(DEPTH):
        lambda_init = 0.8 - 0.6 * math.exp(-0.3 * l)
        h = rmsnorm(x, norm_mix[l])
        proj = h @ w_in[l]
        da_q, da_k, da_v, ml_q, ml_k, ml_v, ml_o, ml_if, gates = jnp.split(proj, IN_SPLITS, axis=-1)
        lq = da_lambda[l].astype(jnp.float32)
        lam = jnp.exp(jnp.sum(lq[0] * lq[1])) - jnp.exp(jnp.sum(lq[2] * lq[3])) + lambda_init
        branch_a = diff_attention(da_q.reshape(B, S, DA_HEADS, 2, DA_QK_DIM),
                                  da_k.reshape(B, S, DA_HEADS, 2, DA_QK_DIM),
                                  da_v.reshape(B, S, DA_HEADS, DA_V_DIM),
                                  lam, da_subln[l], lambda_init)
        qk = jax.nn.silu(causal_conv(jnp.concatenate([ml_q, ml_k], axis=-1), conv_w[l], conv_b[l]))
        mq, mk = jnp.split(qk, 2, axis=-1)
        if_raw = ml_if + ml_gate_bias[l]
        hm = mlstm(mq.reshape(B, S, ML_HEADS, ML_HEAD_DIM), mk.reshape(B, S, ML_HEADS, ML_HEAD_DIM),
                   ml_v.reshape(B, S, ML_HEADS, ML_HEAD_DIM), if_raw[..., :ML_HEADS], if_raw[..., ML_HEADS:])
        hm = rmsnorm(hm, ml_headnorm[l].reshape(ML_HEADS, ML_HEAD_DIM)).reshape(B, S, ML_WIDTH)
        branch_b = jax.nn.sigmoid(ml_o) * hm
        gate_a, gate_b = jnp.split(gates, 2, axis=-1)
        merged = jax.nn.sigmoid(gate_a) * (branch_a @ w_branch_a[l]) + jax.nn.sigmoid(gate_b) * (branch_b @ w_branch_b[l])
        x = x + merged @ w_out[l]
        x = x + peer(rmsnorm(x, norm_ffn[l]), peer_query[l], peer_subkeys[l], expert_u[l], expert_v[l])
    return rmsnorm(x, norm_final)
```

```cpp
#include <hip/hip_runtime.h>
#include <cstdio>
#include <cstdint>
namespace pg8 {
#define PG8_LAS __attribute__((address_space(3)))
typedef unsigned short bf16_t;
typedef short bf16x8 __attribute__((ext_vector_type(8)));
typedef float f32x4 __attribute__((ext_vector_type(4)));
typedef unsigned u32x4 __attribute__((ext_vector_type(4)));
constexpr int BM = 256, BK = 64, HALF = 128, HTB = HALF * BK * 2  , STAGE_BYTES = 8 * HTB, NXCD = 8, WGM = 8;

__host__ __device__ __forceinline__ int lds_byte(int r, int c) { const int st = (r >> 4) * 2 + (c >> 5), rr = r & 15, cc = c & 31, ob = rr * 64 + cc * 2; return st * 1024 + (ob ^ (((ob >> 9) & 1) << 5)); }
__host__ __device__ __forceinline__ void stage_rc(int b, int& R, int& C) { const int st = b / 1024, sb = b % 1024, swz = sb ^ (((sb >> 9) & 1) << 5); R = (st >> 1) * 16 + swz / 64; C = (st & 1) * 32 + (swz % 64) / 2; }
__host__ __device__ __forceinline__ int perm32(int rho) { const int n = rho >> 4, i = rho & 15; return 8 * (i >> 2) + 4 * n + (i & 3); }

struct Unit { int pm, pn; };
struct Gemm { const bf16_t* A; const bf16_t* Bt; int M, N, K; };

struct StaticOrder {
    int nM, nN, nwg, G, c;
    __host__ __device__ void init(int M, int N, int G_, int c_) { nM = M / BM; nN = N / BM; nwg = nM * nN; G = G_; c = c_; }
    __host__ __device__ bool next(int i, Unit& u) const {
        const long L = (long)i * G + c; if (L >= nwg) return false;
        int wgid = (int)L; { const int q = nwg / NXCD, r = nwg % NXCD, xcd = wgid % NXCD, off = wgid / NXCD; wgid = (xcd < r ? xcd * (q + 1) : r * (q + 1) + (xcd - r) * q) + off; }
        const int nig = WGM * nN, gid = wgid / nig, fm = gid * WGM, gsz = (nM - fm) < WGM ? (nM - fm) : WGM;
        u.pm = fm + ((wgid % nig) % gsz); u.pn = (wgid % nig) / gsz; return true;
    }
    __device__ __forceinline__ void a_ready(const Unit&) const {}
    __device__ __forceinline__ void done(const Unit&) const {}
};

__device__ __forceinline__ unsigned cvt_pk_bf16(float lo, float hi) { unsigned r; asm volatile("v_cvt_pk_bf16_f32 %0, %1, %2" : "=v"(r) : "v"(lo), "v"(hi)); return r; }
typedef float f32x2 __attribute__((ext_vector_type(2)));
__device__ __forceinline__ float sigmoidf_fast(float x) { return __builtin_amdgcn_rcpf(1.0f + __builtin_amdgcn_exp2f(-1.4426950408889634f * x)); }
__device__ __forceinline__ float bf_lo(unsigned w) { return __uint_as_float(w << 16); }
__device__ __forceinline__ float bf_hi(unsigned w) { return __uint_as_float(w & 0xffff0000u); }

struct EpiProj {
    static constexpr bool PERM = true, AFTER_DRAIN = false;
    bf16_t* segbase;
    size_t segstride;
    bf16_t* gates;
    const float* rstd;
    float qscale;
    __device__ __forceinline__ void operator()(const f32x4 (&acc)[2][2][4][2], const Unit& u, int wr, int wc, int fr, int fq) const {
        const int pn = u.pn; bf16_t* base; int ldc, colt, mode;
        if (pn < 28) { const int seg = pn >> 2; base = segbase + (size_t)seg * segstride; ldc = 1024; colt = (pn & 3) * 256; mode = seg == 0 ? 1 : (seg == 6 ? 2 : 0); }
        else { base = gates; ldc = 4096; colt = (pn - 28) * 256; mode = 2; }
        const int row0 = u.pm * BM + wr * 64 + fr, col0 = colt + wc * 32 + 8 * fq;
#pragma unroll
        for (int ai = 0; ai < 2; ++ai)
#pragma unroll
            for (int m = 0; m < 4; ++m) { const int row = row0 + ai * HALF + m * 16; float r = rstd[row]; if (mode == 1) r *= qscale;
                bf16_t* rowp = base + (size_t)row * ldc + col0;
#pragma unroll
                for (int bj = 0; bj < 2; ++bj) { f32x4 v0 = acc[ai][bj][m][0] * r, v1 = acc[ai][bj][m][1] * r;
                    if (mode == 2) {
#pragma unroll
                        for (int e = 0; e < 4; ++e) { v0[e] = sigmoidf_fast(v0[e]); v1[e] = sigmoidf_fast(v1[e]); } }
                    u32x4 w; w.x = cvt_pk_bf16(v0[0], v0[1]); w.y = cvt_pk_bf16(v0[2], v0[3]); w.z = cvt_pk_bf16(v1[0], v1[1]); w.w = cvt_pk_bf16(v1[2], v1[3]);
                    *(u32x4*)(rowp + bj * HALF) = w; } }
    }
};
template <int PASS> struct EpiGate {
    static constexpr bool PERM = true, AFTER_DRAIN = false;
    bf16_t* merged; const bf16_t* gates;
    __device__ __forceinline__ void operator()(const f32x4 (&acc)[2][2][4][2], const Unit& u, int wr, int wc, int fr, int fq) const {
        const int row0 = u.pm * BM + wr * 64 + fr, col0 = u.pn * BM + wc * 32 + 8 * fq;
#pragma unroll
        for (int ai = 0; ai < 2; ++ai)
#pragma unroll
            for (int m = 0; m < 4; ++m) { const int row = row0 + ai * HALF + m * 16;
#pragma unroll
                for (int bj = 0; bj < 2; ++bj) { const int col = col0 + bj * HALF;
                    const u32x4 g = *(const u32x4*)(gates + (size_t)row * 4096 + PASS * 2048 + col);
                    f32x4 v0 = acc[ai][bj][m][0], v1 = acc[ai][bj][m][1];
                    v0[0] *= bf_lo(g.x); v0[1] *= bf_hi(g.x); v0[2] *= bf_lo(g.y); v0[3] *= bf_hi(g.y); v1[0] *= bf_lo(g.z); v1[1] *= bf_hi(g.z); v1[2] *= bf_lo(g.w); v1[3] *= bf_hi(g.w);
                    bf16_t* dst = merged + (size_t)row * 2048 + col;
                    if (PASS == 1) { const u32x4 p = *(const u32x4*)dst;
                        v0[0] += bf_lo(p.x); v0[1] += bf_hi(p.x); v0[2] += bf_lo(p.y); v0[3] += bf_hi(p.y); v1[0] += bf_lo(p.z); v1[1] += bf_hi(p.z); v1[2] += bf_lo(p.w); v1[3] += bf_hi(p.w); }
                    u32x4 w; w.x = cvt_pk_bf16(v0[0], v0[1]); w.y = cvt_pk_bf16(v0[2], v0[3]); w.z = cvt_pk_bf16(v1[0], v1[1]); w.w = cvt_pk_bf16(v1[2], v1[3]);
                    *(u32x4*)dst = w; } }
    }
};
struct EpiRes {
    static constexpr bool PERM = false, AFTER_DRAIN = false;
    const float* x; float* x1; bf16_t* x1b; float* ssq;
    __device__ __forceinline__ void operator()(const f32x4 (&acc)[2][2][4][2], const Unit& u, int wr, int wc, int fr, int fq) const {
        const int row0 = u.pm * BM + wr * 64 + fr, col0 = u.pn * BM + wc * 32 + 4 * fq;
#pragma unroll
        for (int ai = 0; ai < 2; ++ai)
#pragma unroll
            for (int m = 0; m < 4; ++m) { const int row = row0 + ai * HALF + m * 16; const size_t off = (size_t)row * 2048 + col0; float s = 0.f;
#pragma unroll
                for (int bj = 0; bj < 2; ++bj)
#pragma unroll
                    for (int n = 0; n < 2; ++n) { const size_t o = off + bj * HALF + n * 16; const f32x4 v = *(const f32x4*)(x + o) + acc[ai][bj][m][n];
                        *(f32x4*)(x1 + o) = v; typedef unsigned u32x2v __attribute__((ext_vector_type(2))); u32x2v w; w.x = cvt_pk_bf16(v[0], v[1]); w.y = cvt_pk_bf16(v[2], v[3]);
                        *(u32x2v*)(x1b + o) = w; s += (v[0] * v[0] + v[1] * v[1]) + (v[2] * v[2] + v[3] * v[3]); }
                s += __shfl_xor(s, 16); s += __shfl_xor(s, 32);
                if (fq == 0) ssq[(size_t)row * 32 + u.pn * 4 + wc] = s; }
    }
};
struct EpiQ {
    static constexpr bool PERM = true, AFTER_DRAIN = false;
    bf16_t* out; const float* ssq; float eps;
    __device__ __forceinline__ void operator()(const f32x4 (&acc)[2][2][4][2], const Unit& u, int wr, int wc, int fr, int fq) const {
        const int row0 = u.pm * BM + wr * 64 + fr, col0 = u.pn * BM + wc * 32 + 8 * fq;
#pragma unroll
        for (int ai = 0; ai < 2; ++ai)
#pragma unroll
            for (int m = 0; m < 4; ++m) { const int row = row0 + ai * HALF + m * 16; const f32x4* sp = (const f32x4*)(ssq + (size_t)row * 32); float s = 0.f;
#pragma unroll
                for (int i = 0; i < 8; ++i) { const f32x4 t = sp[i]; s += (t[0] + t[1]) + (t[2] + t[3]); }
                const float r = 1.0f / sqrtf(s * (1.0f / 2048.0f) + eps);
#pragma unroll
                for (int bj = 0; bj < 2; ++bj) { const f32x4 v0 = acc[ai][bj][m][0] * r, v1 = acc[ai][bj][m][1] * r;
                    u32x4 w; w.x = cvt_pk_bf16(v0[0], v0[1]); w.y = cvt_pk_bf16(v0[2], v0[3]); w.z = cvt_pk_bf16(v1[0], v1[1]); w.w = cvt_pk_bf16(v1[2], v1[3]);
                    *(u32x4*)(out + (size_t)row * 2048 + col0 + bj * HALF) = w; } }
    }
};

template <class Epi, class Sched, bool ALIGN_EPI = false, bool SP2 = false>
__device__ __forceinline__ void gemm_phase(PG8_LAS unsigned char* lds, const Gemm g, const Sched& S, const Epi& E) {
    const int tid = threadIdx.x, wid = __builtin_amdgcn_readfirstlane(tid >> 6), lane = tid & 63, wr = wid >> 2, wc = wid & 3, fr = lane & 15, fq = lane >> 4;
    const int K = g.K, nt = K / BK;
    unsigned voffA[2], voffB[2];
#pragma unroll
    for (int i = 0; i < 2; ++i) { int R, C; stage_rc(tid * 16 + i * 8192, R, C); const int Rb = Epi::PERM ? ((R & ~31) + perm32(R & 31)) : R;
        voffA[i] = (unsigned)(R * K + C) * 2u; voffB[i] = (unsigned)(Rb * K + C) * 2u; }
    const size_t kstep = (size_t)(BK * 2);
    const size_t hstep = (size_t)HALF * K * 2;
    const size_t tstep = 2 * hstep;
    const unsigned ldsw = (unsigned)wid * 1024u;
    const int aoff = lds_byte(wr * 64 + fr, fq * 8), boff = lds_byte(wc * 32 + fr, fq * 8);
#define PG8_SA(b, h) (((b) * 2 + (h)) * HTB)
#define PG8_SB(b, h) ((4 + (b) * 2 + (h)) * HTB)
#define PG8_STAGE(bufoff, gbase, voff) do { _Pragma("unroll") for (int _i = 0; _i < 2; ++_i) \
        __builtin_amdgcn_global_load_lds((const unsigned*)((const char*)(gbase) + (voff)[_i]), (PG8_LAS unsigned*)(lds + (bufoff) + ldsw + _i * 8192), 16, 0, 0); } while (0)
#define PG8_LDA(dst, b, h) do { _Pragma("unroll") for (int m = 0; m < 4; ++m) _Pragma("unroll") for (int k = 0; k < 2; ++k) dst[m][k] = *(const PG8_LAS bf16x8*)(lds + PG8_SA(b, h) + aoff + m * 2048 + k * 1024); } while (0)
#define PG8_LDB(dst, b, h) do { _Pragma("unroll") for (int n = 0; n < 2; ++n) _Pragma("unroll") for (int k = 0; k < 2; ++k) dst[n][k] = *(const PG8_LAS bf16x8*)(lds + PG8_SB(b, h) + boff + n * 2048 + k * 1024); } while (0)
#define PG8_MMA(ai, bj, At, Bt) do { __builtin_amdgcn_s_setprio(1); _Pragma("unroll") for (int m = 0; m < 4; ++m) _Pragma("unroll") for (int n = 0; n < 2; ++n) _Pragma("unroll") for (int k = 0; k < 2; ++k) \
        acc[ai][bj][m][n] = __builtin_amdgcn_mfma_f32_16x16x32_bf16(Bt[n][k], At[m][k], acc[ai][bj][m][n], 0, 0, 0); __builtin_amdgcn_s_setprio(0); } while (0)
#define PG8_WAIT_V(n) asm volatile("s_waitcnt vmcnt(" #n ")" ::: "memory")
#define PG8_WAIT_L(n) asm volatile("s_waitcnt lgkmcnt(" #n ")" ::: "memory")
#define PG8_BAR __builtin_amdgcn_s_barrier()
#define PG8_SCHED __builtin_amdgcn_sched_barrier(0)
    Unit cur, nxt; int ui = 0;
    if (!S.next(0, cur)) return;
    f32x4 acc[2][2][4][2];
#pragma unroll
    for (int a = 0; a < 2; ++a)
#pragma unroll
        for (int b = 0; b < 2; ++b)
#pragma unroll
            for (int m = 0; m < 4; ++m)
#pragma unroll
                for (int n = 0; n < 2; ++n) acc[a][b][m][n] = (f32x4){0.f, 0.f, 0.f, 0.f};
    bf16x8 At[4][2], B0[2][2], B1[2][2];
    const char* cA = (const char*)g.A + (size_t)cur.pm * tstep; const char* cB = (const char*)g.Bt + (size_t)cur.pn * tstep;
    S.a_ready(cur);
    if constexpr (SP2) {
        PG8_STAGE(PG8_SB(0, 0), cB, voffB); PG8_STAGE(PG8_SB(0, 1), cB + hstep, voffB); PG8_STAGE(PG8_SA(0, 0), cA, voffA); PG8_STAGE(PG8_SA(0, 1), cA + hstep, voffA);
        if (wr == 1) PG8_BAR;
        PG8_WAIT_V(2); PG8_BAR;
        PG8_STAGE(PG8_SB(1, 0), cB + kstep, voffB); PG8_STAGE(PG8_SA(1, 0), cA + kstep, voffA); PG8_STAGE(PG8_SB(1, 1), cB + hstep + kstep, voffB);
        PG8_WAIT_V(6); PG8_BAR;
    } else {
        PG8_STAGE(PG8_SB(0, 0), cB, voffB); PG8_STAGE(PG8_SA(0, 0), cA, voffA); PG8_STAGE(PG8_SB(0, 1), cB + hstep, voffB); PG8_STAGE(PG8_SA(0, 1), cA + hstep, voffA);
        if (wr == 1) PG8_BAR;
        PG8_WAIT_V(4); PG8_BAR;
        PG8_STAGE(PG8_SB(1, 0), cB + kstep, voffB); PG8_STAGE(PG8_SA(1, 0), cA + kstep, voffA); PG8_STAGE(PG8_SB(1, 1), cB + hstep + kstep, voffB);
        PG8_WAIT_V(6); PG8_BAR;
    }
    for (;;) {
        const bool has_next = S.next(ui + 1, nxt);
        const char* nA = has_next ? (const char*)g.A + (size_t)nxt.pm * tstep : cA; const char* nB = has_next ? (const char*)g.Bt + (size_t)nxt.pn * tstep : cB;
        for (int t = 0; t < nt; t += 2) {
            const bool last = (t == nt - 2);
            const char* a1 = cA + (size_t)(t + 1) * kstep;
            const char* a2 = last ? nA : cA + (size_t)(t + 2) * kstep; const char* b2 = last ? nB : cB + (size_t)(t + 2) * kstep;
            const char* a3 = a2 + kstep; const char* b3 = b2 + kstep;
            if (last && has_next) S.a_ready(nxt);
            if constexpr (SP2) {
            PG8_LDB(B0, 0, 0); PG8_LDB(B1, 0, 1); PG8_SCHED; PG8_LDA(At, 0, 0); PG8_STAGE(PG8_SA(1, 1), a1 + hstep, voffA);
            PG8_WAIT_V(8); PG8_WAIT_L(0); PG8_BAR; PG8_MMA(0, 0, At, B0); PG8_MMA(0, 1, At, B1); PG8_BAR; PG8_SCHED;
            PG8_LDA(At, 0, 1); PG8_STAGE(PG8_SB(0, 0), b2, voffB); PG8_STAGE(PG8_SB(0, 1), b2 + hstep, voffB); PG8_STAGE(PG8_SA(0, 0), a2, voffA);
            PG8_WAIT_V(8); PG8_WAIT_L(0); PG8_BAR; PG8_MMA(1, 0, At, B0); PG8_MMA(1, 1, At, B1); PG8_BAR; PG8_SCHED;
            PG8_LDB(B0, 1, 0); PG8_LDB(B1, 1, 1); PG8_SCHED; PG8_LDA(At, 1, 0); PG8_STAGE(PG8_SA(0, 1), a2 + hstep, voffA);
            PG8_WAIT_V(8); PG8_WAIT_L(0); PG8_BAR; PG8_MMA(0, 0, At, B0); PG8_MMA(0, 1, At, B1); PG8_BAR; PG8_SCHED;
            PG8_LDA(At, 1, 1); PG8_STAGE(PG8_SB(1, 0), b3, voffB); PG8_STAGE(PG8_SB(1, 1), b3 + hstep, voffB); PG8_STAGE(PG8_SA(1, 0), a3, voffA);
            PG8_WAIT_V(8); PG8_WAIT_L(0); PG8_BAR; PG8_MMA(1, 0, At, B0); PG8_MMA(1, 1, At, B1); PG8_BAR; PG8_SCHED;
            } else {
            PG8_LDB(B0, 0, 0); PG8_SCHED; PG8_LDA(At, 0, 0); PG8_STAGE(PG8_SA(1, 1), a1 + hstep, voffA);
            PG8_WAIT_L(8); PG8_BAR; PG8_WAIT_L(0); PG8_MMA(0, 0, At, B0); PG8_BAR; PG8_SCHED;
            PG8_LDB(B1, 0, 1); PG8_STAGE(PG8_SB(0, 0), b2, voffB);
            PG8_BAR; PG8_WAIT_L(0); PG8_MMA(0, 1, At, B1); PG8_BAR;
            PG8_LDA(At, 0, 1); PG8_STAGE(PG8_SA(0, 0), a2, voffA);
            PG8_BAR; PG8_WAIT_L(0); PG8_MMA(1, 0, At, B0); PG8_BAR; PG8_SCHED;
            PG8_STAGE(PG8_SB(0, 1), b2 + hstep, voffB);
            PG8_WAIT_V(6); PG8_BAR; PG8_MMA(1, 1, At, B1); PG8_BAR;
            PG8_LDB(B0, 1, 0); PG8_SCHED; PG8_LDA(At, 1, 0); PG8_STAGE(PG8_SA(0, 1), a2 + hstep, voffA);
            PG8_WAIT_L(8); PG8_BAR; PG8_WAIT_L(0); PG8_MMA(0, 0, At, B0); PG8_BAR; PG8_SCHED;
            PG8_LDB(B1, 1, 1); PG8_STAGE(PG8_SB(1, 0), b3, voffB);
            PG8_BAR; PG8_WAIT_L(0); PG8_MMA(0, 1, At, B1); PG8_BAR;
            PG8_LDA(At, 1, 1); PG8_STAGE(PG8_SA(1, 0), a3, voffA);
            PG8_BAR; PG8_WAIT_L(0); PG8_MMA(1, 0, At, B0); PG8_BAR; PG8_SCHED;
            PG8_STAGE(PG8_SB(1, 1), b3 + hstep, voffB);
            PG8_WAIT_V(6); PG8_BAR; PG8_MMA(1, 1, At, B1); PG8_BAR;
            }
        }
        if constexpr (ALIGN_EPI) { if (wr == 0) PG8_BAR; }
        if constexpr (!Epi::AFTER_DRAIN) { E(acc, cur, wr, wc, fr, fq); S.done(cur); }
        if (!has_next) break;
#pragma unroll
        for (int a = 0; a < 2; ++a)
#pragma unroll
            for (int b = 0; b < 2; ++b)
#pragma unroll
                for (int m = 0; m < 4; ++m)
#pragma unroll
                    for (int n = 0; n < 2; ++n) acc[a][b][m][n] = (f32x4){0.f, 0.f, 0.f, 0.f};
        cur = nxt; cA = nA; cB = nB; ++ui;
        if constexpr (ALIGN_EPI) { if (wr == 1) PG8_BAR; }
    }
    PG8_WAIT_V(0);
    if constexpr (!ALIGN_EPI) { if (wr == 0) PG8_BAR; }
    PG8_BAR;
    if constexpr (Epi::AFTER_DRAIN) { E.fused(acc, cur, wr, wc, fr, fq, lds, wid, lane); S.done(cur); }
#undef PG8_SA
#undef PG8_SB
#undef PG8_STAGE
#undef PG8_LDA
#undef PG8_LDB
#undef PG8_MMA
#undef PG8_WAIT_V
#undef PG8_WAIT_L
#undef PG8_BAR
#undef PG8_SCHED
}
}

constexpr int NWAVES = 8;
constexpr int BATCH = 2, SEQ = 8192, DM = 2048, T = BATCH * SEQ;
constexpr int IN_WIDTH = 11280, NPROJ = 11264;
constexpr int NH = 8, HD = 128;
constexpr int NEXP = 16384, NKEYS = 128, TOPK = 16;
constexpr float EPS = 1e-6f;
constexpr float LOG2E = 1.4426950408889634f;
constexpr int SEGTOK = 1024, NSEG = SEQ / SEGTOK;

constexpr size_t MiB = 1u << 20;
constexpr size_t WS_CTL = 0, CTL_ZERO_BYTES = 1 * MiB;
constexpr size_t WS_IF = 1 * MiB;
constexpr size_t WS_RSTD1 = 2 * MiB;
constexpr size_t WS_LAM = 2 * MiB + 64 * 1024;
constexpr size_t WS_FCUM = 2 * MiB + 128 * 1024;
constexpr size_t WS_LIT = 2 * MiB + 640 * 1024;
constexpr size_t WS_WA = 4 * MiB, WS_WB = 8 * MiB, WS_WOUT = 12 * MiB, WS_WQ = 20 * MiB;
constexpr size_t WS_SK = 28 * MiB;
constexpr size_t WS_WIF = 28 * MiB + 512 * 1024;
constexpr size_t WS_SSQ = 29 * MiB;
constexpr size_t WS_WIN = 32 * MiB;
constexpr size_t WS_CSEG = 32 * MiB;
constexpr size_t WS_XB = 76 * MiB;
constexpr size_t WS_MQC = 76 * MiB, WS_MKC = 108 * MiB;
constexpr size_t WS_QA = 140 * MiB;
constexpr size_t SEG_STRIDE = 32 * MiB;
constexpr size_t WS_KA = WS_QA + SEG_STRIDE, WS_VA = WS_QA + 2 * SEG_STRIDE, WS_MQ = WS_QA + 3 * SEG_STRIDE, WS_MK = WS_QA + 4 * SEG_STRIDE, WS_MV = WS_QA + 5 * SEG_STRIDE, WS_MO = WS_QA + 6 * SEG_STRIDE;
constexpr size_t WS_MERGED = WS_KA;
constexpr size_t WS_X1B = WS_MQ;
constexpr size_t WS_QP = WS_MV;
constexpr size_t WS_GATES = 364 * MiB;
constexpr size_t WS_UB = 364 * MiB, WS_VB = 428 * MiB;
constexpr size_t WS_IDX = 492 * MiB, WS_GATE = 500 * MiB;
constexpr size_t WS_END = 508 * MiB;
constexpr int CSEG_STRIDE = 128 * 128 + 128 + 8;
static_assert((size_t)16 * NSEG * CSEG_STRIDE * 4 <= 44 * MiB, "CSEG fits W_in region");
constexpr int CW_BAR = 4096;
constexpr int CW_SEGCNT = 16384;

constexpr int RING_OFF = 0, RING_BYTES = 131072;
constexpr int LDSCTL_OFF = RING_BYTES, MISC_OFF = LDSCTL_OFF + 320;
constexpr int LDS_BYTES = 147456;

#define GAS __attribute__((address_space(1)))
#define LAS __attribute__((address_space(3)))
typedef unsigned short bf16;
typedef unsigned v4u __attribute__((ext_vector_type(4)));
typedef float f32x4 __attribute__((ext_vector_type(4)));
typedef short bf16x8 __attribute__((ext_vector_type(8)));
typedef GAS unsigned gu32;
typedef GAS unsigned long long gu64;
#define RLX_AGENT __ATOMIC_RELAXED, __HIP_MEMORY_SCOPE_AGENT
#define LDS_WAIT() asm volatile("s_waitcnt lgkmcnt(0)" ::: "memory")
#define VM_WAIT() asm volatile("s_waitcnt vmcnt(0)" ::: "memory")
__device__ __forceinline__ unsigned long long rt() { return __builtin_amdgcn_s_memrealtime(); }
__device__ __forceinline__ unsigned f2bf(float f) { unsigned u = __builtin_bit_cast(unsigned, f); return (u + 0x7fffu + ((u >> 16) & 1u)) >> 16; }
__device__ __forceinline__ unsigned pk2(float lo, float hi) { return f2bf(lo) | (f2bf(hi) << 16); }

#define XB_TMO      128
#define XB_XCNT(j)  (256  + 64 * (j))
#define XB_XSUB(j)  (1280 + 64 * (j))
#define XB_XGEN(j)  (2304 + 64 * (j))
#define XB_TOP      3328
#define XB_TOPGEN   3392
#define XCD_BAR_WORDS 3456
#define XB_SPIN_CAP (1u << 18)

__device__ __forceinline__ unsigned xb_ld(unsigned* p)              { return __hip_atomic_load(p, __ATOMIC_RELAXED, __HIP_MEMORY_SCOPE_AGENT); }
__device__ __forceinline__ unsigned xb_add(unsigned* p, unsigned v) { return __hip_atomic_fetch_add(p, v, __ATOMIC_RELAXED, __HIP_MEMORY_SCOPE_AGENT); }
__device__ __forceinline__ unsigned xb_xcc_id() { return (unsigned)__builtin_amdgcn_s_getreg((3 << 11) | 20) & 0xFu; }
#define XB_SPIN(cond, bar) do { unsigned _sp = 0; while (cond) { __builtin_amdgcn_s_sleep(1); \
    if ((++_sp & 255u) == 0u) { if (xb_ld(&(bar)[XB_TMO])) break; if (_sp > XB_SPIN_CAP) { atomicAdd(&(bar)[XB_TMO], 1u); break; } } } } while (0)

struct XcdBarrier {
    unsigned* bar; unsigned x;
    volatile LAS unsigned* st;
};

__device__ __forceinline__ XcdBarrier xcd_barrier_post(unsigned* bar, volatile LAS unsigned* st) {
    XcdBarrier b; b.bar = bar; b.x = xb_xcc_id(); b.st = st;
    if (threadIdx.x == 0) (void)xb_add(&bar[XB_XCNT(b.x)], 1u);
    return b;
}
__device__ __forceinline__ void xcd_barrier_complete(unsigned* bar, unsigned x, unsigned& nloc, unsigned& nx) {
    const unsigned G = gridDim.x * gridDim.y * gridDim.z;
    unsigned sum, cnt, mine, sp = 0u;
    for (;;) {
        sum = 0u; cnt = 0u; mine = 0u;
#pragma unroll
        for (unsigned j = 0; j < 16; ++j) { const unsigned c = xb_ld(&bar[XB_XCNT(j)]); sum += c; cnt += (c > 0u) ? 1u : 0u; mine = (j == x) ? c : mine; }
        if (sum == G) break;
        __builtin_amdgcn_s_sleep(1);
        if ((++sp & 255u) == 0u) { if (xb_ld(&bar[XB_TMO])) break; if (sp > XB_SPIN_CAP) { atomicAdd(&bar[XB_TMO], 1u); break; } }
    }
    nloc = mine > 0u ? mine : 1u; nx = cnt > 0u ? cnt : 1u;
}

__device__ __forceinline__ void xcd_barrier(const XcdBarrier& b) {
    asm volatile("s_waitcnt vmcnt(0)" ::: "memory");
    __syncthreads();
    if (threadIdx.x == 0) {
        unsigned* bar = b.bar;
        __builtin_amdgcn_s_waitcnt(0);
        unsigned nloc = b.st[0], nx = b.st[1];
        if (nloc == 0u) { xcd_barrier_complete(bar, b.x, nloc, nx); b.st[0] = nloc; b.st[1] = nx; }
        const unsigned old = xb_add(&bar[XB_XSUB(b.x)], 1u);
        const unsigned gen = old / nloc;
        if (old + 1u == (gen + 1u) * nloc) {
            __builtin_amdgcn_fence(__ATOMIC_RELEASE, "agent");
            asm volatile("s_waitcnt vmcnt(0)" ::: "memory");
            const unsigned og = xb_add(&bar[XB_TOP], 1u);
            const unsigned tg = og / nx;
            if (og + 1u == (tg + 1u) * nx) xb_add(&bar[XB_TOPGEN], 1u);
            else XB_SPIN(xb_ld(&bar[XB_TOPGEN]) == tg, bar);
            __builtin_amdgcn_fence(__ATOMIC_ACQUIRE, "agent");
            xb_add(&bar[XB_XGEN(b.x)], 1u);
            asm volatile("s_waitcnt vmcnt(0)" ::: "memory");
        } else {
            XB_SPIN(xb_ld(&bar[XB_XGEN(b.x)]) == gen, bar);
            __builtin_amdgcn_fence(__ATOMIC_ACQUIRE, "agent");
            asm volatile("s_waitcnt vmcnt(0)" ::: "memory");
        }
    }
    __syncthreads();
}

struct Frame {
    LAS unsigned char* lds;
    volatile LAS unsigned* MISC;
    gu32* ctl;
    unsigned char* ws;
    int tid, lane, wave;
    int vcu, G;
    const float* const* in;
    float* out;
};
typedef unsigned u32x2 __attribute__((ext_vector_type(2)));
typedef float f32x16 __attribute__((ext_vector_type(16)));
typedef short s16x4 __attribute__((ext_vector_type(4)));

__device__ __forceinline__ float wave_sum(float v) {
#pragma unroll
    for (int o = 1; o < 64; o <<= 1) v += __shfl_xor(v, o);
    return v;
}
__device__ __forceinline__ float wave_max(float v) {
#pragma unroll
    for (int o = 1; o < 64; o <<= 1) v = fmaxf(v, __shfl_xor(v, o));
    return v;
}
__device__ __forceinline__ float bflo(unsigned w) { return __uint_as_float(w << 16); }
__device__ __forceinline__ float bfhi(unsigned w) { return __uint_as_float(w & 0xffff0000u); }
__device__ __forceinline__ unsigned cvtpk(float lo, float hi) { unsigned r; asm volatile("v_cvt_pk_bf16_f32 %0, %1, %2" : "=v"(r) : "v"(lo), "v"(hi)); return r; }

__device__ __forceinline__ void transpose_item(const float* W, int ldw, int src_col0, int k0, bf16* WT, int ldt, int dst_row0, const float* gk, LAS float* scr, int lane) {
#pragma unroll 8
    for (int i = 0; i < 32; ++i) { const int kk = 2 * i + (lane >> 5); float v = W[(size_t)(k0 + kk) * ldw + src_col0 + (lane & 31)]; if (gk) v *= gk[k0 + kk]; scr[kk * 33 + (lane & 31)] = v; }
    LDS_WAIT(); asm volatile("" ::: "memory");
    const int c = lane & 7;
#pragma unroll
    for (int j = 0; j < 4; ++j) { const int n = (lane >> 3) + 8 * j; const LAS float* s = scr + (8 * c) * 33 + n;
        v4u o; o.x = pk2(s[0 * 33], s[1 * 33]); o.y = pk2(s[2 * 33], s[3 * 33]); o.z = pk2(s[4 * 33], s[5 * 33]); o.w = pk2(s[6 * 33], s[7 * 33]);
        *(GAS v4u*)(WT + (size_t)(dst_row0 + n) * ldt + k0 + 8 * c) = o; }
    LDS_WAIT(); asm volatile("" ::: "memory");
}
__device__ __forceinline__ void p0_prep(Frame& F) {
    LAS float* scr = (LAS float*)(F.lds + RING_OFF + F.wave * 16384);
    const int gw = F.vcu * NWAVES + F.wave, NGW = F.G * NWAVES, lane = F.lane;
    const float* x = F.in[0]; const float* norm_mix = F.in[1]; const float* w_in = F.in[2];
    const float* da_lambda = F.in[6];
    const float* w_a = F.in[9]; const float* w_b = F.in[10]; const float* w_out = F.in[11]; const float* norm_ffn = F.in[12]; const float* peer_query = F.in[13]; const float* subkeys = F.in[14];
    bf16* WIN = (bf16*)(F.ws + WS_WIN); bf16* WA = (bf16*)(F.ws + WS_WA); bf16* WB = (bf16*)(F.ws + WS_WB); bf16* WOUT = (bf16*)(F.ws + WS_WOUT); bf16* WQ = (bf16*)(F.ws + WS_WQ);
    bf16* SK = (bf16*)(F.ws + WS_SK); bf16* WIF = (bf16*)(F.ws + WS_WIF); bf16* XB = (bf16*)(F.ws + WS_XB); float* RSTD1 = (float*)(F.ws + WS_RSTD1);
    constexpr int I_IN = 32 * 352, I_A = 16 * 64, I_B = 16 * 64, I_OUT = 32 * 64, I_Q = 32 * 64, I_IF = 512, I_SK = 512, I_LAM = 1;
    constexpr int NITEMS = I_IN + I_A + I_B + I_OUT + I_Q + I_IF + I_SK + I_LAM;
    for (int it = gw; it < NITEMS; it += NGW) {
        int r = it;
        if (r < I_IN) { const int kb = r / 352, nb = r % 352, n0 = nb * 32; transpose_item(w_in, IN_WIDTH, n0 + (n0 >= 7168 ? 16 : 0), kb * 64, WIN, DM, n0, norm_mix, scr, lane); continue; } r -= I_IN;
        if (r < I_A) { const int kb = r / 64, nb = r % 64; transpose_item(w_a, 2048, nb * 32, kb * 64, WA, 1024, nb * 32, nullptr, scr, lane); continue; } r -= I_A;
        if (r < I_B) { const int kb = r / 64, nb = r % 64; transpose_item(w_b, 2048, nb * 32, kb * 64, WB, 1024, nb * 32, nullptr, scr, lane); continue; } r -= I_B;
        if (r < I_OUT) { const int kb = r / 64, nb = r % 64; transpose_item(w_out, 2048, nb * 32, kb * 64, WOUT, 2048, nb * 32, nullptr, scr, lane); continue; } r -= I_OUT;
        if (r < I_Q) { const int kb = r / 64, nb = r % 64; transpose_item(peer_query, 2048, nb * 32, kb * 64, WQ, 2048, nb * 32, norm_ffn, scr, lane); continue; } r -= I_Q;
        if (r < I_IF) { const int e = r * 64 + lane, j = e >> 11, k = e & 2047; WIF[e] = (bf16)f2bf(w_in[(size_t)k * IN_WIDTH + 7168 + j] * norm_mix[k]); continue; } r -= I_IF;
        if (r < I_SK) {
#pragma unroll
            for (int q = 0; q < 2; ++q) { const int e = r * 512 + q * 256 + lane * 4; const f32x4 v = *(const f32x4*)(subkeys + e); u32x2 w; w.x = pk2(v[0], v[1]); w.y = pk2(v[2], v[3]); *(u32x2*)(SK + e) = w; }
            continue; } r -= I_SK;
        { float a = da_lambda[lane] * da_lambda[64 + lane], b = da_lambda[128 + lane] * da_lambda[192 + lane]; a = wave_sum(a); b = wave_sum(b);
          if (lane == 0) ((float*)(F.ws + WS_LAM))[0] = __expf(a) - __expf(b) + 0.2f; }
    }
    for (int m = gw; m < T; m += NGW) {
        const GAS f32x4* xr = (const GAS f32x4*)(x + (size_t)m * DM) + lane; f32x4 v[8]; float s = 0.f;
#pragma unroll
        for (int j = 0; j < 8; ++j) { v[j] = xr[64 * j]; s += (v[j][0] * v[j][0] + v[j][1] * v[j][1]) + (v[j][2] * v[j][2] + v[j][3] * v[j][3]); }
        s = wave_sum(s);
        GAS u32x2* o = (GAS u32x2*)(XB + (size_t)m * DM) + lane;
#pragma unroll
        for (int j = 0; j < 8; ++j) { u32x2 w; w.x = pk2(v[j][0], v[j][1]); w.y = pk2(v[j][2], v[j][3]); o[64 * j] = w; }
        if (lane == 0) RSTD1[m] = 1.0f / sqrtf(s * (1.0f / DM) + EPS);
    }
}

__device__ __forceinline__ void p1_ifgates(Frame& F) {
    const int gw = F.vcu * NWAVES + F.wave, NGW = F.G * NWAVES, lane = F.lane;
    const bf16* XB = (const bf16*)(F.ws + WS_XB); const bf16* WIF = (const bf16*)(F.ws + WS_WIF); const float* RSTD1 = (const float*)(F.ws + WS_RSTD1);
    const float* gbias = F.in[5]; float* IFO = (float*)(F.ws + WS_IF);
    for (int it = gw; it < T / 16; it += NGW) {
        const int t0 = it * 16; f32x4 acc = {0.f, 0.f, 0.f, 0.f};
        const bf16* ap = XB + (size_t)(t0 + (lane & 15)) * DM + 8 * (lane >> 4); const bf16* bp = WIF + (size_t)(lane & 15) * DM + 8 * (lane >> 4);
#pragma unroll 8
        for (int ks = 0; ks < 64; ++ks) { const bf16x8 a = *(const bf16x8*)(ap + ks * 32), b = *(const bf16x8*)(bp + ks * 32); acc = __builtin_amdgcn_mfma_f32_16x16x32_bf16(a, b, acc, 0, 0, 0); }
        const int col = lane & 15; const float bs = gbias[col];
#pragma unroll
        for (int j = 0; j < 4; ++j) { const int row = t0 + (lane >> 4) * 4 + j; IFO[(size_t)row * 16 + col] = acc[j] * RSTD1[row] + bs; }
    }
}

__device__ __forceinline__ void p2_conv_scan(Frame& F) {
    const float* conv_w = F.in[3]; const float* conv_b = F.in[4];
    const bf16* MQ = (const bf16*)(F.ws + WS_MQ); const bf16* MK = (const bf16*)(F.ws + WS_MK);
    bf16* MQC = (bf16*)(F.ws + WS_MQC); bf16* MKC = (bf16*)(F.ws + WS_MKC);
    const int nthr = F.G * 512, gt = F.vcu * 512 + F.tid;
    for (int item = gt; item < 256 * 1024; item += nthr) {
        const int cg = item & 255, run = item >> 8; const int c0 = (cg & 127) * 8; const bool isk = cg >= 128;
        const bf16* src = (isk ? MK : MQ) + c0; bf16* dst = (isk ? MKC : MQC) + c0; const int wc0 = (isk ? 1024 : 0) + c0;
        float w[4][8], bb[8];
#pragma unroll
        for (int j = 0; j < 4; ++j) { const f32x4 a = *(const f32x4*)(conv_w + j * 2048 + wc0), b = *(const f32x4*)(conv_w + j * 2048 + wc0 + 4);
            w[j][0] = a[0]; w[j][1] = a[1]; w[j][2] = a[2]; w[j][3] = a[3]; w[j][4] = b[0]; w[j][5] = b[1]; w[j][6] = b[2]; w[j][7] = b[3]; }
        { const f32x4 a = *(const f32x4*)(conv_b + wc0), b = *(const f32x4*)(conv_b + wc0 + 4); bb[0] = a[0]; bb[1] = a[1]; bb[2] = a[2]; bb[3] = a[3]; bb[4] = b[0]; bb[5] = b[1]; bb[6] = b[2]; bb[7] = b[3]; }
        const int t0 = run * 16; const bool first = (t0 & (SEQ - 1)) == 0;
        float h0[8], h1[8], h2[8];
#pragma unroll
        for (int e = 0; e < 8; ++e) { h0[e] = 0.f; h1[e] = 0.f; h2[e] = 0.f; }
        if (!first) {
            const v4u a = *(const v4u*)(src + (size_t)(t0 - 3) * 1024), b = *(const v4u*)(src + (size_t)(t0 - 2) * 1024), c = *(const v4u*)(src + (size_t)(t0 - 1) * 1024);
            h0[0] = bflo(a.x); h0[1] = bfhi(a.x); h0[2] = bflo(a.y); h0[3] = bfhi(a.y); h0[4] = bflo(a.z); h0[5] = bfhi(a.z); h0[6] = bflo(a.w); h0[7] = bfhi(a.w);
            h1[0] = bflo(b.x); h1[1] = bfhi(b.x); h1[2] = bflo(b.y); h1[3] = bfhi(b.y); h1[4] = bflo(b.z); h1[5] = bfhi(b.z); h1[6] = bflo(b.w); h1[7] = bfhi(b.w);
            h2[0] = bflo(c.x); h2[1] = bfhi(c.x); h2[2] = bflo(c.y); h2[3] = bfhi(c.y); h2[4] = bflo(c.z); h2[5] = bfhi(c.z); h2[6] = bflo(c.w); h2[7] = bfhi(c.w);
        }
        const float osc = isk ? 0.08838834764831845f : 1.0f;
#pragma unroll 4
        for (int i = 0; i < 16; ++i) {
            const v4u d = *(const v4u*)(src + (size_t)(t0 + i) * 1024); float cur[8];
            cur[0] = bflo(d.x); cur[1] = bfhi(d.x); cur[2] = bflo(d.y); cur[3] = bfhi(d.y); cur[4] = bflo(d.z); cur[5] = bfhi(d.z); cur[6] = bflo(d.w); cur[7] = bfhi(d.w);
            float y[8];
#pragma unroll
            for (int e = 0; e < 8; ++e) { float v = bb[e] + w[0][e] * h0[e] + w[1][e] * h1[e] + w[2][e] * h2[e] + w[3][e] * cur[e]; v = v * pg8::sigmoidf_fast(v) * osc; y[e] = v; h0[e] = h1[e]; h1[e] = h2[e]; h2[e] = cur[e]; }
            v4u o; o.x = cvtpk(y[0], y[1]); o.y = cvtpk(y[2], y[3]); o.z = cvtpk(y[4], y[5]); o.w = cvtpk(y[6], y[7]);
            *(v4u*)(dst + (size_t)(t0 + i) * 1024) = o;
        }
    }
    if (F.vcu < 16) {
        const int bh = F.vcu, b = bh >> 3, h = bh & 7, tid = F.tid;
        const float* IFI = (const float*)(F.ws + WS_IF) + (size_t)b * SEQ * 16;
        float* FC = (float*)(F.ws + WS_FCUM) + (size_t)bh * SEQ; float* LI = (float*)(F.ws + WS_LIT) + (size_t)bh * SEQ;
        LAS float* sh = (LAS float*)(F.lds + RING_OFF);
        float lf[16]; float run = 0.f, lmax = -3.0e38f;
#pragma unroll
        for (int i = 0; i < 16; ++i) { const int t = tid * 16 + i; const float li = IFI[(size_t)t * 16 + h], fr = IFI[(size_t)t * 16 + 8 + h];
            const float ls = fminf(fr, 0.f) - log1pf(expf(-fabsf(fr))); run += ls; lf[i] = run; LI[t] = li; lmax = fmaxf(lmax, li); }
        float incl = run;
#pragma unroll
        for (int o = 1; o < 64; o <<= 1) { const float n = __shfl_up(incl, o); if (F.lane >= o) incl += n; }
        lmax = wave_max(lmax);
        if (F.lane == 63) sh[F.wave] = incl; if (F.lane == 0) sh[8 + F.wave] = lmax; __syncthreads();
        float base = incl - run, mx = sh[8];
#pragma unroll
        for (int w = 0; w < 8; ++w) { if (w < F.wave) base += sh[w]; mx = fmaxf(mx, sh[8 + w]); }
        if (tid == 0) ((float*)(F.ws + WS_LAM))[16 + bh] = mx;
#pragma unroll
        for (int i = 0; i < 16; ++i) FC[tid * 16 + i] = base + lf[i];
        __syncthreads();
    }
}

constexpr int SHM_V = 64 * 128 * 2, SHM_K = 64 * 128 * 2;
constexpr int FL_WS = 65536;
constexpr int FL_BTAB = 65536 + 2048;
constexpr int FL_NTAB = 65536 + 2048 + 512;
constexpr int FL_RED = 65536 + 4096;
constexpr int FL_OT = 73728;
#define KSWZ(row, colB) ((row) * 256 + ((colB) ^ (((row) & 7) << 4)))
#define SBAR() __builtin_amdgcn_sched_barrier(0)
__device__ __forceinline__ int crow(int r, int hi) { return (r & 3) + 8 * (r >> 2) + 4 * hi; }
__device__ __forceinline__ int v_st(int k, int c) { const int kk = (k & ~0xC) | ((k & 4) << 1) | ((k & 8) >> 1); return ((kk >> 3) * 4 + (c >> 5)) * 512 + ((kk & 7) * 32 + (c & 31)) * 2; }
__device__ __forceinline__ int v_rd_base(int lane) { return ((lane & 3) << 3) | (((lane >> 2) & 3) << 6) | (((lane >> 4) & 1) << 5) | (((lane >> 5) & 1) << 8); }
constexpr int v_rd_off(int d0, int ks, int half) { return d0 * 512 + ks * 4096 + half * 2048; }
template <int OFF> __device__ __forceinline__ s16x4 tr_read(int vb) { s16x4 r; asm volatile("ds_read_b64_tr_b16 %0, %1 offset:%2" : "=&v"(r) : "v"(vb), "i"(OFF) : "memory"); return r; }
#define PKF(L, H) (bf16x8){L[0], L[1], L[2], L[3], H[0], H[1], H[2], H[3]}
template <int D0> __device__ __forceinline__ void pv_one(f32x16& od, int vb, bf16x8 pa0, bf16x8 pa1, bf16x8 pa2, bf16x8 pa3) {
    const s16x4 l0 = tr_read<v_rd_off(D0, 0, 0)>(vb), h0 = tr_read<v_rd_off(D0, 0, 1)>(vb), l1 = tr_read<v_rd_off(D0, 1, 0)>(vb), h1 = tr_read<v_rd_off(D0, 1, 1)>(vb);
    const s16x4 l2 = tr_read<v_rd_off(D0, 2, 0)>(vb), h2 = tr_read<v_rd_off(D0, 2, 1)>(vb), l3 = tr_read<v_rd_off(D0, 3, 0)>(vb), h3 = tr_read<v_rd_off(D0, 3, 1)>(vb);
    asm volatile("s_waitcnt lgkmcnt(0)" ::: "memory"); SBAR();
    od = __builtin_amdgcn_mfma_f32_32x32x16_bf16(pa0, PKF(l0, h0), od, 0, 0, 0);
    od = __builtin_amdgcn_mfma_f32_32x32x16_bf16(pa1, PKF(l1, h1), od, 0, 0, 0);
    od = __builtin_amdgcn_mfma_f32_32x32x16_bf16(pa2, PKF(l2, h2), od, 0, 0, 0);
    od = __builtin_amdgcn_mfma_f32_32x32x16_bf16(pa3, PKF(l3, h3), od, 0, 0, 0);
}
__device__ __forceinline__ void pv_d0(f32x16* o, int vb, bf16x8 pa0, bf16x8 pa1, bf16x8 pa2, bf16x8 pa3) {
    pv_one<0>(o[0], vb, pa0, pa1, pa2, pa3); pv_one<1>(o[1], vb, pa0, pa1, pa2, pa3); pv_one<2>(o[2], vb, pa0, pa1, pa2, pa3); pv_one<3>(o[3], vb, pa0, pa1, pa2, pa3);
}
__device__ __forceinline__ void pack_p(const f32x16& p0, const f32x16& p1, bf16x8& pa0, bf16x8& pa1, bf16x8& pa2, bf16x8& pa3) {
#define PK4(P, BASE, OUT) do { unsigned a0 = cvtpk(P[BASE + 0], P[BASE + 1]), a1 = cvtpk(P[BASE + 2], P[BASE + 3]);   \
    unsigned b0 = cvtpk(P[BASE + 4], P[BASE + 5]), b1 = cvtpk(P[BASE + 6], P[BASE + 7]);                              \
    auto r0 = __builtin_amdgcn_permlane32_swap(a0, b0, false, false); auto r1 = __builtin_amdgcn_permlane32_swap(a1, b1, false, false); \
    v4u w = {r0[0], r1[0], r0[1], r1[1]}; OUT = *reinterpret_cast<bf16x8*>(&w); } while (0)
    PK4(p0, 0, pa0); PK4(p0, 8, pa1); PK4(p1, 0, pa2); PK4(p1, 8, pa3);
#undef PK4
}
__device__ __forceinline__ float half_swap_sum(float v) { auto rr = __builtin_amdgcn_permlane32_swap(__float_as_uint(v), __float_as_uint(v), false, false); return __uint_as_float(rr[0]) + __uint_as_float(rr[1]); }
__device__ __forceinline__ float half_swap_max(float v) { auto rr = __builtin_amdgcn_permlane32_swap(__float_as_uint(v), __float_as_uint(v), false, false); return fmaxf(__uint_as_float(rr[0]), __uint_as_float(rr[1])); }
__device__ __forceinline__ float half_sum32(float v) { v += __shfl_xor(v, 1); v += __shfl_xor(v, 2); v += __shfl_xor(v, 4); v += __shfl_xor(v, 8); v += __shfl_xor(v, 16); return v; }

__device__ __forceinline__ void attn_unit(Frame& F, char* lds, int b, int h, int u) {
    const int tid = F.tid, wid = F.wave, lane = F.lane, r32 = lane & 31, hi = lane >> 5, map = wid >> 2, wq = wid & 3;
    char* V_lds = lds; char* K_lds = lds + 2 * SHM_V;
    float* wsf = (float*)(lds + FL_WS) + wid * 64; float* li_l = wsf; float* al_l = wsf + 32;
    const size_t rowbase = (size_t)b * SEQ;
    const bf16* QA = (const bf16*)(F.ws + WS_QA); const bf16* KA = (const bf16*)(F.ws + WS_KA); const bf16* VA = (const bf16*)(F.ws + WS_VA); bf16* BA = (bf16*)(F.ws + WS_QA);
    const bf16* Qw = QA + (rowbase + 128 * u + wq * 32 + r32) * 1024 + h * 128 + map * 64 + hi * 8;
    bf16x8 qr[4];
#pragma unroll
    for (int d0 = 0; d0 < 4; ++d0) qr[d0] = *reinterpret_cast<const bf16x8*>(Qw + d0 * 16);
    const bf16* Kh = KA + rowbase * 1024 + h * 128; const bf16* Vh = VA + rowbase * 1024 + h * 128;
    const int sr = tid >> 4, sc = (tid & 15) * 8, vst0 = v_st(sr, sc), vst1 = v_st(32 + sr, sc);
    const int vb0 = (int)(uintptr_t)V_lds + v_rd_base(lane);
    bf16x8 vs0, vs1, ks0, ks1;
#define SLOAD(k0) do { vs0 = *(const bf16x8*)(&Vh[(size_t)((k0) + sr) * 1024 + sc]); vs1 = *(const bf16x8*)(&Vh[(size_t)((k0) + 32 + sr) * 1024 + sc]); \
    ks0 = *(const bf16x8*)(&Kh[(size_t)((k0) + sr) * 1024 + sc]); ks1 = *(const bf16x8*)(&Kh[(size_t)((k0) + 32 + sr) * 1024 + sc]); } while (0)
#define SWRITE(bb) do { *(bf16x8*)(V_lds + (bb) * SHM_V + vst0) = vs0; *(bf16x8*)(V_lds + (bb) * SHM_V + vst1) = vs1; const int kc = sc * 2; \
    *(bf16x8*)(K_lds + (bb) * SHM_K + KSWZ(sr, kc)) = ks0; *(bf16x8*)(K_lds + (bb) * SHM_K + KSWZ(32 + sr, kc)) = ks1; } while (0)
    const int NT = 2 * u + 2, qchunk = 2 * u + (wq >> 1), qrel = wq * 32 + r32;
    const float slope2 = __builtin_amdgcn_exp2f(-(float)(h + 1)) * LOG2E;
    float m_reg = -1e30f, l_reg = 0.f; f32x16 o[4] = {};
    SLOAD(64 * (NT - 1)); asm volatile("s_waitcnt vmcnt(0)" ::: "memory"); SWRITE(0); SLOAD(64 * (NT - 2)); __syncthreads();
    for (int j = 0; j < NT; ++j) {
        const int buf = j & 1, jt = NT - 1 - j;
        if (jt <= qchunk) {
            f32x16 p0, p1;
            const int kb = 64 * jt - 128 * u + 4 * hi;
            if (jt == qchunk) {
#pragma unroll
                for (int r = 0; r < 16; ++r) { const int k0_ = kb + (r & 3) + 8 * (r >> 2), k1_ = k0_ + 32; const int a0 = min(k0_, 2 * qrel - k0_), a1 = min(k1_, 2 * qrel - k1_); p0[r] = slope2 * (float)a0; p1[r] = slope2 * (float)a1; }
            } else {
                const float bb0 = slope2 * (float)kb;
#pragma unroll
                for (int r = 0; r < 16; ++r) { p0[r] = fmaf(slope2, (float)((r & 3) + 8 * (r >> 2)), bb0); p1[r] = p0[r] + 32.f * slope2; }
            }
            const char* Ks = K_lds + buf * SHM_K;
#pragma unroll
            for (int d0 = 0; d0 < 4; ++d0) { const int cb = (map * 64 + d0 * 16 + hi * 8) * 2;
                const bf16x8 b0 = *reinterpret_cast<const bf16x8*>(Ks + KSWZ(r32, cb)), b1 = *reinterpret_cast<const bf16x8*>(Ks + KSWZ(32 + r32, cb));
                p0 = __builtin_amdgcn_mfma_f32_32x32x16_bf16(b0, qr[d0], p0, 0, 0, 0); p1 = __builtin_amdgcn_mfma_f32_32x32x16_bf16(b1, qr[d0], p1, 0, 0, 0); }
            float pmax = p0[0];
#pragma unroll
            for (int r = 1; r < 16; ++r) pmax = fmaxf(pmax, p0[r]);
#pragma unroll
            for (int r = 0; r < 16; ++r) pmax = fmaxf(pmax, p1[r]);
            pmax = half_swap_max(pmax);
            float alpha = 1.f;
            if (!__all(pmax - m_reg <= 8.0f)) { const float mn = fmaxf(m_reg, pmax); alpha = __builtin_amdgcn_exp2f(m_reg - mn); m_reg = mn; }
            float ps = 0.f;
#pragma unroll
            for (int r = 0; r < 16; ++r) { p0[r] = __builtin_amdgcn_exp2f(p0[r] - m_reg); p1[r] = __builtin_amdgcn_exp2f(p1[r] - m_reg); ps += p0[r] + p1[r]; }
            ps = half_swap_sum(ps);
            l_reg = l_reg * alpha + ps;
            bf16x8 pa0, pa1, pa2, pa3; pack_p(p0, p1, pa0, pa1, pa2, pa3);
            if (__any(alpha < 1.f)) { if (hi == 0) al_l[r32] = alpha; asm volatile("s_waitcnt lgkmcnt(0)" ::: "memory");
#pragma unroll
                for (int d = 0; d < 4; ++d)
#pragma unroll
                    for (int r = 0; r < 16; ++r) o[d][r] *= al_l[crow(r, hi)]; }
            SBAR();
            pv_d0(o, vb0 + buf * SHM_V, pa0, pa1, pa2, pa3);
        }
        if (j + 1 < NT) { asm volatile("s_waitcnt vmcnt(0)" ::: "memory"); SWRITE(buf ^ 1); if (j + 2 < NT) SLOAD(64 * (NT - 3 - j)); }
        __syncthreads();
    }
#undef SLOAD
#undef SWRITE
    if (hi == 0) li_l[r32] = l_reg; asm volatile("s_waitcnt lgkmcnt(0)" ::: "memory");
    float rli[16];
#pragma unroll
    for (int r = 0; r < 16; ++r) rli[r] = __builtin_amdgcn_rcpf(li_l[crow(r, hi)]);
    float* X = (float*)lds + wq * 4096;
    if (map == 1) {
#pragma unroll
        for (int r = 0; r < 16; ++r)
#pragma unroll
            for (int d0 = 0; d0 < 4; ++d0) X[crow(r, hi) * 128 + d0 * 32 + r32] = o[d0][r] * rli[r];
    }
    __syncthreads();
    if (map == 0) {
        const float lam = ((const float*)(F.ws + WS_LAM))[0]; const float* subln = F.in[7];
        float g[4];
#pragma unroll
        for (int d0 = 0; d0 < 4; ++d0) g[d0] = subln[d0 * 32 + r32] * 0.8f;
        bf16* OT = (bf16*)(lds + FL_OT);
#pragma unroll
        for (int r = 0; r < 16; ++r) { float dv[4]; float s = 0.f;
#pragma unroll
            for (int d0 = 0; d0 < 4; ++d0) { dv[d0] = o[d0][r] * rli[r] - lam * X[crow(r, hi) * 128 + d0 * 32 + r32]; s += dv[d0] * dv[d0]; }
            s = half_sum32(s); const float rs = 1.0f / sqrtf(s * (1.0f / 128.0f) + EPS);
#pragma unroll
            for (int d0 = 0; d0 < 4; ++d0) OT[(wq * 32 + crow(r, hi)) * 128 + d0 * 32 + r32] = (bf16)f2bf(dv[d0] * rs * g[d0]); }
    }
    __syncthreads();
#pragma unroll
    for (int i = 0; i < 4; ++i) { const int p = tid + 512 * i, row = p >> 4, ch = p & 15;
        *(v4u*)(BA + (rowbase + 128 * u + row) * 1024 + h * 128 + ch * 8) = *(const v4u*)(lds + FL_OT + row * 256 + ch * 16); }
}

__device__ __forceinline__ void mlstm_seg_task(Frame& F, char* lds, int bh, int seg) {
    const int tid = F.tid, wid = F.wave, lane = F.lane, b = bh >> 3, h = bh & 7;
    char* V_lds = lds; char* K_lds = lds + 2 * SHM_V;
    float* wtab = (float*)(lds + FL_RED);
    float* red = (float*)(lds + FL_WS);
    const size_t rowbase = (size_t)b * SEQ + (size_t)seg * SEGTOK;
    const float* FC = (const float*)(F.ws + WS_FCUM) + (size_t)bh * SEQ + seg * SEGTOK; const float* LI = (const float*)(F.ws + WS_LIT) + (size_t)bh * SEQ + seg * SEGTOK;
    const bf16* Kh = (const bf16*)(F.ws + WS_MKC) + rowbase * 1024 + h * 128; const bf16* Vh = (const bf16*)(F.ws + WS_MV) + rowbase * 1024 + h * 128;
    const float li0 = LI[tid], li1 = LI[512 + tid];
    float mx = wave_max(fmaxf(li0, li1)); if (lane == 0) red[wid] = mx; __syncthreads();
    float Lseg = red[0];
#pragma unroll
    for (int i = 1; i < 8; ++i) Lseg = fmaxf(Lseg, red[i]);
    const float FE = FC[SEGTOK - 1];
    wtab[tid] = __expf(FE - FC[tid] + li0 - Lseg); wtab[512 + tid] = __expf(FE - FC[512 + tid] + li1 - Lseg);
    __syncthreads();
    const int sr = tid >> 4, sc = (tid & 15) * 8, vst0 = v_st(sr, sc), vst1 = v_st(32 + sr, sc);
    const int vbV = (int)(uintptr_t)V_lds + v_rd_base(lane), vbK = (int)(uintptr_t)K_lds + v_rd_base(lane);
    v4u vs0, vs1, ks0, ks1; float npart[8];
#pragma unroll
    for (int e = 0; e < 8; ++e) npart[e] = 0.f;
#define SLOAD(k0) do { vs0 = *(const v4u*)(&Vh[(size_t)((k0) + sr) * 1024 + sc]); vs1 = *(const v4u*)(&Vh[(size_t)((k0) + 32 + sr) * 1024 + sc]); \
    ks0 = *(const v4u*)(&Kh[(size_t)((k0) + sr) * 1024 + sc]); ks1 = *(const v4u*)(&Kh[(size_t)((k0) + 32 + sr) * 1024 + sc]); } while (0)
#define KW(kv, wv, outv) do { float f0 = bflo(kv.x) * wv, f1 = bfhi(kv.x) * wv, f2 = bflo(kv.y) * wv, f3 = bfhi(kv.y) * wv, f4 = bflo(kv.z) * wv, f5 = bfhi(kv.z) * wv, f6 = bflo(kv.w) * wv, f7 = bfhi(kv.w) * wv; \
    npart[0] += f0; npart[1] += f1; npart[2] += f2; npart[3] += f3; npart[4] += f4; npart[5] += f5; npart[6] += f6; npart[7] += f7; \
    outv.x = cvtpk(f0, f1); outv.y = cvtpk(f2, f3); outv.z = cvtpk(f4, f5); outv.w = cvtpk(f6, f7); } while (0)
#define SWRITE(bb, k0) do { *(v4u*)(V_lds + (bb) * SHM_V + vst0) = vs0; *(v4u*)(V_lds + (bb) * SHM_V + vst1) = vs1; \
    const float w0_ = wtab[(k0) + sr], w1_ = wtab[(k0) + 32 + sr]; v4u q0_, q1_; KW(ks0, w0_, q0_); KW(ks1, w1_, q1_); \
    *(v4u*)(K_lds + (bb) * SHM_K + vst0) = q0_; *(v4u*)(K_lds + (bb) * SHM_K + vst1) = q1_; } while (0)
    f32x16 acc0 = {}, acc1 = {};
    const int db = wid >> 1, eb0 = 2 * (wid & 1);
    SLOAD(0); asm volatile("s_waitcnt vmcnt(0)" ::: "memory"); SWRITE(0, 0); SLOAD(64); __syncthreads();
    constexpr int NT = SEGTOK / 64;
    for (int j = 0; j < NT; ++j) {
        const int buf = j & 1; const int ka = vbK + buf * SHM_K + db * 512, va = vbV + buf * SHM_V + eb0 * 512;
        s16x4 al[4], ah[4], bl0[4], bh0[4], bl1[4], bh1[4];
#define RD4(KS) do { al[KS] = tr_read<v_rd_off(0, KS, 0)>(ka); ah[KS] = tr_read<v_rd_off(0, KS, 1)>(ka); bl0[KS] = tr_read<v_rd_off(0, KS, 0)>(va); bh0[KS] = tr_read<v_rd_off(0, KS, 1)>(va); \
    bl1[KS] = tr_read<v_rd_off(1, KS, 0)>(va); bh1[KS] = tr_read<v_rd_off(1, KS, 1)>(va); } while (0)
        RD4(0); RD4(1); RD4(2); RD4(3);
#undef RD4
        asm volatile("s_waitcnt lgkmcnt(0)" ::: "memory"); SBAR();
#pragma unroll
        for (int ks = 0; ks < 4; ++ks) { const bf16x8 a = PKF(al[ks], ah[ks]);
            acc0 = __builtin_amdgcn_mfma_f32_32x32x16_bf16(a, PKF(bl0[ks], bh0[ks]), acc0, 0, 0, 0);
            acc1 = __builtin_amdgcn_mfma_f32_32x32x16_bf16(a, PKF(bl1[ks], bh1[ks]), acc1, 0, 0, 0); }
        if (j + 1 < NT) { asm volatile("s_waitcnt vmcnt(0)" ::: "memory"); SWRITE(buf ^ 1, 64 * (j + 1)); if (j + 2 < NT) SLOAD(64 * (j + 2)); }
        __syncthreads();
    }
#undef SLOAD
#undef SWRITE
#undef KW
    float* CS = (float*)(F.ws + WS_CSEG) + (size_t)(bh * NSEG + seg) * CSEG_STRIDE;
    const int r32 = lane & 31, hi = lane >> 5;
#pragma unroll
    for (int r = 0; r < 16; ++r) { const int d = 32 * db + crow(r, hi); CS[d * 128 + 32 * eb0 + r32] = acc0[r]; CS[d * 128 + 32 * (eb0 + 1) + r32] = acc1[r]; }
    float* nred = (float*)lds;
#pragma unroll
    for (int e = 0; e < 8; ++e) nred[sr * 128 + sc + e] = npart[e];
    __syncthreads();
    if (tid < 128) { float s = 0.f; for (int i = 0; i < 32; ++i) s += nred[i * 128 + tid]; CS[128 * 128 + tid] = s; }
    if (tid == 0) CS[128 * 128 + 128] = Lseg;
    asm volatile("s_waitcnt vmcnt(0)" ::: "memory"); __syncthreads();
    if (tid == 0) { __builtin_amdgcn_fence(__ATOMIC_RELEASE, "agent"); asm volatile("s_waitcnt vmcnt(0)" ::: "memory");
        __hip_atomic_fetch_add((unsigned*)(F.ctl + CW_SEGCNT + 64 * bh), 1u, __ATOMIC_RELAXED, __HIP_MEMORY_SCOPE_AGENT); }
    __syncthreads();
}

__device__ __forceinline__ void mlstm_unit(Frame& F, char* lds, int bh, int sj, int qi) {
    const int tid = F.tid, wid = F.wave, lane = F.lane, r32 = lane & 31, hi = lane >> 5, b = bh >> 3, h = bh & 7;
    char* V_lds = lds; char* K_lds = lds + 2 * SHM_V;
    float* wsf = (float*)(lds + FL_WS) + wid * 64; float* li_l = wsf; float* al_l = wsf + 32;
    float* btab = (float*)(lds + FL_BTAB); float* ntab = (float*)(lds + FL_NTAB);
    const size_t segrow = (size_t)b * SEQ + (size_t)sj * SEGTOK;
    const int tl0 = qi * 256;
    const float* FCb = (const float*)(F.ws + WS_FCUM) + (size_t)bh * SEQ; const float* LIb = (const float*)(F.ws + WS_LIT) + (size_t)bh * SEQ;
    const float L = ((const float*)(F.ws + WS_LAM))[16 + bh];
    const float Fref = sj > 0 ? FCb[sj * SEGTOK - 1] : 0.f;
    const bf16* MQC = (const bf16*)(F.ws + WS_MQC); bf16* BB = (bf16*)(F.ws + WS_MQC);
    const bf16* Kh = (const bf16*)(F.ws + WS_MKC) + segrow * 1024 + h * 128; const bf16* Vh = (const bf16*)(F.ws + WS_MV) + segrow * 1024 + h * 128;
    const int trow = tl0 + wid * 32 + r32;
    const bf16* Qw = MQC + (segrow + trow) * 1024 + h * 128 + hi * 8;
    bf16x8 qr[8];
#pragma unroll
    for (int d0 = 0; d0 < 8; ++d0) qr[d0] = *reinterpret_cast<const bf16x8*>(Qw + d0 * 16);
    const float At = (FCb[sj * SEGTOK + trow] - Fref) * LOG2E;
    const int sr = tid >> 4, sc = (tid & 15) * 8, vst0 = v_st(sr, sc), vst1 = v_st(32 + sr, sc);
    const int vb0 = (int)(uintptr_t)V_lds + v_rd_base(lane);
    float l_reg = 0.f; f32x16 o[4] = {};
    if (sj > 0) {
        if (tid == 0) { unsigned sp = 0; while (__hip_atomic_load((unsigned*)(F.ctl + CW_SEGCNT + 64 * bh), __ATOMIC_RELAXED, __HIP_MEMORY_SCOPE_AGENT) < (unsigned)NSEG) { __builtin_amdgcn_s_sleep(2); if (++sp > (1u << 22)) break; }
            __builtin_amdgcn_fence(__ATOMIC_ACQUIRE, "agent"); asm volatile("s_waitcnt vmcnt(0)" ::: "memory"); }
        __syncthreads();
        const float* CS = (const float*)(F.ws + WS_CSEG) + (size_t)(bh * NSEG) * CSEG_STRIDE;
        f32x4 ca[4][2]; float ns = 0.f;
#pragma unroll
        for (int q = 0; q < 4; ++q) { ca[q][0] = (f32x4){0.f, 0.f, 0.f, 0.f}; ca[q][1] = (f32x4){0.f, 0.f, 0.f, 0.f}; }
#pragma unroll 1
        for (int i = 0; i < sj; ++i) { const float* Ci = CS + (size_t)i * CSEG_STRIDE; const float cf = __expf(Fref - FCb[(i + 1) * SEGTOK - 1] + Ci[128 * 128 + 128] - L);
#pragma unroll
            for (int q = 0; q < 4; ++q) { const float* p = Ci + (q * 32 + sr) * 128 + sc; ca[q][0] += cf * *(const f32x4*)p; ca[q][1] += cf * *(const f32x4*)(p + 4); }
            if (tid < 128) ns += cf * Ci[128 * 128 + tid]; }
#pragma unroll
        for (int q = 0; q < 4; ++q) { v4u w; w.x = cvtpk(ca[q][0][0], ca[q][0][1]); w.y = cvtpk(ca[q][0][2], ca[q][0][3]); w.z = cvtpk(ca[q][1][0], ca[q][1][1]); w.w = cvtpk(ca[q][1][2], ca[q][1][3]);
            *(v4u*)(V_lds + (q >> 1) * SHM_V + ((q & 1) ? vst1 : vst0)) = w; }
        if (tid < 128) ntab[tid] = ns;
        __syncthreads();
        pv_d0(o, vb0, qr[0], qr[1], qr[2], qr[3]);
        pv_d0(o, vb0 + SHM_V, qr[4], qr[5], qr[6], qr[7]);
        float dn = 0.f;
#pragma unroll
        for (int d0 = 0; d0 < 8; ++d0) { const v4u qq = __builtin_bit_cast(v4u, qr[d0]); const float* nt = ntab + d0 * 16 + hi * 8;
            dn += bflo(qq.x) * nt[0] + bfhi(qq.x) * nt[1] + bflo(qq.y) * nt[2] + bfhi(qq.y) * nt[3] + bflo(qq.z) * nt[4] + bfhi(qq.z) * nt[5] + bflo(qq.w) * nt[6] + bfhi(qq.w) * nt[7]; }
        dn = half_swap_sum(dn);
        const float rsc = __builtin_amdgcn_exp2f(At);
        l_reg = rsc * dn;
        if (hi == 0) al_l[r32] = rsc; asm volatile("s_waitcnt lgkmcnt(0)" ::: "memory");
#pragma unroll
        for (int d = 0; d < 4; ++d)
#pragma unroll
            for (int r = 0; r < 16; ++r) o[d][r] *= al_l[crow(r, hi)];
        __syncthreads();
    }
    v4u vs0, vs1, ks0, ks1; float bt = 0.f;
#define SLOAD(k0) do { vs0 = *(const v4u*)(&Vh[(size_t)((k0) + sr) * 1024 + sc]); vs1 = *(const v4u*)(&Vh[(size_t)((k0) + 32 + sr) * 1024 + sc]); \
    ks0 = *(const v4u*)(&Kh[(size_t)((k0) + sr) * 1024 + sc]); ks1 = *(const v4u*)(&Kh[(size_t)((k0) + 32 + sr) * 1024 + sc]); \
    if (tid < 64) { const int s_ = sj * SEGTOK + (k0) + tid; bt = (LIb[s_] - L - (FCb[s_] - Fref)) * LOG2E; } } while (0)
#define SWRITE(bb) do { *(v4u*)(V_lds + (bb) * SHM_V + vst0) = vs0; *(v4u*)(V_lds + (bb) * SHM_V + vst1) = vs1; const int kc = sc * 2; \
    *(v4u*)(K_lds + (bb) * SHM_K + KSWZ(sr, kc)) = ks0; *(v4u*)(K_lds + (bb) * SHM_K + KSWZ(32 + sr, kc)) = ks1; if (tid < 64) btab[(bb) * 64 + tid] = bt; } while (0)
    const int NT = 4 * qi + 4, qc = 4 * qi + (wid >> 1), trel = (wid * 32 + r32) & 63;
    SLOAD(0); asm volatile("s_waitcnt vmcnt(0)" ::: "memory"); SWRITE(0); SLOAD(64); __syncthreads();
    for (int j = 0; j < NT; ++j) {
        const int buf = j & 1;
        if (j <= qc) {
            f32x16 p0 = {}, p1 = {};
            const char* Ks = K_lds + buf * SHM_K;
#pragma unroll
            for (int d0 = 0; d0 < 8; ++d0) { const int cb = (d0 * 16 + hi * 8) * 2;
                const bf16x8 b0 = *reinterpret_cast<const bf16x8*>(Ks + KSWZ(r32, cb)), b1 = *reinterpret_cast<const bf16x8*>(Ks + KSWZ(32 + r32, cb));
                p0 = __builtin_amdgcn_mfma_f32_32x32x16_bf16(b0, qr[d0], p0, 0, 0, 0); p1 = __builtin_amdgcn_mfma_f32_32x32x16_bf16(b1, qr[d0], p1, 0, 0, 0); if (d0 == 3) SBAR(); }
            const float* bp = btab + buf * 64 + 4 * hi; float ps = 0.f; const bool diag = (j == qc);
#pragma unroll
            for (int r = 0; r < 16; ++r) { const int kk = (r & 3) + 8 * (r >> 2);
                float w0 = __builtin_amdgcn_exp2f(At + bp[kk]), w1 = __builtin_amdgcn_exp2f(At + bp[kk + 32]);
                if (diag) { if (kk + 4 * hi > trel) w0 = 0.f; if (kk + 32 + 4 * hi > trel) w1 = 0.f; }
                p0[r] *= w0; p1[r] *= w1; ps += p0[r] + p1[r]; }
            l_reg += half_swap_sum(ps);
            bf16x8 pa0, pa1, pa2, pa3; pack_p(p0, p1, pa0, pa1, pa2, pa3);
            SBAR();
            pv_d0(o, vb0 + buf * SHM_V, pa0, pa1, pa2, pa3);
        }
        if (j + 1 < NT) { asm volatile("s_waitcnt vmcnt(0)" ::: "memory"); SWRITE(buf ^ 1); if (j + 2 < NT) SLOAD(64 * (j + 2)); }
        __syncthreads();
    }
#undef SLOAD
#undef SWRITE
    const float den = fmaxf(fabsf(l_reg), __expf(-L));
    if (hi == 0) li_l[r32] = den; asm volatile("s_waitcnt lgkmcnt(0)" ::: "memory");
    const float* hn = F.in[8] + h * 128;
    float g[4];
#pragma unroll
    for (int d0 = 0; d0 < 4; ++d0) g[d0] = hn[d0 * 32 + r32];
    bf16* OT = (bf16*)lds;
#pragma unroll
    for (int r = 0; r < 16; ++r) { const float rd = __builtin_amdgcn_rcpf(li_l[crow(r, hi)]); float hv[4]; float s = 0.f;
#pragma unroll
        for (int d0 = 0; d0 < 4; ++d0) { hv[d0] = o[d0][r] * rd; s += hv[d0] * hv[d0]; }
        s = half_sum32(s); const float rs = 1.0f / sqrtf(s * (1.0f / 128.0f) + EPS);
#pragma unroll
        for (int d0 = 0; d0 < 4; ++d0) OT[(wid * 32 + crow(r, hi)) * 128 + d0 * 32 + r32] = (bf16)f2bf(hv[d0] * rs * g[d0]); }
    __syncthreads();
    const bf16* MO = (const bf16*)(F.ws + WS_MO);
#pragma unroll
    for (int i = 0; i < 8; ++i) { const int p = tid + 512 * i, row = p >> 4, ch = p & 15; const size_t goff = (segrow + tl0 + row) * 1024 + h * 128 + ch * 8;
        const v4u a = *(const v4u*)(lds + row * 256 + ch * 16), m = *(const v4u*)(MO + goff); v4u w;
        w.x = cvtpk(bflo(a.x) * bflo(m.x), bfhi(a.x) * bfhi(m.x)); w.y = cvtpk(bflo(a.y) * bflo(m.y), bfhi(a.y) * bfhi(m.y));
        w.z = cvtpk(bflo(a.z) * bflo(m.z), bfhi(a.z) * bfhi(m.z)); w.w = cvtpk(bflo(a.w) * bflo(m.w), bfhi(a.w) * bfhi(m.w));
        *(v4u*)(BB + goff) = w; }
    __syncthreads();
}

__device__ __forceinline__ unsigned fkey(float f) { const unsigned u = __float_as_uint(f); return (u & 0x80000000u) ? ~u : (u | 0x80000000u); }
__device__ __forceinline__ float funkey(unsigned k) { const unsigned u = (k & 0x80000000u) ? (k & 0x7fffffffu) : ~k; return __uint_as_float(u); }
#define TK_INSERT(L, x) do { unsigned x_ = (x); _Pragma("unroll") for (int j_ = 0; j_ < 16; ++j_) { const unsigned h_ = max(L[j_], x_); x_ = min(L[j_], x_); L[j_] = h_; } } while (0)
#define TK_MERGE(L) do { unsigned o_[16]; _Pragma("unroll") for (int j_ = 0; j_ < 16; ++j_) { auto rr_ = __builtin_amdgcn_permlane32_swap(L[j_], L[j_], false, false); L[j_] = rr_[0]; o_[j_] = rr_[1]; } \
    _Pragma("unroll") for (int q_ = 0; q_ < 16; ++q_) TK_INSERT(L, o_[q_]); } while (0)
typedef __bf16 bf16x2_t __attribute__((ext_vector_type(2)));
__device__ __forceinline__ float dot2bf(unsigned a, unsigned b, float c) { return __builtin_amdgcn_fdot2_f32_bf16(__builtin_bit_cast(bf16x2_t, a), __builtin_bit_cast(bf16x2_t, b), c, false); }

__device__ __forceinline__ void route_unit(Frame& F, char* lds, int t0, int hh) {
    const int lane = F.lane, r32 = lane & 31, hi = lane >> 5, wid = F.wave;
    const bf16* QP = (const bf16*)(F.ws + WS_QP); const bf16* SK = (const bf16*)(F.ws + WS_SK);
    int* IDX = (int*)(F.ws + WS_IDX); float* GATE = (float*)(F.ws + WS_GATE);
    float fa[16], fb[16];
    int* tab = (int*)(lds) + (wid * 64 + lane) * 33;
#pragma unroll
    for (int c = 0; c < 2; ++c) {
        unsigned L[16];
#pragma unroll
        for (int j = 0; j < 16; ++j) L[j] = 0u;
        const bf16* qrow = QP + (size_t)(t0 + r32) * 2048 + hh * 256 + c * 128 + hi * 8;
        bf16x8 qf[8];
#pragma unroll
        for (int ks = 0; ks < 8; ++ks) qf[ks] = *reinterpret_cast<const bf16x8*>(qrow + ks * 16);
        const bf16* skb = SK + (size_t)((hh * 2 + c) * 128 + r32) * 128 + hi * 8;
        const unsigned nbase = 127u - 4u * (unsigned)hi;
#pragma unroll
        for (int nb = 0; nb < 4; ++nb) { f32x16 acc = {}; const bf16* sp = skb + (size_t)nb * 32 * 128; asm volatile("" : "+v"(sp));
#pragma unroll
            for (int ks = 0; ks < 8; ++ks) { const bf16x8 a = *reinterpret_cast<const bf16x8*>(sp + ks * 16); acc = __builtin_amdgcn_mfma_f32_32x32x16_bf16(a, qf[ks], acc, 0, 0, 0); }
#pragma unroll
            for (int r = 0; r < 16; ++r) { const unsigned key = (fkey(acc[r]) & ~127u) | (nbase - (unsigned)(32 * nb + (r & 3) + 8 * (r >> 2))); TK_INSERT(L, key); }
            SBAR(); }
        TK_MERGE(L);
#pragma unroll
        for (int j = 0; j < 16; ++j) { const float f = funkey(L[j] & ~127u); if (c == 0) fa[j] = f; else fb[j] = f; tab[16 * c + j] = 127 - (int)(L[j] & 127u); }
        SBAR();
    }
    unsigned C[16];
#pragma unroll
    for (int j = 0; j < 16; ++j) C[j] = 0u;
    {
        float pa_ = 0.f, pb_ = 0.f; int pf_ = 0; int cnt = 0;
#pragma unroll
        for (int i = 0; i < 16; ++i)
#pragma unroll
            for (int j = 0; j < 16; ++j) if ((i + 1) * (j + 1) <= 16) {
                if ((cnt & 1) == 0) { pa_ = fa[i]; pb_ = fb[j]; pf_ = i * 16 + j; }
                else { const float s = hi ? fa[i] + fb[j] : pa_ + pb_; const int fl = hi ? i * 16 + j : pf_; const unsigned key = (fkey(s) & ~255u) | (unsigned)(255 - fl); TK_INSERT(C, key); }
                ++cnt; }
        static_assert(true, "");
    }
    TK_MERGE(C);
    asm volatile("s_waitcnt lgkmcnt(0)" ::: "memory");
    const float vmax = funkey(C[0] & ~255u); float ev[16]; float es = 0.f;
#pragma unroll
    for (int k = 0; k < 16; ++k) { ev[k] = __expf(funkey(C[k] & ~255u) - vmax); es += ev[k]; }
    const float ri = 1.0f / es;
    const size_t ob = (size_t)(t0 + r32) * 128 + hh * 16;
#pragma unroll
    for (int k = 0; k < 16; ++k) { const int fl = 255 - (int)(C[k] & 255u); const int e = tab[fl >> 4] * 128 + tab[16 + (fl & 15)];
        if ((k >> 3) == hi) { IDX[ob + k] = e; GATE[ob + k] = ev[k] * ri; } }
    asm volatile("s_waitcnt lgkmcnt(0)" ::: "memory");
}

__device__ __forceinline__ float gelu_tanh(float x) { const float z = 0.7978845608028654f * (x + 0.044715f * x * x * x); return x * __builtin_amdgcn_rcpf(1.0f + __builtin_amdgcn_exp2f(-2.0f * LOG2E * z)); }
__device__ __forceinline__ void peer_token(Frame& F, int t) {
    const int lane = F.lane;
    const bf16* UB = (const bf16*)(F.ws + WS_UB); const bf16* VB = (const bf16*)(F.ws + WS_VB);
    const int* IDX = (const int*)(F.ws + WS_IDX) + (size_t)t * 128; const float* GATE = (const float*)(F.ws + WS_GATE) + (size_t)t * 128;
    const float* norm_final = F.in[17];
    float* xrow = F.out + (size_t)t * DM;
    float ss = 0.f; unsigned xp[16];
#pragma unroll
    for (int j = 0; j < 4; ++j) { const f32x4 a = *(const f32x4*)(xrow + 512 * j + 8 * lane), b = *(const f32x4*)(xrow + 512 * j + 8 * lane + 4);
        ss += (a[0] * a[0] + a[1] * a[1]) + (a[2] * a[2] + a[3] * a[3]); ss += (b[0] * b[0] + b[1] * b[1]) + (b[2] * b[2] + b[3] * b[3]);
        xp[4 * j + 0] = cvtpk(a[0], a[1]); xp[4 * j + 1] = cvtpk(a[2], a[3]); xp[4 * j + 2] = cvtpk(b[0], b[1]); xp[4 * j + 3] = cvtpk(b[2], b[3]); }
    ss = wave_sum(ss);
    const float rstd2 = 1.0f / sqrtf(ss * (1.0f / DM) + EPS);
    float y[32];
#pragma unroll
    for (int i = 0; i < 32; ++i) y[i] = 0.f;
    const unsigned lo16 = (unsigned)lane * 16u;
    const int kown = ((lane >> 5) & 1) * 8 + ((lane >> 4) & 1) * 4 + ((lane >> 3) & 1) * 2 + ((lane >> 2) & 1);
#ifdef ABL_NOPEER
    for (int hh = 0; hh < 0; ++hh) {
#elif defined(ABL_HEAD)
    for (int hh = ABL_HEAD; hh < ABL_HEAD + 1; ++hh) {
#else
    for (int hh = 0; hh < 8; ++hh) {
#endif
        float part[16];
#ifdef PEER_NOU
        for (int i = 0; i < 16; ++i) part[i] = (float)(hh + i);
#else
#pragma unroll
        for (int kg = 0; kg < 4; ++kg) {
            v4u u[4][4];
#pragma unroll
            for (int k = 0; k < 4; ++k) { const int e = __builtin_amdgcn_readfirstlane(IDX[hh * 16 + kg * 4 + k]); const char* up = (const char*)UB + (size_t)e * (DM * 2);
#pragma unroll
                for (int j = 0; j < 4; ++j) u[k][j] = *(const v4u*)(up + (lo16 + 1024u * j)); }
#pragma unroll
            for (int k = 0; k < 4; ++k) { float a = 0.f;
#pragma unroll
                for (int j = 0; j < 4; ++j) {
                    a = dot2bf(xp[4 * j + 0], u[k][j][0], a);
                    a = dot2bf(xp[4 * j + 1], u[k][j][1], a);
                    a = dot2bf(xp[4 * j + 2], u[k][j][2], a);
                    a = dot2bf(xp[4 * j + 3], u[k][j][3], a); }
                part[kg * 4 + k] = a; }
            SBAR();
        }
#endif
        SBAR();
#pragma unroll
        for (int i = 0; i < 8; ++i) { const bool up_ = (lane & 32) != 0; const float send = up_ ? part[i] : part[i + 8], keep = up_ ? part[i + 8] : part[i]; part[i] = keep + __shfl_xor(send, 32); }
#pragma unroll
        for (int i = 0; i < 4; ++i) { const bool up_ = (lane & 16) != 0; const float send = up_ ? part[i] : part[i + 4], keep = up_ ? part[i + 4] : part[i]; part[i] = keep + __shfl_xor(send, 16); }
#pragma unroll
        for (int i = 0; i < 2; ++i) { const bool up_ = (lane & 8) != 0; const float send = up_ ? part[i] : part[i + 2], keep = up_ ? part[i + 2] : part[i]; part[i] = keep + __shfl_xor(send, 8); }
        { const bool up_ = (lane & 4) != 0; const float send = up_ ? part[0] : part[1], keep = up_ ? part[1] : part[0]; part[0] = keep + __shfl_xor(send, 4); }
        float a = part[0]; a += __shfl_xor(a, 2); a += __shfl_xor(a, 1);
#ifdef ABL_CONSTACT
        const float act = 0.28f * GATE[hh * 16 + kown] + 0.f * a; const unsigned actp = cvtpk(act, 0.f);
#else
        const float act = gelu_tanh(a * rstd2) * GATE[hh * 16 + kown]; const unsigned actp = cvtpk(act, 0.f);
#endif
        SBAR();
#ifndef PEER_NOV
#pragma unroll
        for (int kg = 0; kg < 4; ++kg) {
            v4u v[4][4];
#pragma unroll
            for (int k = 0; k < 4; ++k) { const int e = __builtin_amdgcn_readfirstlane(IDX[hh * 16 + kg * 4 + k]); const char* vp = (const char*)VB + (size_t)e * (DM * 2);
#pragma unroll
                for (int j = 0; j < 4; ++j) v[k][j] = *(const v4u*)(vp + (lo16 + 1024u * j)); }
#pragma unroll
            for (int k = 0; k < 4; ++k) { const int kk = kg * 4 + k; const int src = (((kk >> 3) & 1) * 32 + ((kk >> 2) & 1) * 16 + ((kk >> 1) & 1) * 8 + (kk & 1) * 4);
                const unsigned akl = __builtin_amdgcn_readlane(actp, src), akh = akl << 16;
#pragma unroll
                for (int j = 0; j < 4; ++j) { const v4u w = v[k][j];
                    y[8 * j + 0] = dot2bf(w[0], akl, y[8 * j + 0]); y[8 * j + 1] = dot2bf(w[0], akh, y[8 * j + 1]);
                    y[8 * j + 2] = dot2bf(w[1], akl, y[8 * j + 2]); y[8 * j + 3] = dot2bf(w[1], akh, y[8 * j + 3]);
                    y[8 * j + 4] = dot2bf(w[2], akl, y[8 * j + 4]); y[8 * j + 5] = dot2bf(w[2], akh, y[8 * j + 5]);
                    y[8 * j + 6] = dot2bf(w[3], akl, y[8 * j + 6]); y[8 * j + 7] = dot2bf(w[3], akh, y[8 * j + 7]); } }
            SBAR();
        }
#else
        y[hh] += act;
#endif
    }
    float s2 = 0.f;
#pragma unroll
    for (int j = 0; j < 4; ++j) { const f32x4 a = *(const f32x4*)(xrow + 512 * j + 8 * lane), b = *(const f32x4*)(xrow + 512 * j + 8 * lane + 4);
#pragma unroll
        for (int e = 0; e < 4; ++e) { float v = a[e] + y[8 * j + e]; y[8 * j + e] = v; s2 += v * v; v = b[e] + y[8 * j + 4 + e]; y[8 * j + 4 + e] = v; s2 += v * v; } }
    s2 = wave_sum(s2);
    const float rf = 1.0f / sqrtf(s2 * (1.0f / DM) + EPS);
#pragma unroll
    for (int j = 0; j < 4; ++j) { const f32x4 g0 = *(const f32x4*)(norm_final + 512 * j + 8 * lane), g1 = *(const f32x4*)(norm_final + 512 * j + 8 * lane + 4);
        f32x4 o0, o1; o0[0] = y[8 * j + 0] * rf * g0[0]; o0[1] = y[8 * j + 1] * rf * g0[1]; o0[2] = y[8 * j + 2] * rf * g0[2]; o0[3] = y[8 * j + 3] * rf * g0[3];
        o1[0] = y[8 * j + 4] * rf * g1[0]; o1[1] = y[8 * j + 5] * rf * g1[1]; o1[2] = y[8 * j + 6] * rf * g1[2]; o1[3] = y[8 * j + 7] * rf * g1[3];
        *(f32x4*)(xrow + 512 * j + 8 * lane) = o0; *(f32x4*)(xrow + 512 * j + 8 * lane + 4) = o1; }
}

__device__ __forceinline__ void p5_expert_cvt(Frame& F) {
    const int gw = F.vcu * NWAVES + F.wave, NGW = F.G * NWAVES, lane = F.lane;
    const float* eu = F.in[15]; const float* ev = F.in[16]; const float* g = F.in[12];
    bf16* UB = (bf16*)(F.ws + WS_UB); bf16* VB = (bf16*)(F.ws + WS_VB);
    f32x4 gv[8];
#pragma unroll
    for (int j = 0; j < 8; ++j) gv[j] = *(const f32x4*)(g + 4 * lane + 256 * j);
    for (int r = gw; r < 2 * NEXP; r += NGW) {
        const bool isv = r >= NEXP; const int e = isv ? r - NEXP : r;
        const GAS f32x4* src = (const GAS f32x4*)((isv ? ev : eu) + (size_t)e * DM) + lane; GAS u32x2* dst = (GAS u32x2*)((isv ? VB : UB) + (size_t)e * DM) + lane;
        f32x4 v[8];
#pragma unroll
        for (int j = 0; j < 8; ++j) v[j] = src[64 * j];
#pragma unroll
        for (int j = 0; j < 8; ++j) { f32x4 t = v[j]; if (!isv) t = t * gv[j]; u32x2 w; w.x = cvtpk(t[0], t[1]); w.y = cvtpk(t[2], t[3]); dst[64 * j] = w; }
    }
}

#ifndef MK_PER_PHASE
#define MK_PER_PHASE 1
#endif
constexpr int N_PHASES = 9;
struct Args { const float* in[18]; float* out; unsigned char* ws; int ph_lo, ph_hi; };
__global__ void __launch_bounds__(NWAVES * 64, 2) fwd_kernel(Args args) {
    extern __shared__ __attribute__((aligned(16))) unsigned char lds[];
    Frame F;
    F.lds = (LAS unsigned char*)lds;
    F.MISC = (volatile LAS unsigned*)(F.lds + MISC_OFF);
    F.tid = threadIdx.x; F.lane = F.tid & 63; F.wave = __builtin_amdgcn_readfirstlane(F.tid >> 6);
    F.G = gridDim.x; { const int bx = blockIdx.x; F.vcu = (F.G % 8 == 0) ? (bx % 8) * (F.G / 8) + bx / 8 : bx; }
    F.ws = args.ws; F.ctl = (gu32*)(args.ws + WS_CTL); F.out = args.out;
    F.in = (const float* const*)__builtin_amdgcn_kernarg_segment_ptr();
    for (int u = F.tid; u < (LDS_BYTES - LDSCTL_OFF) / 4; u += NWAVES * 64) ((LAS unsigned*)(F.lds + LDSCTL_OFF))[u] = 0u;
    __syncthreads();
    XcdBarrier bar; bar.bar = (unsigned*)(F.ctl + CW_BAR); bar.x = 0; bar.st = nullptr;
    if (!MK_PER_PHASE) bar = xcd_barrier_post((unsigned*)(F.ctl + CW_BAR), F.MISC + 8);
    const int lo = args.ph_lo, hi = args.ph_hi;
#define IN(k) (lo <= (k) && (k) < hi)
#define SEAM(k) do { if (IN(k) && IN((k) + 1)) xcd_barrier(bar); } while (0)
    char* gl = (char*)lds + RING_OFF;

#ifndef SK0
    if (IN(0)) { p0_prep(F); } SEAM(0);
#endif
#ifndef SK1
    if (IN(1)) {
        pg8::Gemm g{(const bf16*)(F.ws + WS_XB), (const bf16*)(F.ws + WS_WIN), T, NPROJ, DM}; pg8::StaticOrder S; S.init(T, NPROJ, F.G, (int)blockIdx.x);
        pg8::EpiProj E{(bf16*)(F.ws + WS_QA), SEG_STRIDE / 2, (bf16*)(F.ws + WS_GATES), (const float*)(F.ws + WS_RSTD1), 0.125f * LOG2E};
        pg8::gemm_phase<pg8::EpiProj, pg8::StaticOrder, true, true>(F.lds + RING_OFF, g, S, E);
        p1_ifgates(F);
    } SEAM(1);
#endif
#ifndef SK2
    if (IN(2)) { p2_conv_scan(F); } SEAM(2);
#endif
    if (IN(3)) {
        const int v = F.vcu;
#ifndef SK3A
        if (v < 16 * NSEG) mlstm_seg_task(F, gl, v >> 3, v & 7);
#endif
#ifndef SK3B
#pragma unroll 1
        for (int pi = 0; pi < 4; ++pi) { const int p = 2 * v + (pi >> 1); if (p < 512) { const int bh = p >> 5, u = p & 31; attn_unit(F, gl, bh >> 3, bh & 7, (pi & 1) ? 63 - u : u); } }
#endif
#ifndef SK3C
        if (v < 256) { const int bh = v >> 4, sj = (v >> 1) & 7, pr = v & 1; mlstm_unit(F, gl, bh, sj, pr); mlstm_unit(F, gl, bh, sj, 3 - pr); }
#endif
    } SEAM(3);
#ifndef SK4
    if (IN(4)) {
        { pg8::Gemm g{(const bf16*)(F.ws + WS_QA), (const bf16*)(F.ws + WS_WA), T, DM, 1024}; pg8::StaticOrder S; S.init(T, DM, F.G, (int)blockIdx.x);
          pg8::EpiGate<0> E{(bf16*)(F.ws + WS_MERGED), (const bf16*)(F.ws + WS_GATES)};
          pg8::gemm_phase<pg8::EpiGate<0>, pg8::StaticOrder, true, true>(F.lds + RING_OFF, g, S, E); }
        { pg8::Gemm g{(const bf16*)(F.ws + WS_MQC), (const bf16*)(F.ws + WS_WB), T, DM, 1024}; pg8::StaticOrder S; S.init(T, DM, F.G, (int)blockIdx.x);
          pg8::EpiGate<1> E{(bf16*)(F.ws + WS_MERGED), (const bf16*)(F.ws + WS_GATES)};
          pg8::gemm_phase<pg8::EpiGate<1>, pg8::StaticOrder, true, true>(F.lds + RING_OFF, g, S, E); }
    } SEAM(4);
#endif
#ifndef SK5
    if (IN(5)) {
        pg8::Gemm g{(const bf16*)(F.ws + WS_MERGED), (const bf16*)(F.ws + WS_WOUT), T, DM, DM}; pg8::StaticOrder S; S.init(T, DM, F.G, (int)blockIdx.x);
        pg8::EpiRes E{F.in[0], F.out, (bf16*)(F.ws + WS_X1B), (float*)(F.ws + WS_SSQ)};
        pg8::gemm_phase<pg8::EpiRes, pg8::StaticOrder, true, true>(F.lds + RING_OFF, g, S, E);
        p5_expert_cvt(F);
    } SEAM(5);
#endif
#ifndef SK6
    if (IN(6)) {
        pg8::Gemm g{(const bf16*)(F.ws + WS_X1B), (const bf16*)(F.ws + WS_WQ), T, DM, DM}; pg8::StaticOrder S; S.init(T, DM, F.G, (int)blockIdx.x);
        pg8::EpiQ E{(bf16*)(F.ws + WS_QP), (const float*)(F.ws + WS_SSQ), EPS};
        pg8::gemm_phase<pg8::EpiQ, pg8::StaticOrder, true, true>(F.lds + RING_OFF, g, S, E);
    } SEAM(6);
#endif
#ifndef SK7
    if (IN(7)) {
        const int gw = F.vcu * NWAVES + F.wave, NGW = F.G * NWAVES;
        for (int it = gw; it < (T / 32) * NH; it += NGW) route_unit(F, gl, (it >> 3) * 32, it & 7);
    } SEAM(7);
#endif
#ifndef SK8
    if (IN(8)) {
        const int gw = F.vcu * NWAVES + F.wave, NGW = F.G * NWAVES;
        for (int t = gw; t < T; t += NGW) peer_token(F, t);
    }
#endif
#undef IN
#undef SEAM
}

extern "C" void kernel_launch(void* const* d_in, const int* in_sizes, int n_in, void* d_out, int out_size, void* d_ws, size_t ws_size, hipStream_t stream) {
    static int grid = 0;
    if (grid == 0) {
        if (n_in != 18 || in_sizes[0] != T * DM || out_size != T * DM || ws_size < WS_END) { fprintf(stderr, "kernel_launch: unexpected shapes: n_in %d in0 %d out %d ws %zu (need %zu)\n", n_in, n_in > 0 ? in_sizes[0] : -1, out_size, ws_size, (size_t)WS_END); grid = -1; return; }
        int dev = 0, cus = 0, per_cu = 0;
        if (hipGetDevice(&dev) != hipSuccess || hipDeviceGetAttribute(&cus, hipDeviceAttributeMultiprocessorCount, dev) != hipSuccess) { grid = -1; return; }
        if (hipFuncSetAttribute((const void*)fwd_kernel, hipFuncAttributeMaxDynamicSharedMemorySize, LDS_BYTES) != hipSuccess) { fprintf(stderr, "kernel_launch: hipFuncSetAttribute failed\n"); grid = -1; return; }
        if (hipOccupancyMaxActiveBlocksPerMultiprocessor(&per_cu, (const void*)fwd_kernel, NWAVES * 64, LDS_BYTES) != hipSuccess || per_cu < 1) { fprintf(stderr, "kernel_launch: occupancy query says %d\n", per_cu); per_cu = 1; }
        (void)hipGetLastError();
        grid = cus;
    }
    if (grid < 0) return;
    (void)hipMemsetAsync((char*)d_ws + WS_CTL, 0, CTL_ZERO_BYTES, stream);
    Args a{};
    for (int i = 0; i < 18; ++i) a.in[i] = (const float*)d_in[i];
    a.out = (float*)d_out; a.ws = (unsigned char*)d_ws;
#if MK_PER_PHASE
    for (int p = 0; p < N_PHASES; ++p) { a.ph_lo = p; a.ph_hi = p + 1; hipLaunchKernelGGL(fwd_kernel, dim3(grid), dim3(NWAVES * 64), LDS_BYTES, stream, a); }
#else
    a.ph_lo = 0; a.ph_hi = N_PHASES;
    hipLaunchKernelGGL(fwd_kernel, dim3(grid), dim3(NWAVES * 64), LDS_BYTES, stream, a);
#endif
    const hipError_t le = hipPeekAtLastError();
    if (le != hipSuccess) fprintf(stderr, "kernel_launch: launch failed: %s\n", hipGetErrorName(le));
}
```

```cpp
#include <hip/hip_runtime.h>
#include <cstdio>
#include <cstdint>
namespace pg8 {
#define PG8_LAS __attribute__((address_space(3)))
typedef unsigned short bf16_t;
typedef short bf16x8 __attribute__((ext_vector_type(8)));
typedef float f32x4 __attribute__((ext_vector_type(4)));
typedef unsigned u32x4 __attribute__((ext_vector_type(4)));
constexpr int BM = 256, BK = 64, HALF = 128, HTB = HALF * BK * 2  , STAGE_BYTES = 8 * HTB, NXCD = 8, WGM = 8;

__host__ __device__ __forceinline__ int lds_byte(int r, int c) { const int st = (r >> 4) * 2 + (c >> 5), rr = r & 15, cc = c & 31, ob = rr * 64 + cc * 2; return st * 1024 + (ob ^ (((ob >> 9) & 1) << 5)); }
__host__ __device__ __forceinline__ void stage_rc(int b, int& R, int& C) { const int st = b / 1024, sb = b % 1024, swz = sb ^ (((sb >> 9) & 1) << 5); R = (st >> 1) * 16 + swz / 64; C = (st & 1) * 32 + (swz % 64) / 2; }
__host__ __device__ __forceinline__ int perm32(int rho) { const int n = rho >> 4, i = rho & 15; return 8 * (i >> 2) + 4 * n + (i & 3); }

struct Unit { int pm, pn; };
struct Gemm { const bf16_t* A; const bf16_t* Bt; int M, N, K; };

struct StaticOrder {
    int nM, nN, nwg, G, c;
    __host__ __device__ void init(int M, int N, int G_, int c_) { nM = M / BM; nN = N / BM; nwg = nM * nN; G = G_; c = c_; }
    __host__ __device__ bool next(int i, Unit& u) const {
        const long L = (long)i * G + c; if (L >= nwg) return false;
        int wgid = (int)L; { const int q = nwg / NXCD, r = nwg % NXCD, xcd = wgid % NXCD, off = wgid / NXCD; wgid = (xcd < r ? xcd * (q + 1) : r * (q + 1) + (xcd - r) * q) + off; }
        const int nig = WGM * nN, gid = wgid / nig, fm = gid * WGM, gsz = (nM - fm) < WGM ? (nM - fm) : WGM;
        u.pm = fm + ((wgid % nig) % gsz); u.pn = (wgid % nig) / gsz; return true;
    }
    __device__ __forceinline__ void a_ready(const Unit&) const {}
    __device__ __forceinline__ void done(const Unit&) const {}
};

__device__ __forceinline__ unsigned cvt_pk_bf16(float lo, float hi) { unsigned r; asm volatile("v_cvt_pk_bf16_f32 %0, %1, %2" : "=v"(r) : "v"(lo), "v"(hi)); return r; }
typedef float f32x2 __attribute__((ext_vector_type(2)));
__device__ __forceinline__ float sigmoidf_fast(float x) { return __builtin_amdgcn_rcpf(1.0f + __builtin_amdgcn_exp2f(-1.4426950408889634f * x)); }
__device__ __forceinline__ float bf_lo(unsigned w) { return __uint_as_float(w << 16); }
__device__ __forceinline__ float bf_hi(unsigned w) { return __uint_as_float(w & 0xffff0000u); }

struct EpiProj {
    static constexpr bool PERM = true, AFTER_DRAIN = false;
    bf16_t* segbase;
    size_t segstride;
    bf16_t* gates;
    const float* rstd;
    float cscale;
    float qscale;
    int pn_off;
    unsigned* kmax;
    __device__ __forceinline__ void operator()(const f32x4 (&acc)[2][2][4][2], const Unit& u, int wr, int wc, int fr, int fq) const {
        const int pn = u.pn + pn_off; bf16_t* base; int ldc, colt, mode;
        if (pn < 28) { const int seg = pn >> 2; base = segbase + (size_t)seg * segstride; ldc = 1024; colt = (pn & 3) * 256; mode = seg == 0 ? 1 : (seg == 6 ? 2 : 0); }
        else { base = gates; ldc = 4096; colt = (pn - 28) * 256; mode = 2; }
        const int row0 = u.pm * BM + wr * 64 + fr, col0 = colt + wc * 32 + 8 * fq; float kmx[2] = {0.f, 0.f};
        float rr[2][4];
#pragma unroll
        for (int ai = 0; ai < 2; ++ai)
#pragma unroll
            for (int m = 0; m < 4; ++m) rr[ai][m] = rstd ? rstd[row0 + ai * HALF + m * 16] : cscale;
#pragma unroll
        for (int ai = 0; ai < 2; ++ai)
#pragma unroll
            for (int m = 0; m < 4; ++m) { const int row = row0 + ai * HALF + m * 16; float r = rr[ai][m]; if (mode == 1) r *= qscale;
                bf16_t* rowp = base + (size_t)row * ldc + col0;
#pragma unroll
                for (int bj = 0; bj < 2; ++bj) { f32x4 v0 = acc[ai][bj][m][0] * r, v1 = acc[ai][bj][m][1] * r;
                    if (mode == 2) {
#pragma unroll
                        for (int e = 0; e < 4; ++e) { v0[e] = sigmoidf_fast(v0[e]); v1[e] = sigmoidf_fast(v1[e]); } }
                    u32x4 w; w.x = cvt_pk_bf16(v0[0], v0[1]); w.y = cvt_pk_bf16(v0[2], v0[3]); w.z = cvt_pk_bf16(v1[0], v1[1]); w.w = cvt_pk_bf16(v1[2], v1[3]);
                    *(u32x4*)(rowp + bj * HALF) = w;
                    if (kmax && pn >= 4 && pn < 8) {
                        float s = ((v0[0] * v0[0] + v0[1] * v0[1]) + (v0[2] * v0[2] + v0[3] * v0[3])) + ((v1[0] * v1[0] + v1[1] * v1[1]) + (v1[2] * v1[2] + v1[3] * v1[3]));
                        s += __shfl_xor(s, 16); s += __shfl_xor(s, 32); kmx[bj] = fmaxf(kmx[bj], s); } } }
        if (kmax && pn >= 4 && pn < 8 && fq == 0) {
#pragma unroll
            for (int bj = 0; bj < 2; ++bj) { float m = kmx[bj];
#pragma unroll
                for (int o = 1; o < 16; o <<= 1) m = fmaxf(m, __shfl_xor(m, o));
                if (fr == 0) atomicMax(kmax + (row0 >> 13) * 32 + ((colt + bj * HALF + wc * 32) >> 5), __float_as_uint(m)); } }
    }
};
template <int PASS> struct EpiGate {
    static constexpr bool PERM = true, AFTER_DRAIN = false;
    bf16_t* merged; const bf16_t* gates;
    __device__ __forceinline__ void operator()(const f32x4 (&acc)[2][2][4][2], const Unit& u, int wr, int wc, int fr, int fq) const {
        const int row0 = u.pm * BM + wr * 64 + fr, col0 = u.pn * BM + wc * 32 + 8 * fq;
        u32x4 gq[2][4][2];
#pragma unroll
        for (int ai = 0; ai < 2; ++ai)
#pragma unroll
            for (int m = 0; m < 4; ++m)
#pragma unroll
                for (int bj = 0; bj < 2; ++bj) gq[ai][m][bj] = *(const u32x4*)(gates + (size_t)(row0 + ai * HALF + m * 16) * 4096 + PASS * 2048 + col0 + bj * HALF);
#pragma unroll
        for (int ai = 0; ai < 2; ++ai) {
            u32x4 pq[4][2];
            if (PASS == 1) {
#pragma unroll
                for (int m = 0; m < 4; ++m)
#pragma unroll
                    for (int bj = 0; bj < 2; ++bj) pq[m][bj] = *(const u32x4*)(merged + (size_t)(row0 + ai * HALF + m * 16) * 2048 + col0 + bj * HALF); }
#pragma unroll
            for (int m = 0; m < 4; ++m)
#pragma unroll
                for (int bj = 0; bj < 2; ++bj) { const int row = row0 + ai * HALF + m * 16, col = col0 + bj * HALF; const u32x4 g = gq[ai][m][bj];
                    f32x4 v0 = acc[ai][bj][m][0], v1 = acc[ai][bj][m][1];
                    v0[0] *= bf_lo(g.x); v0[1] *= bf_hi(g.x); v0[2] *= bf_lo(g.y); v0[3] *= bf_hi(g.y); v1[0] *= bf_lo(g.z); v1[1] *= bf_hi(g.z); v1[2] *= bf_lo(g.w); v1[3] *= bf_hi(g.w);
                    if (PASS == 1) { const u32x4 p = pq[m][bj];
                        v0[0] += bf_lo(p.x); v0[1] += bf_hi(p.x); v0[2] += bf_lo(p.y); v0[3] += bf_hi(p.y); v1[0] += bf_lo(p.z); v1[1] += bf_hi(p.z); v1[2] += bf_lo(p.w); v1[3] += bf_hi(p.w); }
                    u32x4 w; w.x = cvt_pk_bf16(v0[0], v0[1]); w.y = cvt_pk_bf16(v0[2], v0[3]); w.z = cvt_pk_bf16(v1[0], v1[1]); w.w = cvt_pk_bf16(v1[2], v1[3]);
                    *(u32x4*)(merged + (size_t)row * 2048 + col) = w; }
        }
    }
};
struct EpiRes {
    static constexpr bool PERM = false, AFTER_DRAIN = false;
    const float* x; bf16_t* x1b; float* ssq;
    __device__ __forceinline__ void operator()(const f32x4 (&acc)[2][2][4][2], const Unit& u, int wr, int wc, int fr, int fq) const {
        const int row0 = u.pm * BM + wr * 64 + fr, col0 = u.pn * BM + wc * 32 + 4 * fq;
#pragma unroll
        for (int ai = 0; ai < 2; ++ai) {
            f32x4 xq[4][2][2];
#pragma unroll
            for (int m = 0; m < 4; ++m)
#pragma unroll
                for (int bj = 0; bj < 2; ++bj)
#pragma unroll
                    for (int n = 0; n < 2; ++n) xq[m][bj][n] = *(const f32x4*)(x + (size_t)(row0 + ai * HALF + m * 16) * 2048 + col0 + bj * HALF + n * 16);
#pragma unroll
            for (int m = 0; m < 4; ++m) { const int row = row0 + ai * HALF + m * 16; const size_t off = (size_t)row * 2048 + col0; float s = 0.f;
#pragma unroll
                for (int bj = 0; bj < 2; ++bj)
#pragma unroll
                    for (int n = 0; n < 2; ++n) { const size_t o = off + bj * HALF + n * 16; const f32x4 v = xq[m][bj][n] + acc[ai][bj][m][n];
                        typedef unsigned u32x2v __attribute__((ext_vector_type(2))); u32x2v w; w.x = cvt_pk_bf16(v[0], v[1]); w.y = cvt_pk_bf16(v[2], v[3]);
                        *(u32x2v*)(x1b + o) = w; s += (v[0] * v[0] + v[1] * v[1]) + (v[2] * v[2] + v[3] * v[3]); }
                s += __shfl_xor(s, 16); s += __shfl_xor(s, 32);
                if (fq == 0) ssq[(size_t)row * 32 + u.pn * 4 + wc] = s; }
        }
    }
};
struct EpiQ {
    static constexpr bool PERM = true, AFTER_DRAIN = false;
    bf16_t* out; const float* rstd2;
    __device__ __forceinline__ void operator()(const f32x4 (&acc)[2][2][4][2], const Unit& u, int wr, int wc, int fr, int fq) const {
        const int row0 = u.pm * BM + wr * 64 + fr, col0 = u.pn * BM + wc * 32 + 8 * fq;
        float rr[2][4];
#pragma unroll
        for (int ai = 0; ai < 2; ++ai)
#pragma unroll
            for (int m = 0; m < 4; ++m) rr[ai][m] = rstd2[row0 + ai * HALF + m * 16];
#pragma unroll
        for (int ai = 0; ai < 2; ++ai)
#pragma unroll
            for (int m = 0; m < 4; ++m) { const int row = row0 + ai * HALF + m * 16; const float r = rr[ai][m];
#pragma unroll
                for (int bj = 0; bj < 2; ++bj) { const f32x4 v0 = acc[ai][bj][m][0] * r, v1 = acc[ai][bj][m][1] * r;
                    u32x4 w; w.x = cvt_pk_bf16(v0[0], v0[1]); w.y = cvt_pk_bf16(v0[2], v0[3]); w.z = cvt_pk_bf16(v1[0], v1[1]); w.w = cvt_pk_bf16(v1[2], v1[3]);
                    *(u32x4*)(out + (size_t)row * 2048 + col0 + bj * HALF) = w; } }
    }
};

template <class Epi, class Sched, bool ALIGN_EPI = false, bool SP2 = false, bool FP8 = false>
__device__ __forceinline__ void gemm_phase(PG8_LAS unsigned char* lds, const Gemm g, const Sched& S, const Epi& E, const int wid_in) {
    const int wid = wid_in, lane = (int)__builtin_amdgcn_mbcnt_hi(~0u, __builtin_amdgcn_mbcnt_lo(~0u, 0u)), tid = wid * 64 + lane, wr = wid >> 2, wc = wid & 3, fr = lane & 15, fq = lane >> 4;
    const int K = g.K, nt = K / BK;
    unsigned voffA[2], voffB[2];
#pragma unroll
    for (int i = 0; i < 2; ++i) { int R, C; stage_rc(tid * 16 + i * 8192, R, C); const int Rb = Epi::PERM ? ((R & ~31) + perm32(R & 31)) : R;
        voffA[i] = (unsigned)(R * K + C) * 2u; voffB[i] = (unsigned)(Rb * K + C) * 2u; }
    const size_t half64 = (size_t)64 * K * 2;
    const size_t kstep = (size_t)(BK * 2);
    const size_t hstep = (size_t)HALF * K * 2;
    const size_t tstep = 2 * hstep;
    const unsigned ldsw = (unsigned)wid * 1024u; const unsigned ldsw_base = (unsigned)__builtin_amdgcn_readfirstlane((int)((unsigned)(uintptr_t)lds + ldsw));
    const int aoff = lds_byte(wr * 64 + fr, fq * 8), boff = lds_byte(wc * 32 + fr, fq * 8);
    const PG8_LAS unsigned char* const ldsA = lds + aoff; const PG8_LAS unsigned char* const ldsB = lds + 4 * HTB + boff;
#define PG8_SA(b, h) (((b) * 2 + (h)) * HTB)
#define PG8_SB(b, h) ((4 + (b) * 2 + (h)) * HTB)
#define PG8_STAGE(bufoff, gbase, voff) do { _Pragma("unroll") for (int _i = 0; _i < 2; ++_i) \
        asm volatile("s_add_u32 m0, %2, %3\n\ts_nop 0\n\tglobal_load_lds_dwordx4 %0, %1" : : "v"((voff)[0]), "s"((const char*)(gbase) + (size_t)_i * half64), "s"(ldsw_base), "i"((bufoff) + _i * 8192) : "memory", "scc"); } while (0)
#define PG8_LDA(dst, b, h) do { _Pragma("unroll") for (int m = 0; m < 4; ++m) { if constexpr (FP8) { const i32x4_ r0_ = *(const PG8_LAS i32x4_*)(ldsA + PG8_SA(b, h) + m * 2048), r1_ = *(const PG8_LAS i32x4_*)(ldsA + PG8_SA(b, h) + m * 2048 + 1024); dst##8[m] = __builtin_shufflevector(r0_, r1_, 0, 1, 2, 3, 4, 5, 6, 7); } \
        else { _Pragma("unroll") for (int k = 0; k < 2; ++k) dst[m][k] = *(const PG8_LAS bf16x8*)(ldsA + PG8_SA(b, h) + m * 2048 + k * 1024); } } } while (0)
#define PG8_LDB(dst, b, h) do { _Pragma("unroll") for (int n = 0; n < 2; ++n) { if constexpr (FP8) { const i32x4_ r0_ = *(const PG8_LAS i32x4_*)(ldsB + (PG8_SB(b, h) - 4 * HTB) + n * 2048), r1_ = *(const PG8_LAS i32x4_*)(ldsB + (PG8_SB(b, h) - 4 * HTB) + n * 2048 + 1024); dst##8[n] = __builtin_shufflevector(r0_, r1_, 0, 1, 2, 3, 4, 5, 6, 7); } \
        else { _Pragma("unroll") for (int k = 0; k < 2; ++k) dst[n][k] = *(const PG8_LAS bf16x8*)(ldsB + (PG8_SB(b, h) - 4 * HTB) + n * 2048 + k * 1024); } } } while (0)
#define PG8_MMA(ai, bj, At, Bt) do { __builtin_amdgcn_s_setprio(1); _Pragma("unroll") for (int m = 0; m < 4; ++m) _Pragma("unroll") for (int n = 0; n < 2; ++n) { \
        if constexpr (FP8) acc[ai][bj][m][n] = __builtin_amdgcn_mfma_scale_f32_16x16x128_f8f6f4(Bt##8[n], At##8[m], acc[ai][bj][m][n], 0, 0, 0, 127, 0, 127); \
        else { _Pragma("unroll") for (int k = 0; k < 2; ++k) acc[ai][bj][m][n] = __builtin_amdgcn_mfma_f32_16x16x32_bf16(Bt[n][k], At[m][k], acc[ai][bj][m][n], 0, 0, 0); } } \
        __builtin_amdgcn_s_setprio(0); } while (0)
#define PG8_WAIT_V(n) asm volatile("s_waitcnt vmcnt(" #n ")" ::: "memory")
#define PG8_WAIT_L(n) asm volatile("s_waitcnt lgkmcnt(" #n ")" ::: "memory")
#define PG8_BAR __builtin_amdgcn_s_barrier()
#define PG8_SCHED __builtin_amdgcn_sched_barrier(0)
    Unit cur, nxt; int ui = 0;
    if (!S.next(0, cur)) return;
    f32x4 acc[2][2][4][2];
#pragma unroll
    for (int a = 0; a < 2; ++a)
#pragma unroll
        for (int b = 0; b < 2; ++b)
#pragma unroll
            for (int m = 0; m < 4; ++m)
#pragma unroll
                for (int n = 0; n < 2; ++n) acc[a][b][m][n] = (f32x4){0.f, 0.f, 0.f, 0.f};
    typedef int i32x8_ __attribute__((ext_vector_type(8))); typedef int i32x4_ __attribute__((ext_vector_type(4)));
    bf16x8 At[4][2], B0[2][2], B1[2][2]; i32x8_ At8[4], B08[2], B18[2];
    const char* cA = (const char*)g.A + (size_t)cur.pm * tstep; const char* cB = (const char*)g.Bt + (size_t)cur.pn * tstep;
    S.a_ready(cur);
    if constexpr (SP2) {
        PG8_STAGE(PG8_SB(0, 0), cB, voffB); PG8_STAGE(PG8_SB(0, 1), cB + hstep, voffB); PG8_STAGE(PG8_SA(0, 0), cA, voffA); PG8_STAGE(PG8_SA(0, 1), cA + hstep, voffA);
        if (wr == 1) PG8_BAR;
        PG8_WAIT_V(2); PG8_BAR;
        PG8_STAGE(PG8_SB(1, 0), cB + kstep, voffB); PG8_STAGE(PG8_SA(1, 0), cA + kstep, voffA); PG8_STAGE(PG8_SB(1, 1), cB + hstep + kstep, voffB);
        PG8_WAIT_V(6); PG8_BAR;
    } else {
        PG8_STAGE(PG8_SB(0, 0), cB, voffB); PG8_STAGE(PG8_SA(0, 0), cA, voffA); PG8_STAGE(PG8_SB(0, 1), cB + hstep, voffB); PG8_STAGE(PG8_SA(0, 1), cA + hstep, voffA);
        if (wr == 1) PG8_BAR;
        PG8_WAIT_V(4); PG8_BAR;
        PG8_STAGE(PG8_SB(1, 0), cB + kstep, voffB); PG8_STAGE(PG8_SA(1, 0), cA + kstep, voffA); PG8_STAGE(PG8_SB(1, 1), cB + hstep + kstep, voffB);
        PG8_WAIT_V(6); PG8_BAR;
    }
    for (;;) {
        const bool has_next = S.next(ui + 1, nxt);
        const char* nA = has_next ? (const char*)g.A + (size_t)nxt.pm * tstep : cA; const char* nB = has_next ? (const char*)g.Bt + (size_t)nxt.pn * tstep : cB;
        for (int t = 0; t < nt; t += 2) {
            const bool last = (t == nt - 2);
            const char* a1 = cA + (size_t)(t + 1) * kstep;
            const char* a2 = last ? nA : cA + (size_t)(t + 2) * kstep; const char* b2 = last ? nB : cB + (size_t)(t + 2) * kstep;
            const char* a3 = a2 + kstep; const char* b3 = b2 + kstep;
            if (last && has_next) S.a_ready(nxt);
            if constexpr (SP2) {
            PG8_LDB(B0, 0, 0); PG8_LDB(B1, 0, 1); PG8_SCHED; PG8_LDA(At, 0, 0); PG8_STAGE(PG8_SA(1, 1), a1 + hstep, voffA);
            PG8_WAIT_V(8); PG8_WAIT_L(0); PG8_BAR; PG8_MMA(0, 0, At, B0); PG8_MMA(0, 1, At, B1); PG8_BAR; PG8_SCHED;
            PG8_LDA(At, 0, 1); PG8_STAGE(PG8_SB(0, 0), b2, voffB); PG8_STAGE(PG8_SB(0, 1), b2 + hstep, voffB); PG8_STAGE(PG8_SA(0, 0), a2, voffA);
            PG8_WAIT_V(8); PG8_WAIT_L(0); PG8_BAR; PG8_MMA(1, 0, At, B0); PG8_MMA(1, 1, At, B1); PG8_BAR; PG8_SCHED;
            PG8_LDB(B0, 1, 0); PG8_LDB(B1, 1, 1); PG8_SCHED; PG8_LDA(At, 1, 0); PG8_STAGE(PG8_SA(0, 1), a2 + hstep, voffA);
            PG8_WAIT_V(8); PG8_WAIT_L(0); PG8_BAR; PG8_MMA(0, 0, At, B0); PG8_MMA(0, 1, At, B1); PG8_BAR; PG8_SCHED;
            PG8_LDA(At, 1, 1); PG8_STAGE(PG8_SB(1, 0), b3, voffB); PG8_STAGE(PG8_SB(1, 1), b3 + hstep, voffB); PG8_STAGE(PG8_SA(1, 0), a3, voffA);
            PG8_WAIT_V(8); PG8_WAIT_L(0); PG8_BAR; PG8_MMA(1, 0, At, B0); PG8_MMA(1, 1, At, B1); PG8_BAR; PG8_SCHED;
            } else {
            PG8_LDB(B0, 0, 0); PG8_SCHED; PG8_LDA(At, 0, 0); PG8_STAGE(PG8_SA(1, 1), a1 + hstep, voffA);
            PG8_WAIT_L(8); PG8_BAR; PG8_WAIT_L(0); PG8_MMA(0, 0, At, B0); PG8_BAR; PG8_SCHED;
            PG8_LDB(B1, 0, 1); PG8_STAGE(PG8_SB(0, 0), b2, voffB);
            PG8_BAR; PG8_WAIT_L(0); PG8_MMA(0, 1, At, B1); PG8_BAR;
            PG8_LDA(At, 0, 1); PG8_STAGE(PG8_SA(0, 0), a2, voffA);
            PG8_BAR; PG8_WAIT_L(0); PG8_MMA(1, 0, At, B0); PG8_BAR; PG8_SCHED;
            PG8_STAGE(PG8_SB(0, 1), b2 + hstep, voffB);
            PG8_WAIT_V(6); PG8_BAR; PG8_MMA(1, 1, At, B1); PG8_BAR;
            PG8_LDB(B0, 1, 0); PG8_SCHED; PG8_LDA(At, 1, 0); PG8_STAGE(PG8_SA(0, 1), a2 + hstep, voffA);
            PG8_WAIT_L(8); PG8_BAR; PG8_WAIT_L(0); PG8_MMA(0, 0, At, B0); PG8_BAR; PG8_SCHED;
            PG8_LDB(B1, 1, 1); PG8_STAGE(PG8_SB(1, 0), b3, voffB);
            PG8_BAR; PG8_WAIT_L(0); PG8_MMA(0, 1, At, B1); PG8_BAR;
            PG8_LDA(At, 1, 1); PG8_STAGE(PG8_SA(1, 0), a3, voffA);
            PG8_BAR; PG8_WAIT_L(0); PG8_MMA(1, 0, At, B0); PG8_BAR; PG8_SCHED;
            PG8_STAGE(PG8_SB(1, 1), b3 + hstep, voffB);
            PG8_WAIT_V(6); PG8_BAR; PG8_MMA(1, 1, At, B1); PG8_BAR;
            }
        }
        if constexpr (ALIGN_EPI) { if (wr == 0) PG8_BAR; }
        if constexpr (!Epi::AFTER_DRAIN) { int laneE = (int)__builtin_amdgcn_mbcnt_hi(~0u, __builtin_amdgcn_mbcnt_lo(~0u, 0u)); asm volatile("" : "+v"(laneE));
            const int widE = wid_in; E(acc, cur, widE >> 2, widE & 3, laneE & 15, laneE >> 4); S.done(cur); }
        if (!has_next) break;
#pragma unroll
        for (int a = 0; a < 2; ++a)
#pragma unroll
            for (int b = 0; b < 2; ++b)
#pragma unroll
                for (int m = 0; m < 4; ++m)
#pragma unroll
                    for (int n = 0; n < 2; ++n) acc[a][b][m][n] = (f32x4){0.f, 0.f, 0.f, 0.f};
        cur = nxt; cA = nA; cB = nB; ++ui;
        if constexpr (ALIGN_EPI) { if (wr == 1) PG8_BAR; }
    }
    PG8_WAIT_V(0);
    if constexpr (!ALIGN_EPI) { if (wr == 0) PG8_BAR; }
    PG8_BAR;
    if constexpr (Epi::AFTER_DRAIN) { E.fused(acc, cur, wr, wc, fr, fq, lds, wid, lane); S.done(cur); }
#undef PG8_SA
#undef PG8_SB
#undef PG8_STAGE
#undef PG8_LDA
#undef PG8_LDB
#undef PG8_MMA
#undef PG8_WAIT_V
#undef PG8_WAIT_L
#undef PG8_BAR
#undef PG8_SCHED
}
}

constexpr int NWAVES = 8;
constexpr int BATCH = 2, SEQ = 8192, DM = 2048, T = BATCH * SEQ;
constexpr int IN_WIDTH = 11280, NPROJ = 11264;
constexpr int NH = 8, HD = 128;
constexpr int NEXP = 16384, NKEYS = 128, TOPK = 16;
constexpr float EPS = 1e-6f;
constexpr float LOG2E = 1.4426950408889634f;
constexpr int SEGTOK = 1024, NSEG = SEQ / SEGTOK;

constexpr size_t MiB = 1u << 20;
constexpr size_t WS_CTL = 0, CTL_ZERO_BYTES = 1 * MiB;
constexpr size_t WS_IF = 1 * MiB;
constexpr size_t WS_RSTD1 = 2 * MiB;
constexpr size_t WS_LAM = 2 * MiB + 64 * 1024;
constexpr size_t WS_FCUM = 2 * MiB + 128 * 1024;
constexpr size_t WS_LIT = 2 * MiB + 640 * 1024;
constexpr size_t WS_WA = 4 * MiB, WS_WB = 8 * MiB, WS_WOUT = 12 * MiB, WS_WQ = 20 * MiB;
constexpr size_t WS_SK = 28 * MiB;
constexpr size_t WS_WIF = 28 * MiB + 512 * 1024;
constexpr size_t WS_SSQ = 29 * MiB;
constexpr size_t WS_WIN = 32 * MiB;
constexpr size_t WS_CSEG = 32 * MiB;
constexpr int NSENS = 2048;
constexpr size_t WS_WINB = 60 * MiB;
constexpr size_t WS_XB = 76 * MiB;
constexpr size_t OUT_MQC = 0, OUT_MKC = 32 * MiB;
constexpr size_t WS_BB = 76 * MiB;
constexpr size_t WS_QA = 140 * MiB;
constexpr size_t SEG_STRIDE = 32 * MiB;
constexpr size_t WS_KA = WS_QA + SEG_STRIDE, WS_VA = WS_QA + 2 * SEG_STRIDE, WS_MQ = WS_QA + 3 * SEG_STRIDE, WS_MK = WS_QA + 4 * SEG_STRIDE, WS_MV = WS_QA + 5 * SEG_STRIDE, WS_MO = WS_QA + 6 * SEG_STRIDE;
constexpr size_t WS_MERGED = WS_KA;
constexpr size_t WS_X1B = WS_MQ;
constexpr size_t WS_QP = WS_MV;
constexpr size_t WS_GATES = 364 * MiB;
constexpr size_t WS_UB = 364 * MiB, WS_VB = 428 * MiB, WS_VB6 = 396 * MiB;
constexpr size_t WS_PART = 140 * MiB;
constexpr size_t WS_ACT = 204 * MiB;
constexpr size_t WS_SSQ2 = 212 * MiB;
constexpr size_t WS_RSTD2 = 215 * MiB;
constexpr size_t WS_X8 = 420 * MiB;
constexpr size_t WS_X6 = 420 * MiB;
constexpr size_t WS_Y = 300 * MiB;
constexpr size_t WS_SCU = 31 * MiB, WS_SCV = 31 * MiB + 256 * 1024;
constexpr size_t WS_IDX = 492 * MiB, WS_GATE = 500 * MiB;
constexpr size_t WS_END = 508 * MiB;
constexpr int CSEG_STRIDE = 128 * 128 + 128 + 8;
static_assert((size_t)16 * NSEG * CSEG_STRIDE * 4 <= 44 * MiB, "CSEG fits W_in region");
constexpr int CW_BAR = 4096;
constexpr int CW_KMAX = 20480;
constexpr int CW_QUEUE = 24576;
constexpr int CW_SEGCNT = 16384;

constexpr int RING_OFF = 0, RING_BYTES = 131072;
constexpr int LDSCTL_OFF = RING_BYTES, MISC_OFF = LDSCTL_OFF + 320;
constexpr int LDS_BYTES = 147456;

#define GAS __attribute__((address_space(1)))
#define LAS __attribute__((address_space(3)))
typedef unsigned short bf16;
typedef unsigned v4u __attribute__((ext_vector_type(4)));
typedef float f32x4 __attribute__((ext_vector_type(4)));
typedef short bf16x8 __attribute__((ext_vector_type(8)));
typedef GAS unsigned gu32;
typedef GAS unsigned long long gu64;
#define RLX_AGENT __ATOMIC_RELAXED, __HIP_MEMORY_SCOPE_AGENT
#define LDS_WAIT() asm volatile("s_waitcnt lgkmcnt(0)" ::: "memory")
#define VM_WAIT() asm volatile("s_waitcnt vmcnt(0)" ::: "memory")
__device__ __forceinline__ unsigned long long rt() { return __builtin_amdgcn_s_memrealtime(); }
__device__ __forceinline__ unsigned f2bf(float f) { unsigned u = __builtin_bit_cast(unsigned, f); return (u + 0x7fffu + ((u >> 16) & 1u)) >> 16; }
__device__ __forceinline__ unsigned pk2(float lo, float hi) { return f2bf(lo) | (f2bf(hi) << 16); }

#define XB_TMO      128
#define XB_XCNT(j)  (256  + 64 * (j))
#define XB_XSUB(j)  (1280 + 64 * (j))
#define XB_XGEN(j)  (2304 + 64 * (j))
#define XB_TOP      3328
#define XB_TOPGEN   3392
#define XCD_BAR_WORDS 3456
#define XB_SPIN_CAP (1u << 18)

__device__ __forceinline__ unsigned xb_ld(unsigned* p)              { return __hip_atomic_load(p, __ATOMIC_RELAXED, __HIP_MEMORY_SCOPE_AGENT); }
__device__ __forceinline__ unsigned xb_add(unsigned* p, unsigned v) { return __hip_atomic_fetch_add(p, v, __ATOMIC_RELAXED, __HIP_MEMORY_SCOPE_AGENT); }
__device__ __forceinline__ unsigned xb_xcc_id() { return (unsigned)__builtin_amdgcn_s_getreg((3 << 11) | 20) & 0xFu; }
#define XB_SPIN(cond, bar) do { unsigned _sp = 0; while (cond) { __builtin_amdgcn_s_sleep(1); \
    if ((++_sp & 255u) == 0u) { if (xb_ld(&(bar)[XB_TMO])) break; if (_sp > XB_SPIN_CAP) { atomicAdd(&(bar)[XB_TMO], 1u); break; } } } } while (0)

struct XcdBarrier {
    unsigned* bar; unsigned x;
    volatile LAS unsigned* st;
    bool w0;
};
__device__ __forceinline__ int xb_lane_id() { return (int)__builtin_amdgcn_mbcnt_hi(~0u, __builtin_amdgcn_mbcnt_lo(~0u, 0u)); }

__device__ __forceinline__ XcdBarrier xcd_barrier_post(unsigned* bar, volatile LAS unsigned* st, int wave) {
    XcdBarrier b; b.bar = bar; b.x = xb_xcc_id(); b.st = st; b.w0 = wave == 0;
    if (b.w0 && xb_lane_id() == 0) (void)xb_add(&bar[XB_XCNT(b.x)], 1u);
    return b;
}
__device__ __forceinline__ void xcd_barrier_complete(unsigned* bar, unsigned x, unsigned& nloc, unsigned& nx) {
    const unsigned G = gridDim.x * gridDim.y * gridDim.z;
    unsigned sum, cnt, mine, sp = 0u;
    for (;;) {
        sum = 0u; cnt = 0u; mine = 0u;
#pragma unroll
        for (unsigned j = 0; j < 16; ++j) { const unsigned c = xb_ld(&bar[XB_XCNT(j)]); sum += c; cnt += (c > 0u) ? 1u : 0u; mine = (j == x) ? c : mine; }
        if (sum == G) break;
        __builtin_amdgcn_s_sleep(1);
        if ((++sp & 255u) == 0u) { if (xb_ld(&bar[XB_TMO])) break; if (sp > XB_SPIN_CAP) { atomicAdd(&bar[XB_TMO], 1u); break; } }
    }
    nloc = mine > 0u ? mine : 1u; nx = cnt > 0u ? cnt : 1u;
}

__device__ __forceinline__ void xcd_barrier(const XcdBarrier& b) {
    asm volatile("s_waitcnt vmcnt(0)" ::: "memory");
    __syncthreads();
    if (b.w0 && xb_lane_id() == 0) {
        unsigned* bar = b.bar;
        __builtin_amdgcn_s_waitcnt(0);
        unsigned nloc = b.st[0], nx = b.st[1];
        if (nloc == 0u) { xcd_barrier_complete(bar, b.x, nloc, nx); b.st[0] = nloc; b.st[1] = nx; }
        const unsigned old = xb_add(&bar[XB_XSUB(b.x)], 1u);
        const unsigned gen = old / nloc;
        if (old + 1u == (gen + 1u) * nloc) {
            __builtin_amdgcn_fence(__ATOMIC_RELEASE, "agent");
            asm volatile("s_waitcnt vmcnt(0)" ::: "memory");
            const unsigned og = xb_add(&bar[XB_TOP], 1u);
            const unsigned tg = og / nx;
            if (og + 1u == (tg + 1u) * nx) xb_add(&bar[XB_TOPGEN], 1u);
            else XB_SPIN(xb_ld(&bar[XB_TOPGEN]) == tg, bar);
            __builtin_amdgcn_fence(__ATOMIC_ACQUIRE, "agent");
            xb_add(&bar[XB_XGEN(b.x)], 1u);
            asm volatile("s_waitcnt vmcnt(0)" ::: "memory");
        } else {
            XB_SPIN(xb_ld(&bar[XB_XGEN(b.x)]) == gen, bar);
            __builtin_amdgcn_fence(__ATOMIC_ACQUIRE, "agent");
            asm volatile("s_waitcnt vmcnt(0)" ::: "memory");
        }
    }
    __syncthreads();
}

struct Frame {
    LAS unsigned char* lds;
    volatile LAS unsigned* MISC;
    gu32* ctl;
    unsigned char* ws;
    int tid, lane, wave;
    int vcu, G;
    const float* const* in;
    float* out;
};
typedef unsigned u32x2 __attribute__((ext_vector_type(2)));
typedef float f32x16 __attribute__((ext_vector_type(16)));
typedef short s16x4 __attribute__((ext_vector_type(4)));

__device__ __forceinline__ float wave_sum(float v) {
#pragma unroll
    for (int o = 1; o < 64; o <<= 1) v += __shfl_xor(v, o);
    return v;
}
__device__ __forceinline__ float wave_max(float v) {
#pragma unroll
    for (int o = 1; o < 64; o <<= 1) v = fmaxf(v, __shfl_xor(v, o));
    return v;
}
__device__ __forceinline__ float bflo(unsigned w) { return __uint_as_float(w << 16); }
__device__ __forceinline__ float bfhi(unsigned w) { return __uint_as_float(w & 0xffff0000u); }
__device__ __forceinline__ unsigned cvtpk(float lo, float hi) { unsigned r; asm volatile("v_cvt_pk_bf16_f32 %0, %1, %2" : "=v"(r) : "v"(lo), "v"(hi)); return r; }

template <bool HASG> __device__ __forceinline__ void transpose_item(const float* W, int ldw, int src_col0, int k0, bf16* WT, int ldt, int dst_row0, const float* gk, LAS float* scr, int lane) {
    { const float* wp_ = W + (size_t)(k0 + (lane >> 3)) * ldw + src_col0 + 4 * (lane & 7); const float* gp_ = gk + k0 + (lane >> 3); LAS float* sp_ = scr + (lane >> 3) * 33 + 4 * (lane & 7);
      f32x4 v[8]; float gq[8];
#pragma unroll
      for (int i = 0; i < 8; ++i) { v[i] = *(const f32x4*)(wp_ + (size_t)(8 * i) * ldw); if constexpr (HASG) gq[i] = gp_[8 * i]; else gq[i] = 1.0f; }
#pragma unroll
      for (int i = 0; i < 8; ++i) { sp_[8 * i * 33] = v[i][0] * gq[i]; sp_[8 * i * 33 + 1] = v[i][1] * gq[i]; sp_[8 * i * 33 + 2] = v[i][2] * gq[i]; sp_[8 * i * 33 + 3] = v[i][3] * gq[i]; } }
    LDS_WAIT(); asm volatile("" ::: "memory");
    const int c = lane & 7;
#pragma unroll
    for (int j = 0; j < 4; ++j) { const int n = (lane >> 3) + 8 * j; const LAS float* s = scr + (8 * c) * 33 + n;
        v4u o; o.x = pk2(s[0 * 33], s[1 * 33]); o.y = pk2(s[2 * 33], s[3 * 33]); o.z = pk2(s[4 * 33], s[5 * 33]); o.w = pk2(s[6 * 33], s[7 * 33]);
        *(GAS v4u*)(WT + (size_t)(dst_row0 + n) * ldt + k0 + 8 * c) = o; }
    LDS_WAIT(); asm volatile("" ::: "memory");
}
template <bool HASG> __device__ __forceinline__ void transpose_item8(const float* W, int ldw, int src_col0, int k0, unsigned char* WT8, int ldt, int dst_row0, const float* gk, float scale, LAS float* scr, int lane) {
    { const float* wp_ = W + (size_t)(k0 + (lane >> 3)) * ldw + src_col0 + 4 * (lane & 7); const float* gp_ = gk + k0 + (lane >> 3); LAS float* sp_ = scr + (lane >> 3) * 33 + 4 * (lane & 7);
      f32x4 v[8]; float gq[8];
#pragma unroll
      for (int i = 0; i < 8; ++i) { v[i] = *(const f32x4*)(wp_ + (size_t)(8 * i) * ldw); if constexpr (HASG) gq[i] = gp_[8 * i]; else gq[i] = 1.0f; }
#pragma unroll
      for (int i = 0; i < 8; ++i) gq[i] *= scale;
#pragma unroll
      for (int i = 0; i < 8; ++i) { sp_[8 * i * 33] = v[i][0] * gq[i]; sp_[8 * i * 33 + 1] = v[i][1] * gq[i]; sp_[8 * i * 33 + 2] = v[i][2] * gq[i]; sp_[8 * i * 33 + 3] = v[i][3] * gq[i]; } }
    LDS_WAIT(); asm volatile("" ::: "memory");
    const int c = lane & 7;
#pragma unroll
    for (int j = 0; j < 4; ++j) { const int n = (lane >> 3) + 8 * j; const LAS float* s = scr + (8 * c) * 33 + n;
        int p0 = __builtin_amdgcn_cvt_pk_fp8_f32(s[0 * 33], s[1 * 33], 0, false); p0 = __builtin_amdgcn_cvt_pk_fp8_f32(s[2 * 33], s[3 * 33], p0, true);
        int p1 = __builtin_amdgcn_cvt_pk_fp8_f32(s[4 * 33], s[5 * 33], 0, false); p1 = __builtin_amdgcn_cvt_pk_fp8_f32(s[6 * 33], s[7 * 33], p1, true);
        u32x2 o; o.x = (unsigned)p0; o.y = (unsigned)p1;
        *(GAS u32x2*)(WT8 + (size_t)(dst_row0 + n) * ldt + k0 + 8 * c) = o; }
    LDS_WAIT(); asm volatile("" ::: "memory");
}
constexpr float WIN_SCALE = 64.0f;
__device__ __forceinline__ void p0_prep(Frame& F) {
    LAS float* scr = (LAS float*)(F.lds + RING_OFF + F.wave * 16384);
    const int gw = F.vcu * NWAVES + F.wave, NGW = F.G * NWAVES, lane = F.lane;
    const float* x = F.in[0]; const float* norm_mix = F.in[1]; const float* w_in = F.in[2];
    const float* da_lambda = F.in[6];
    const float* w_a = F.in[9]; const float* w_b = F.in[10]; const float* w_out = F.in[11]; const float* norm_ffn = F.in[12]; const float* peer_query = F.in[13]; const float* subkeys = F.in[14];
    bf16* WIN = (bf16*)(F.ws + WS_WIN); bf16* WA = (bf16*)(F.ws + WS_WA); bf16* WB = (bf16*)(F.ws + WS_WB); bf16* WOUT = (bf16*)(F.ws + WS_WOUT); bf16* WQ = (bf16*)(F.ws + WS_WQ);
    bf16* SK = (bf16*)(F.ws + WS_SK); bf16* WIF = (bf16*)(F.ws + WS_WIF); bf16* XB = (bf16*)(F.ws + WS_XB); float* RSTD1 = (float*)(F.ws + WS_RSTD1);
    constexpr int I_IN = 32 * 352, I_A = 16 * 64, I_B = 16 * 64, I_OUT = 32 * 64, I_Q = 32 * 64, I_IF = 512, I_SK = 512, I_LAM = 1;
    constexpr int NITEMS = I_IN + I_A + I_B + I_OUT + I_Q + I_IF + I_SK + I_LAM;
    for (int it = gw; it < NITEMS; it += NGW) {
        int r = it;
        if (r < I_IN) { const int kb = r / 352, nb = r % 352, n0 = nb * 32;
            if (n0 < NSENS) transpose_item<true>(w_in, IN_WIDTH, n0, kb * 64, (bf16*)(F.ws + WS_WINB), DM, n0, norm_mix, scr, lane);
            else transpose_item8<true>(w_in, IN_WIDTH, n0 + (n0 >= 7168 ? 16 : 0), kb * 64, (unsigned char*)WIN, DM, n0 - NSENS, norm_mix, WIN_SCALE, scr, lane);
            continue; } r -= I_IN;
        if (r < I_A) { const int kb = r / 64, nb = r % 64; transpose_item<false>(w_a, 2048, nb * 32, kb * 64, WA, 1024, nb * 32, w_a, scr, lane); continue; } r -= I_A;
        if (r < I_B) { const int kb = r / 64, nb = r % 64; transpose_item<false>(w_b, 2048, nb * 32, kb * 64, WB, 1024, nb * 32, w_b, scr, lane); continue; } r -= I_B;
        if (r < I_OUT) { const int kb = r / 64, nb = r % 64; transpose_item<false>(w_out, 2048, nb * 32, kb * 64, WOUT, 2048, nb * 32, w_out, scr, lane); continue; } r -= I_OUT;
        if (r < I_Q) { const int kb = r / 64, nb = r % 64; transpose_item<true>(peer_query, 2048, nb * 32, kb * 64, WQ, 2048, nb * 32, norm_ffn, scr, lane); continue; } r -= I_Q;
        if (r < I_IF) { const int e = r * 64 + lane, j = e >> 11, k = e & 2047; WIF[e] = (bf16)f2bf(w_in[(size_t)k * IN_WIDTH + 7168 + j] * norm_mix[k]); continue; } r -= I_IF;
        if (r < I_SK) {
#pragma unroll
            for (int q = 0; q < 2; ++q) { const int e = r * 512 + q * 256 + lane * 4; const f32x4 v = *(const f32x4*)(subkeys + e); u32x2 w; w.x = pk2(v[0], v[1]); w.y = pk2(v[2], v[3]); *(u32x2*)(SK + e) = w; }
            continue; } r -= I_SK;
        { float a = da_lambda[lane] * da_lambda[64 + lane], b = da_lambda[128 + lane] * da_lambda[192 + lane]; a = wave_sum(a); b = wave_sum(b);
          if (lane == 0) ((float*)(F.ws + WS_LAM))[0] = __expf(a) - __expf(b) + 0.2f; }
    }
    unsigned char* XB8 = (unsigned char*)F.out;
    for (int m = gw; m < T; m += NGW) {
        const GAS f32x4* xr = (const GAS f32x4*)(x + (size_t)m * DM) + lane; f32x4 v[8]; float s = 0.f;
#pragma unroll
        for (int j = 0; j < 8; ++j) { v[j] = xr[64 * j]; s += (v[j][0] * v[j][0] + v[j][1] * v[j][1]) + (v[j][2] * v[j][2] + v[j][3] * v[j][3]); }
        s = wave_sum(s);
        const float rs = 1.0f / sqrtf(s * (1.0f / DM) + EPS);
        GAS unsigned* o = (GAS unsigned*)(XB8 + (size_t)m * DM) + lane; GAS u32x2* ob = (GAS u32x2*)(XB + (size_t)m * DM) + lane;
#pragma unroll
        for (int j = 0; j < 8; ++j) { int p = __builtin_amdgcn_cvt_pk_fp8_f32(v[j][0] * rs, v[j][1] * rs, 0, false); p = __builtin_amdgcn_cvt_pk_fp8_f32(v[j][2] * rs, v[j][3] * rs, p, true); o[64 * j] = (unsigned)p;
            u32x2 w; w.x = pk2(v[j][0], v[j][1]); w.y = pk2(v[j][2], v[j][3]); ob[64 * j] = w; }
        if (lane == 0) RSTD1[m] = rs;
    }
}

__device__ __forceinline__ void p1_ifgates(Frame& F) {
    const int gw = (F.vcu >> 1) * NWAVES + F.wave, NGW = (F.G >> 1) * NWAVES, lane = F.lane;
    const bf16* WIF = (const bf16*)(F.ws + WS_WIF); const float* RSTD1 = (const float*)(F.ws + WS_RSTD1);
    const float* gbias = F.in[5]; float* IFO = (float*)(F.ws + WS_IF);
    for (int it = gw; it < T / 16; it += NGW) {
        const int t0 = it * 16; f32x4 acc = {0.f, 0.f, 0.f, 0.f};
        const bf16* ap = (const bf16*)(F.ws + WS_XB) + (size_t)(t0 + (lane & 15)) * DM + 8 * (lane >> 4); const bf16* bp = WIF + (size_t)(lane & 15) * DM + 8 * (lane >> 4);
#pragma unroll 8
        for (int ks = 0; ks < 64; ++ks) { const bf16x8 a = *(const bf16x8*)(ap + ks * 32); const bf16x8 b = *(const bf16x8*)(bp + ks * 32);
            acc = __builtin_amdgcn_mfma_f32_16x16x32_bf16(a, b, acc, 0, 0, 0); }
        const int col = lane & 15; const float bs = gbias[col];
#pragma unroll
        for (int j = 0; j < 4; ++j) { const int row = t0 + (lane >> 4) * 4 + j; IFO[(size_t)row * 16 + col] = acc[j] * RSTD1[row] + bs; }
    }
}

__device__ __forceinline__ void p2_conv_scan(Frame& F) {
    const float* conv_w = F.in[3]; const float* conv_b = F.in[4];
    const bf16* MQ = (const bf16*)(F.ws + WS_MQ); const bf16* MK = (const bf16*)(F.ws + WS_MK);
    bf16* MQC = (bf16*)((unsigned char*)F.out + OUT_MQC); bf16* MKC = (bf16*)((unsigned char*)F.out + OUT_MKC);
    const int nthr = F.G * 512, gt = F.vcu * 512 + F.tid;
    for (int item = gt; item < 256 * 1024; item += nthr) {
        const int cg = item & 255, run = item >> 8; const int c0 = (cg & 127) * 8; const bool isk = cg >= 128;
        const bf16* src = (isk ? MK : MQ) + c0; bf16* dst = (isk ? MKC : MQC) + c0; const int wc0 = (isk ? 1024 : 0) + c0;
        float w[4][8], bb[8];
#pragma unroll
        for (int j = 0; j < 4; ++j) { const f32x4 a = *(const f32x4*)(conv_w + j * 2048 + wc0), b = *(const f32x4*)(conv_w + j * 2048 + wc0 + 4);
            w[j][0] = a[0]; w[j][1] = a[1]; w[j][2] = a[2]; w[j][3] = a[3]; w[j][4] = b[0]; w[j][5] = b[1]; w[j][6] = b[2]; w[j][7] = b[3]; }
        { const f32x4 a = *(const f32x4*)(conv_b + wc0), b = *(const f32x4*)(conv_b + wc0 + 4); bb[0] = a[0]; bb[1] = a[1]; bb[2] = a[2]; bb[3] = a[3]; bb[4] = b[0]; bb[5] = b[1]; bb[6] = b[2]; bb[7] = b[3]; }
        const int t0 = run * 16; const bool first = (t0 & (SEQ - 1)) == 0;
        float h0[8], h1[8], h2[8];
#pragma unroll
        for (int e = 0; e < 8; ++e) { h0[e] = 0.f; h1[e] = 0.f; h2[e] = 0.f; }
        if (!first) {
            const v4u a = *(const v4u*)(src + (size_t)(t0 - 3) * 1024), b = *(const v4u*)(src + (size_t)(t0 - 2) * 1024), c = *(const v4u*)(src + (size_t)(t0 - 1) * 1024);
            h0[0] = bflo(a.x); h0[1] = bfhi(a.x); h0[2] = bflo(a.y); h0[3] = bfhi(a.y); h0[4] = bflo(a.z); h0[5] = bfhi(a.z); h0[6] = bflo(a.w); h0[7] = bfhi(a.w);
            h1[0] = bflo(b.x); h1[1] = bfhi(b.x); h1[2] = bflo(b.y); h1[3] = bfhi(b.y); h1[4] = bflo(b.z); h1[5] = bfhi(b.z); h1[6] = bflo(b.w); h1[7] = bfhi(b.w);
            h2[0] = bflo(c.x); h2[1] = bfhi(c.x); h2[2] = bflo(c.y); h2[3] = bfhi(c.y); h2[4] = bflo(c.z); h2[5] = bfhi(c.z); h2[6] = bflo(c.w); h2[7] = bfhi(c.w);
        }
        const float osc = isk ? 0.08838834764831845f : 1.0f;
        v4u dv[16];
#pragma unroll
        for (int i = 0; i < 16; ++i) dv[i] = *(const v4u*)(src + (size_t)(t0 + i) * 1024);
#pragma unroll
        for (int i = 0; i < 16; ++i) {
            const v4u d = dv[i]; float cur[8];
            cur[0] = bflo(d.x); cur[1] = bfhi(d.x); cur[2] = bflo(d.y); cur[3] = bfhi(d.y); cur[4] = bflo(d.z); cur[5] = bfhi(d.z); cur[6] = bflo(d.w); cur[7] = bfhi(d.w);
            float y[8];
#pragma unroll
            for (int e = 0; e < 8; ++e) { float v = bb[e] + w[0][e] * h0[e] + w[1][e] * h1[e] + w[2][e] * h2[e] + w[3][e] * cur[e]; v = v * pg8::sigmoidf_fast(v) * osc; y[e] = v; h0[e] = h1[e]; h1[e] = h2[e]; h2[e] = cur[e]; }
            v4u o; o.x = cvtpk(y[0], y[1]); o.y = cvtpk(y[2], y[3]); o.z = cvtpk(y[4], y[5]); o.w = cvtpk(y[6], y[7]);
            *(v4u*)(dst + (size_t)(t0 + i) * 1024) = o;
        }
    }
    if (F.vcu < 16) {
        const int bh = F.vcu, b = bh >> 3, h = bh & 7, tid = F.tid;
        const float* IFI = (const float*)(F.ws + WS_IF) + (size_t)b * SEQ * 16;
        float* FC = (float*)(F.ws + WS_FCUM) + (size_t)bh * SEQ; float* LI = (float*)(F.ws + WS_LIT) + (size_t)bh * SEQ;
        LAS float* sh = (LAS float*)(F.lds + RING_OFF);
        float lf[16]; float run = 0.f, lmax = -3.0e38f;
#pragma unroll
        for (int i = 0; i < 16; ++i) { const int t = tid * 16 + i; const float li = IFI[(size_t)t * 16 + h], fr = IFI[(size_t)t * 16 + 8 + h];
            const float ls = fminf(fr, 0.f) - log1pf(expf(-fabsf(fr))); run += ls; lf[i] = run; LI[t] = li; lmax = fmaxf(lmax, li); }
        float incl = run;
#pragma unroll
        for (int o = 1; o < 64; o <<= 1) { const float n = __shfl_up(incl, o); if (F.lane >= o) incl += n; }
        lmax = wave_max(lmax);
        if (F.lane == 63) sh[F.wave] = incl; if (F.lane == 0) sh[8 + F.wave] = lmax; __syncthreads();
        float base = incl - run, mx = sh[8];
#pragma unroll
        for (int w = 0; w < 8; ++w) { if (w < F.wave) base += sh[w]; mx = fmaxf(mx, sh[8 + w]); }
        if (tid == 0) ((float*)(F.ws + WS_LAM))[16 + bh] = mx;
#pragma unroll
        for (int i = 0; i < 16; ++i) FC[tid * 16 + i] = base + lf[i];
        __syncthreads();
    }
}

constexpr int SHM_V = 64 * 128 * 2, SHM_K = 64 * 128 * 2;
constexpr int FL_WS = 81920;
constexpr int FL_BTAB = FL_WS + 2048;
constexpr int FL_NTAB = FL_WS + 2048 + 512;
constexpr int FL_RED = FL_WS + 4096;
constexpr int FL_OT = FL_WS + 8192;
constexpr float ATT_MARGIN = 66.0f;
#define KSWZ(row, colB) ((row) * 256 + ((colB) ^ (((row) & 7) << 4)))
#define SBAR() __builtin_amdgcn_sched_barrier(0)
__device__ __forceinline__ int crow(int r, int hi) { return (r & 3) + 8 * (r >> 2) + 4 * hi; }
__device__ __forceinline__ int v_st(int k, int c) { const int kk = (k & ~0xC) | ((k & 4) << 1) | ((k & 8) >> 1); return ((kk >> 3) * 4 + (c >> 5)) * 512 + ((kk & 7) * 32 + (c & 31)) * 2; }
__device__ __forceinline__ int v_rd_base(int lane) { return ((lane & 3) << 3) | (((lane >> 2) & 3) << 6) | (((lane >> 4) & 1) << 5) | (((lane >> 5) & 1) << 8); }
constexpr int v_rd_off(int d0, int ks, int half) { return d0 * 512 + ks * 4096 + half * 2048; }
template <int OFF> __device__ __forceinline__ s16x4 tr_read(int vb) { s16x4 r; asm volatile("ds_read_b64_tr_b16 %0, %1 offset:%2" : "=&v"(r) : "v"(vb), "i"(OFF) : "memory"); return r; }
#define PKF(L, H) (bf16x8){L[0], L[1], L[2], L[3], H[0], H[1], H[2], H[3]}
template <int D0> __device__ __forceinline__ void pv_one(f32x16& od, int vb, bf16x8 pa0, bf16x8 pa1, bf16x8 pa2, bf16x8 pa3) {
    const s16x4 l0 = tr_read<v_rd_off(D0, 0, 0)>(vb), h0 = tr_read<v_rd_off(D0, 0, 1)>(vb), l1 = tr_read<v_rd_off(D0, 1, 0)>(vb), h1 = tr_read<v_rd_off(D0, 1, 1)>(vb);
    const s16x4 l2 = tr_read<v_rd_off(D0, 2, 0)>(vb), h2 = tr_read<v_rd_off(D0, 2, 1)>(vb), l3 = tr_read<v_rd_off(D0, 3, 0)>(vb), h3 = tr_read<v_rd_off(D0, 3, 1)>(vb);
    asm volatile("s_waitcnt lgkmcnt(0)" ::: "memory"); SBAR();
    od = __builtin_amdgcn_mfma_f32_32x32x16_bf16(pa0, PKF(l0, h0), od, 0, 0, 0);
    od = __builtin_amdgcn_mfma_f32_32x32x16_bf16(pa1, PKF(l1, h1), od, 0, 0, 0);
    od = __builtin_amdgcn_mfma_f32_32x32x16_bf16(pa2, PKF(l2, h2), od, 0, 0, 0);
    od = __builtin_amdgcn_mfma_f32_32x32x16_bf16(pa3, PKF(l3, h3), od, 0, 0, 0);
}
__device__ __forceinline__ void pv_d0(f32x16* o, int vb, bf16x8 pa0, bf16x8 pa1, bf16x8 pa2, bf16x8 pa3) {
    pv_one<0>(o[0], vb, pa0, pa1, pa2, pa3); pv_one<1>(o[1], vb, pa0, pa1, pa2, pa3); pv_one<2>(o[2], vb, pa0, pa1, pa2, pa3); pv_one<3>(o[3], vb, pa0, pa1, pa2, pa3);
}
__device__ __forceinline__ void pack_p(const f32x16& p0, const f32x16& p1, bf16x8& pa0, bf16x8& pa1, bf16x8& pa2, bf16x8& pa3) {
#define PK4(P, BASE, OUT) do { unsigned a0 = cvtpk(P[BASE + 0], P[BASE + 1]), a1 = cvtpk(P[BASE + 2], P[BASE + 3]);   \
    unsigned b0 = cvtpk(P[BASE + 4], P[BASE + 5]), b1 = cvtpk(P[BASE + 6], P[BASE + 7]);                              \
    auto r0 = __builtin_amdgcn_permlane32_swap(a0, b0, false, false); auto r1 = __builtin_amdgcn_permlane32_swap(a1, b1, false, false); \
    v4u w = {r0[0], r1[0], r0[1], r1[1]}; OUT = *reinterpret_cast<bf16x8*>(&w); } while (0)
    PK4(p0, 0, pa0); PK4(p0, 8, pa1); PK4(p1, 0, pa2); PK4(p1, 8, pa3);
#undef PK4
}
__device__ __forceinline__ float half_swap_sum(float v) { auto rr = __builtin_amdgcn_permlane32_swap(__float_as_uint(v), __float_as_uint(v), false, false); return __uint_as_float(rr[0]) + __uint_as_float(rr[1]); }
__device__ __forceinline__ float half_swap_max(float v) { auto rr = __builtin_amdgcn_permlane32_swap(__float_as_uint(v), __float_as_uint(v), false, false); return fmaxf(__uint_as_float(rr[0]), __uint_as_float(rr[1])); }
__device__ __forceinline__ float half_sum32(float v) { v += __shfl_xor(v, 1); v += __shfl_xor(v, 2); v += __shfl_xor(v, 4); v += __shfl_xor(v, 8); v += __shfl_xor(v, 16); return v; }

__device__ __forceinline__ void attn_unit(Frame& F, char* lds, int b, int h, int u, bf16* BA) {
    const int tid = F.tid, wid = F.wave, lane = F.lane, r32 = lane & 31, hi = lane >> 5, map = wid >> 2, wq = wid & 3;
    char* V_lds = lds; char* K_lds = lds + 2 * SHM_V;
    float* wsf = (float*)(lds + FL_WS) + wid * 64; float* li_l = wsf; float* al_l = wsf + 32;
    const size_t rowbase = (size_t)b * SEQ;
    const bf16* QA = (const bf16*)(F.ws + WS_QA); const bf16* KA = (const bf16*)(F.ws + WS_KA); const bf16* VA = (const bf16*)(F.ws + WS_VA);
    const bf16* Qw = QA + (rowbase + 128 * u + wq * 32 + r32) * 1024 + h * 128 + map * 64 + hi * 8;
    bf16x8 qr[4];
#pragma unroll
    for (int d0 = 0; d0 < 4; ++d0) qr[d0] = *reinterpret_cast<const bf16x8*>(Qw + d0 * 16);
    const bf16* Kh = KA + rowbase * 1024 + h * 128; const bf16* Vh = VA + rowbase * 1024 + h * 128;
    const int vb0 = (int)(uintptr_t)V_lds + v_rd_base(lane);
    const int NT = 2 * u + 2, qchunk = 2 * u + (wq >> 1), qrel = wq * 32 + r32;
    unsigned kvo[2], vvo[2];
#pragma unroll
    for (int i = 0; i < 2; ++i) { const int off = (wid * 2 + i) * 1024 + lane * 16;
        { const int r = off >> 8, chs = (off >> 4) & 15, ch = chs ^ (r & 7); kvo[i] = (unsigned)(r * 2048 + ch * 16); }
        { const int s = off >> 9, kk = (s >> 2) * 8 + ((lane & 31) >> 2), c = (s & 3) * 32 + (lane & 3) * 8, k = (kk & ~0xC) | ((kk & 4) << 1) | ((kk & 8) >> 1); vvo[i] = (unsigned)(k * 2048 + c * 2); } }
    const unsigned ldsK = (unsigned)__builtin_amdgcn_readfirstlane((int)((unsigned)(uintptr_t)K_lds + (unsigned)wid * 2048u)), ldsV = (unsigned)__builtin_amdgcn_readfirstlane((int)((unsigned)(uintptr_t)V_lds + (unsigned)wid * 2048u));
#define DMA16(voff, sbase, ldsdst, imm) asm volatile("s_add_u32 m0, %2, %3\n\ts_nop 0\n\tglobal_load_lds_dwordx4 %0, %1" : : "v"(voff), "s"(sbase), "s"(ldsdst), "i"(imm) : "memory", "scc")
#define DMAK(jj, slot) do { const char* sb_ = (const char*)(Kh + (size_t)(64 * (NT - 1 - (jj))) * 1024); const unsigned ld_ = ldsK + (unsigned)(slot) * (unsigned)SHM_K; DMA16(kvo[0], sb_, ld_, 0); DMA16(kvo[1], sb_, ld_, 1024); } while (0)
#define DMAV(jj, slot) do { const char* sb_ = (const char*)(Vh + (size_t)(64 * (NT - 1 - (jj))) * 1024); const unsigned ld_ = ldsV + (unsigned)(slot) * (unsigned)SHM_V; DMA16(vvo[0], sb_, ld_, 0); DMA16(vvo[1], sb_, ld_, 1024); } while (0)
    const float slope2 = __builtin_amdgcn_exp2f(-(float)(h + 1)) * LOG2E;
    float m_reg, l_reg = 0.f; f32x16 o[4] = {};
    float sbound;
    { float qn = 0.f;
#pragma unroll
      for (int d0 = 0; d0 < 4; ++d0) { const v4u qq = __builtin_bit_cast(v4u, qr[d0]);
#pragma unroll
          for (int c = 0; c < 4; ++c) { const float a = bflo(qq[c]), b2 = bfhi(qq[c]); qn += a * a + b2 * b2; } }
      qn = half_swap_sum(qn);
      const unsigned* km = (const unsigned*)(F.ctl + CW_KMAX) + b * 32 + 4 * h + 2 * map;
      const float kmax2 = __uint_as_float(km[0]) + __uint_as_float(km[1]);
      sbound = sqrtf(qn * kmax2) * 1.01f + 1.0f; }
    m_reg = slope2 * (float)qrel - sbound;
    int* jst = (int*)(lds + FL_NTAB); int jstop = 0;
#define SCORE(P0, P1, jj, slot) do { const int jt_ = NT - 1 - (jj); const int kb_ = 64 * jt_ - 128 * u + 4 * hi; \
        if (jt_ > qchunk) { _Pragma("unroll") for (int r = 0; r < 16; ++r) { P0[r] = -1e30f; P1[r] = -1e30f; } } \
        else { if (jt_ == qchunk) { _Pragma("unroll") for (int r = 0; r < 16; ++r) { const int k0_ = kb_ + (r & 3) + 8 * (r >> 2), k1_ = k0_ + 32; P0[r] = slope2 * (float)min(k0_, 2 * qrel - k0_) - m_reg; P1[r] = slope2 * (float)min(k1_, 2 * qrel - k1_) - m_reg; } } \
               else { const float bb0_ = slope2 * (float)kb_ - m_reg; _Pragma("unroll") for (int r = 0; r < 16; ++r) { P0[r] = fmaf(slope2, (float)((r & 3) + 8 * (r >> 2)), bb0_); P1[r] = P0[r] + 32.f * slope2; } } \
               const char* Ks_ = K_lds + (slot) * SHM_K; \
               _Pragma("unroll") for (int d0 = 0; d0 < 4; ++d0) { const int cb_ = (map * 64 + d0 * 16 + hi * 8) * 2; \
                   const bf16x8 b0_ = *reinterpret_cast<const bf16x8*>(Ks_ + KSWZ(r32, cb_)), b1_ = *reinterpret_cast<const bf16x8*>(Ks_ + KSWZ(32 + r32, cb_)); \
                   P0 = __builtin_amdgcn_mfma_f32_32x32x16_bf16(b0_, qr[d0], P0, 0, 0, 0); P1 = __builtin_amdgcn_mfma_f32_32x32x16_bf16(b1_, qr[d0], P1, 0, 0, 0); } } } while (0)
#define STEP(PC0, PC1, PN0, PN1, jj) do { \
        if ((jj) + 2 < NT) DMAK((jj) + 2, ((jj) + 2) % 3); \
        if ((jj) + 1 < NT) DMAV((jj) + 1, ((jj) + 1) & 1); \
        if ((jj) + 1 < NT) SCORE(PN0, PN1, (jj) + 1, ((jj) + 1) % 3); \
        float pmax = PC0[0]; \
        _Pragma("unroll") for (int r = 1; r < 16; ++r) pmax = fmaxf(pmax, PC0[r]); \
        _Pragma("unroll") for (int r = 0; r < 16; ++r) pmax = fmaxf(pmax, PC1[r]); \
        pmax = half_swap_max(pmax); \
        float alpha = 1.f; \
        if (!__all(pmax <= 8.0f)) { const float dl = fmaxf(pmax, 0.f); alpha = __builtin_amdgcn_exp2f(-dl); m_reg += dl; \
            _Pragma("unroll") for (int r = 0; r < 16; ++r) { PC0[r] -= dl; PC1[r] -= dl; } \
            if ((jj) + 1 < NT) { _Pragma("unroll") for (int r = 0; r < 16; ++r) { PN0[r] -= dl; PN1[r] -= dl; } } } \
        float ps = 0.f; \
        _Pragma("unroll") for (int r = 0; r < 16; ++r) { PC0[r] = __builtin_amdgcn_exp2f(PC0[r]); PC1[r] = __builtin_amdgcn_exp2f(PC1[r]); ps += PC0[r] + PC1[r]; } \
        ps = half_swap_sum(ps); \
        l_reg = l_reg * alpha + ps; \
        bf16x8 pa0, pa1, pa2, pa3; pack_p(PC0, PC1, pa0, pa1, pa2, pa3); \
        if (__any(alpha < 1.f)) { if (hi == 0) al_l[r32] = alpha; asm volatile("s_waitcnt lgkmcnt(0)" ::: "memory"); \
            _Pragma("unroll") for (int d = 0; d < 4; ++d) _Pragma("unroll") for (int r = 0; r < 16; ++r) o[d][r] *= al_l[crow(r, hi)]; } \
        SBAR(); \
        pv_d0(o, vb0 + ((jj) & 1) * SHM_V, pa0, pa1, pa2, pa3); \
        SBAR(); \
        if ((jj) == 1) { const float nf = (m_reg - ATT_MARGIN - sbound) / (64.f * slope2) + (float)(128 * u - 63) * (1.0f / 64.0f); int js = (int)ceilf(fmaxf(nf, 0.f)); \
            _Pragma("unroll") for (int o_ = 1; o_ < 64; o_ <<= 1) js = min(js, __shfl_xor(js, o_)); \
            if (lane == 0) jst[wid] = js; } \
        asm volatile("s_waitcnt vmcnt(0)" ::: "memory"); \
        __syncthreads(); } while (0)
    DMAK(0, 0); DMAV(0, 0); DMAK(1, 1);
    asm volatile("s_waitcnt vmcnt(0)" ::: "memory"); __syncthreads();
    f32x16 pA0, pA1, pB0, pB1;
    SCORE(pA0, pA1, 0, 0);
    for (int j = 0; j < NT; j += 2) {
        if (j == 2) { jstop = jst[0];
#pragma unroll
            for (int w = 1; w < 8; ++w) jstop = min(jstop, jst[w]); }
        if (NT - 1 - j < jstop) break;
        STEP(pA0, pA1, pB0, pB1, j);
        if (NT - 2 - j < jstop) break;
        STEP(pB0, pB1, pA0, pA1, j + 1);
    }
#undef DMAK
#undef DMAV
#undef DMA16
#undef SCORE
#undef STEP
    __syncthreads();
    if (hi == 0) li_l[r32] = l_reg; asm volatile("s_waitcnt lgkmcnt(0)" ::: "memory");
    float rli[16];
#pragma unroll
    for (int r = 0; r < 16; ++r) rli[r] = __builtin_amdgcn_rcpf(li_l[crow(r, hi)]);
    float* X = (float*)lds + wq * 4096;
    if (map == 1) {
#pragma unroll
        for (int r = 0; r < 16; ++r)
#pragma unroll
            for (int d0 = 0; d0 < 4; ++d0) X[crow(r, hi) * 128 + d0 * 32 + r32] = o[d0][r] * rli[r];
    }
    __syncthreads();
    if (map == 0) {
        const float lam = ((const float*)(F.ws + WS_LAM))[0]; const float* subln = F.in[7];
        float g[4];
#pragma unroll
        for (int d0 = 0; d0 < 4; ++d0) g[d0] = subln[d0 * 32 + r32] * 0.8f;
        bf16* OT = (bf16*)(lds + FL_OT);
#pragma unroll
        for (int r = 0; r < 16; ++r) { float dv[4]; float s = 0.f;
#pragma unroll
            for (int d0 = 0; d0 < 4; ++d0) { dv[d0] = o[d0][r] * rli[r] - lam * X[crow(r, hi) * 128 + d0 * 32 + r32]; s += dv[d0] * dv[d0]; }
            s = half_sum32(s); const float rs = 1.0f / sqrtf(s * (1.0f / 128.0f) + EPS);
#pragma unroll
            for (int d0 = 0; d0 < 4; ++d0) OT[(wq * 32 + crow(r, hi)) * 128 + d0 * 32 + r32] = (bf16)f2bf(dv[d0] * rs * g[d0]); }
    }
    __syncthreads();
#pragma unroll
    for (int i = 0; i < 4; ++i) { const int p = tid + 512 * i, row = p >> 4, ch = p & 15;
        *(v4u*)(BA + (rowbase + 128 * u + row) * 1024 + h * 128 + ch * 8) = *(const v4u*)(lds + FL_OT + row * 256 + ch * 16); }
}

__device__ __forceinline__ void mlstm_seg_task(Frame& F, char* lds, int bh, int seg) {
    const int tid = F.tid, wid = F.wave, lane = F.lane, b = bh >> 3, h = bh & 7;
    char* V_lds = lds; char* K_lds = lds + 2 * SHM_V;
    float* wtab = (float*)(lds + FL_RED);
    float* red = (float*)(lds + FL_WS);
    const size_t rowbase = (size_t)b * SEQ + (size_t)seg * SEGTOK;
    const float* FC = (const float*)(F.ws + WS_FCUM) + (size_t)bh * SEQ + seg * SEGTOK; const float* LI = (const float*)(F.ws + WS_LIT) + (size_t)bh * SEQ + seg * SEGTOK;
    const bf16* Kh = (const bf16*)((const unsigned char*)F.out + OUT_MKC) + rowbase * 1024 + h * 128; const bf16* Vh = (const bf16*)(F.ws + WS_MV) + rowbase * 1024 + h * 128;
    const float li0 = LI[tid], li1 = LI[512 + tid];
    float mx = wave_max(fmaxf(li0, li1)); if (lane == 0) red[wid] = mx; __syncthreads();
    float Lseg = red[0];
#pragma unroll
    for (int i = 1; i < 8; ++i) Lseg = fmaxf(Lseg, red[i]);
    const float FE = FC[SEGTOK - 1];
    wtab[tid] = __expf(FE - FC[tid] + li0 - Lseg); wtab[512 + tid] = __expf(FE - FC[512 + tid] + li1 - Lseg);
    __syncthreads();
    const int sr = tid >> 4, sc = (tid & 15) * 8, vst0 = v_st(sr, sc), vst1 = v_st(32 + sr, sc);
    const int vbV = (int)(uintptr_t)V_lds + v_rd_base(lane), vbK = (int)(uintptr_t)K_lds + v_rd_base(lane);
    v4u vs0, vs1, ks0, ks1; float npart[8];
#pragma unroll
    for (int e = 0; e < 8; ++e) npart[e] = 0.f;
#define SLOAD(k0) do { vs0 = *(const v4u*)(&Vh[(size_t)((k0) + sr) * 1024 + sc]); vs1 = *(const v4u*)(&Vh[(size_t)((k0) + 32 + sr) * 1024 + sc]); \
    ks0 = *(const v4u*)(&Kh[(size_t)((k0) + sr) * 1024 + sc]); ks1 = *(const v4u*)(&Kh[(size_t)((k0) + 32 + sr) * 1024 + sc]); } while (0)
#define KW(kv, wv, outv) do { float f0 = bflo(kv.x) * wv, f1 = bfhi(kv.x) * wv, f2 = bflo(kv.y) * wv, f3 = bfhi(kv.y) * wv, f4 = bflo(kv.z) * wv, f5 = bfhi(kv.z) * wv, f6 = bflo(kv.w) * wv, f7 = bfhi(kv.w) * wv; \
    npart[0] += f0; npart[1] += f1; npart[2] += f2; npart[3] += f3; npart[4] += f4; npart[5] += f5; npart[6] += f6; npart[7] += f7; \
    outv.x = cvtpk(f0, f1); outv.y = cvtpk(f2, f3); outv.z = cvtpk(f4, f5); outv.w = cvtpk(f6, f7); } while (0)
#define SWRITE(bb, k0) do { *(v4u*)(V_lds + (bb) * SHM_V + vst0) = vs0; *(v4u*)(V_lds + (bb) * SHM_V + vst1) = vs1; \
    const float w0_ = wtab[(k0) + sr], w1_ = wtab[(k0) + 32 + sr]; v4u q0_, q1_; KW(ks0, w0_, q0_); KW(ks1, w1_, q1_); \
    *(v4u*)(K_lds + (bb) * SHM_K + vst0) = q0_; *(v4u*)(K_lds + (bb) * SHM_K + vst1) = q1_; } while (0)
    f32x16 acc0 = {}, acc1 = {};
    const int db = wid >> 1, eb0 = 2 * (wid & 1);
    SLOAD(0); asm volatile("s_waitcnt vmcnt(0)" ::: "memory"); SWRITE(0, 0); SLOAD(64); __syncthreads();
    constexpr int NT = SEGTOK / 64;
    for (int j = 0; j < NT; ++j) {
        const int buf = j & 1; const int ka = vbK + buf * SHM_K + db * 512, va = vbV + buf * SHM_V + eb0 * 512;
        s16x4 al[4], ah[4], bl0[4], bh0[4], bl1[4], bh1[4];
#define RD4(KS) do { al[KS] = tr_read<v_rd_off(0, KS, 0)>(ka); ah[KS] = tr_read<v_rd_off(0, KS, 1)>(ka); bl0[KS] = tr_read<v_rd_off(0, KS, 0)>(va); bh0[KS] = tr_read<v_rd_off(0, KS, 1)>(va); \
    bl1[KS] = tr_read<v_rd_off(1, KS, 0)>(va); bh1[KS] = tr_read<v_rd_off(1, KS, 1)>(va); } while (0)
        RD4(0); RD4(1); RD4(2); RD4(3);
#undef RD4
        asm volatile("s_waitcnt lgkmcnt(0)" ::: "memory"); SBAR();
#pragma unroll
        for (int ks = 0; ks < 4; ++ks) { const bf16x8 a = PKF(al[ks], ah[ks]);
            acc0 = __builtin_amdgcn_mfma_f32_32x32x16_bf16(a, PKF(bl0[ks], bh0[ks]), acc0, 0, 0, 0);
            acc1 = __builtin_amdgcn_mfma_f32_32x32x16_bf16(a, PKF(bl1[ks], bh1[ks]), acc1, 0, 0, 0); }
        if (j + 1 < NT) { asm volatile("s_waitcnt vmcnt(0)" ::: "memory"); SWRITE(buf ^ 1, 64 * (j + 1)); if (j + 2 < NT) SLOAD(64 * (j + 2)); }
        __syncthreads();
    }
#undef SLOAD
#undef SWRITE
#undef KW
    float* CS = (float*)(F.ws + WS_CSEG) + (size_t)(bh * NSEG + seg) * CSEG_STRIDE;
    const int r32 = lane & 31, hi = lane >> 5;
#pragma unroll
    for (int r = 0; r < 16; ++r) { const int d = 32 * db + crow(r, hi); CS[d * 128 + 32 * eb0 + r32] = acc0[r]; CS[d * 128 + 32 * (eb0 + 1) + r32] = acc1[r]; }
    float* nred = (float*)lds;
#pragma unroll
    for (int e = 0; e < 8; ++e) nred[sr * 128 + sc + e] = npart[e];
    __syncthreads();
    if (tid < 128) { float s = 0.f; for (int i = 0; i < 32; ++i) s += nred[i * 128 + tid]; CS[128 * 128 + tid] = s; }
    if (tid == 0) CS[128 * 128 + 128] = Lseg;
    asm volatile("s_waitcnt vmcnt(0)" ::: "memory"); __syncthreads();
    if (tid == 0) { __builtin_amdgcn_fence(__ATOMIC_RELEASE, "agent"); asm volatile("s_waitcnt vmcnt(0)" ::: "memory");
        __hip_atomic_fetch_add((unsigned*)(F.ctl + CW_SEGCNT + 64 * bh), 1u, __ATOMIC_RELAXED, __HIP_MEMORY_SCOPE_AGENT); }
    __syncthreads();
}

__device__ __forceinline__ void mlstm_unit(Frame& F, char* lds, int bh, int sj, int qi, bf16* BB) {
    const int tid = F.tid, wid = F.wave, lane = F.lane, r32 = lane & 31, hi = lane >> 5, b = bh >> 3, h = bh & 7;
    char* V_lds = lds; char* K_lds = lds + 2 * SHM_V;
    float* wsf = (float*)(lds + FL_WS) + wid * 64; float* li_l = wsf; float* al_l = wsf + 32;
    float* btab = (float*)(lds + FL_BTAB); float* ntab = (float*)(lds + FL_NTAB);
    const size_t segrow = (size_t)b * SEQ + (size_t)sj * SEGTOK;
    const int tl0 = qi * 256;
    const float* FCb = (const float*)(F.ws + WS_FCUM) + (size_t)bh * SEQ; const float* LIb = (const float*)(F.ws + WS_LIT) + (size_t)bh * SEQ;
    const float L = ((const float*)(F.ws + WS_LAM))[16 + bh];
    const float Fref = sj > 0 ? FCb[sj * SEGTOK - 1] : 0.f;
    const bf16* MQC = (const bf16*)((const unsigned char*)F.out + OUT_MQC);
    const bf16* Kh = (const bf16*)((const unsigned char*)F.out + OUT_MKC) + segrow * 1024 + h * 128; const bf16* Vh = (const bf16*)(F.ws + WS_MV) + segrow * 1024 + h * 128;
    const int trow = tl0 + wid * 32 + r32;
    const bf16* Qw = MQC + (segrow + trow) * 1024 + h * 128 + hi * 8;
    bf16x8 qr[8];
#pragma unroll
    for (int d0 = 0; d0 < 8; ++d0) qr[d0] = *reinterpret_cast<const bf16x8*>(Qw + d0 * 16);
    const float At = (FCb[sj * SEGTOK + trow] - Fref) * LOG2E;
    const int sr = tid >> 4, sc = (tid & 15) * 8, vst0 = v_st(sr, sc), vst1 = v_st(32 + sr, sc);
    const int vb0 = (int)(uintptr_t)V_lds + v_rd_base(lane);
    float l_reg = 0.f; f32x16 o[4] = {};
    if (sj > 0) {
        if (tid == 0) { unsigned sp = 0; while (__hip_atomic_load((unsigned*)(F.ctl + CW_SEGCNT + 64 * bh), __ATOMIC_RELAXED, __HIP_MEMORY_SCOPE_AGENT) < (unsigned)NSEG) { __builtin_amdgcn_s_sleep(2); if (++sp > (1u << 22)) break; }
            __builtin_amdgcn_fence(__ATOMIC_ACQUIRE, "agent"); asm volatile("s_waitcnt vmcnt(0)" ::: "memory"); }
        __syncthreads();
        const float* CS = (const float*)(F.ws + WS_CSEG) + (size_t)(bh * NSEG) * CSEG_STRIDE;
        f32x4 ca[4][2]; float ns = 0.f;
#pragma unroll
        for (int q = 0; q < 4; ++q) { ca[q][0] = (f32x4){0.f, 0.f, 0.f, 0.f}; ca[q][1] = (f32x4){0.f, 0.f, 0.f, 0.f}; }
#pragma unroll 1
        for (int i = 0; i < sj; ++i) { const float* Ci = CS + (size_t)i * CSEG_STRIDE; const float cf = __expf(Fref - FCb[(i + 1) * SEGTOK - 1] + Ci[128 * 128 + 128] - L);
#pragma unroll
            for (int q = 0; q < 4; ++q) { const float* p = Ci + (q * 32 + sr) * 128 + sc; ca[q][0] += cf * *(const f32x4*)p; ca[q][1] += cf * *(const f32x4*)(p + 4); }
            if (tid < 128) ns += cf * Ci[128 * 128 + tid]; }
#pragma unroll
        for (int q = 0; q < 4; ++q) { v4u w; w.x = cvtpk(ca[q][0][0], ca[q][0][1]); w.y = cvtpk(ca[q][0][2], ca[q][0][3]); w.z = cvtpk(ca[q][1][0], ca[q][1][1]); w.w = cvtpk(ca[q][1][2], ca[q][1][3]);
            *(v4u*)(V_lds + (q >> 1) * SHM_V + ((q & 1) ? vst1 : vst0)) = w; }
        if (tid < 128) ntab[tid] = ns;
        __syncthreads();
        pv_d0(o, vb0, qr[0], qr[1], qr[2], qr[3]);
        pv_d0(o, vb0 + SHM_V, qr[4], qr[5], qr[6], qr[7]);
        float dn = 0.f;
#pragma unroll
        for (int d0 = 0; d0 < 8; ++d0) { const v4u qq = __builtin_bit_cast(v4u, qr[d0]); const float* nt = ntab + d0 * 16 + hi * 8;
            dn += bflo(qq.x) * nt[0] + bfhi(qq.x) * nt[1] + bflo(qq.y) * nt[2] + bfhi(qq.y) * nt[3] + bflo(qq.z) * nt[4] + bfhi(qq.z) * nt[5] + bflo(qq.w) * nt[6] + bfhi(qq.w) * nt[7]; }
        dn = half_swap_sum(dn);
        const float rsc = __builtin_amdgcn_exp2f(At);
        l_reg = rsc * dn;
        if (hi == 0) al_l[r32] = rsc; asm volatile("s_waitcnt lgkmcnt(0)" ::: "memory");
#pragma unroll
        for (int d = 0; d < 4; ++d)
#pragma unroll
            for (int r = 0; r < 16; ++r) o[d][r] *= al_l[crow(r, hi)];
        __syncthreads();
    }
    v4u vs0, vs1, ks0, ks1; float bt = 0.f;
#define SLOAD(k0) do { vs0 = *(const v4u*)(&Vh[(size_t)((k0) + sr) * 1024 + sc]); vs1 = *(const v4u*)(&Vh[(size_t)((k0) + 32 + sr) * 1024 + sc]); \
    ks0 = *(const v4u*)(&Kh[(size_t)((k0) + sr) * 1024 + sc]); ks1 = *(const v4u*)(&Kh[(size_t)((k0) + 32 + sr) * 1024 + sc]); \
    if (tid < 64) { const int s_ = sj * SEGTOK + (k0) + tid; bt = (LIb[s_] - L - (FCb[s_] - Fref)) * LOG2E; } } while (0)
#define SWRITE(bb) do { *(v4u*)(V_lds + (bb) * SHM_V + vst0) = vs0; *(v4u*)(V_lds + (bb) * SHM_V + vst1) = vs1; const int kc = sc * 2; \
    *(v4u*)(K_lds + (bb) * SHM_K + KSWZ(sr, kc)) = ks0; *(v4u*)(K_lds + (bb) * SHM_K + KSWZ(32 + sr, kc)) = ks1; if (tid < 64) btab[(bb) * 64 + tid] = bt; } while (0)
    const int NT = 4 * qi + 4, qc = 4 * qi + (wid >> 1), trel = (wid * 32 + r32) & 63;
    SLOAD(0); asm volatile("s_waitcnt vmcnt(0)" ::: "memory"); SWRITE(0); SLOAD(64); __syncthreads();
    for (int j = 0; j < NT; ++j) {
        const int buf = j & 1;
        if (j <= qc) {
            f32x16 p0 = {}, p1 = {};
            const char* Ks = K_lds + buf * SHM_K;
#pragma unroll
            for (int d0 = 0; d0 < 8; ++d0) { const int cb = (d0 * 16 + hi * 8) * 2;
                const bf16x8 b0 = *reinterpret_cast<const bf16x8*>(Ks + KSWZ(r32, cb)), b1 = *reinterpret_cast<const bf16x8*>(Ks + KSWZ(32 + r32, cb));
                p0 = __builtin_amdgcn_mfma_f32_32x32x16_bf16(b0, qr[d0], p0, 0, 0, 0); p1 = __builtin_amdgcn_mfma_f32_32x32x16_bf16(b1, qr[d0], p1, 0, 0, 0); if (d0 == 3) SBAR(); }
            const float* bp = btab + buf * 64 + 4 * hi; float ps = 0.f; const bool diag = (j == qc);
#pragma unroll
            for (int r = 0; r < 16; ++r) { const int kk = (r & 3) + 8 * (r >> 2);
                float w0 = __builtin_amdgcn_exp2f(At + bp[kk]), w1 = __builtin_amdgcn_exp2f(At + bp[kk + 32]);
                if (diag) { if (kk + 4 * hi > trel) w0 = 0.f; if (kk + 32 + 4 * hi > trel) w1 = 0.f; }
                p0[r] *= w0; p1[r] *= w1; ps += p0[r] + p1[r]; }
            l_reg += half_swap_sum(ps);
            bf16x8 pa0, pa1, pa2, pa3; pack_p(p0, p1, pa0, pa1, pa2, pa3);
            SBAR();
            pv_d0(o, vb0 + buf * SHM_V, pa0, pa1, pa2, pa3);
        }
        if (j + 1 < NT) { asm volatile("s_waitcnt vmcnt(0)" ::: "memory"); SWRITE(buf ^ 1); if (j + 2 < NT) SLOAD(64 * (j + 2)); }
        __syncthreads();
    }
#undef SLOAD
#undef SWRITE
    const float den = fmaxf(fabsf(l_reg), __expf(-L));
    if (hi == 0) li_l[r32] = den; asm volatile("s_waitcnt lgkmcnt(0)" ::: "memory");
    const float* hn = F.in[8] + h * 128;
    float g[4];
#pragma unroll
    for (int d0 = 0; d0 < 4; ++d0) g[d0] = hn[d0 * 32 + r32];
    bf16* OT = (bf16*)lds;
#pragma unroll
    for (int r = 0; r < 16; ++r) { const float rd = __builtin_amdgcn_rcpf(li_l[crow(r, hi)]); float hv[4]; float s = 0.f;
#pragma unroll
        for (int d0 = 0; d0 < 4; ++d0) { hv[d0] = o[d0][r] * rd; s += hv[d0] * hv[d0]; }
        s = half_sum32(s); const float rs = 1.0f / sqrtf(s * (1.0f / 128.0f) + EPS);
#pragma unroll
        for (int d0 = 0; d0 < 4; ++d0) OT[(wid * 32 + crow(r, hi)) * 128 + d0 * 32 + r32] = (bf16)f2bf(hv[d0] * rs * g[d0]); }
    __syncthreads();
    const bf16* MO = (const bf16*)(F.ws + WS_MO);
    v4u mq[8];
#pragma unroll
    for (int i = 0; i < 8; ++i) { const int p = tid + 512 * i, row = p >> 4, ch = p & 15; mq[i] = *(const v4u*)(MO + (segrow + tl0 + row) * 1024 + h * 128 + ch * 8); }
#pragma unroll
    for (int i = 0; i < 8; ++i) { const int p = tid + 512 * i, row = p >> 4, ch = p & 15; const size_t goff = (segrow + tl0 + row) * 1024 + h * 128 + ch * 8;
        const v4u a = *(const v4u*)(lds + row * 256 + ch * 16), m = mq[i]; v4u w;
        w.x = cvtpk(bflo(a.x) * bflo(m.x), bfhi(a.x) * bfhi(m.x)); w.y = cvtpk(bflo(a.y) * bflo(m.y), bfhi(a.y) * bfhi(m.y));
        w.z = cvtpk(bflo(a.z) * bflo(m.z), bfhi(a.z) * bfhi(m.z)); w.w = cvtpk(bflo(a.w) * bflo(m.w), bfhi(a.w) * bfhi(m.w));
        *(v4u*)(BB + goff) = w; }
    __syncthreads();
}

__device__ __forceinline__ unsigned fkey(float f) { const unsigned u = __float_as_uint(f); return (u & 0x80000000u) ? ~u : (u | 0x80000000u); }
__device__ __forceinline__ float funkey(unsigned k) { const unsigned u = (k & 0x80000000u) ? (k & 0x7fffffffu) : ~k; return __uint_as_float(u); }
#define CE(a, b) do { const unsigned h_ = max(a, b), l_ = min(a, b); a = h_; b = l_; } while (0)
#define SORT16(X) do { CE(X[0], X[1]); CE(X[2], X[3]); CE(X[0], X[2]); CE(X[1], X[3]); CE(X[1], X[2]); CE(X[4], X[5]); CE(X[6], X[7]); CE(X[4], X[6]); CE(X[5], X[7]); CE(X[5], X[6]); CE(X[0], X[4]); CE(X[2], X[6]); CE(X[2], X[4]); CE(X[1], X[5]); CE(X[3], X[7]); CE(X[3], X[5]); CE(X[1], X[2]); CE(X[3], X[4]); CE(X[5], X[6]); CE(X[8], X[9]); CE(X[10], X[11]); CE(X[8], X[10]); CE(X[9], X[11]); CE(X[9], X[10]); CE(X[12], X[13]); CE(X[14], X[15]); CE(X[12], X[14]); CE(X[13], X[15]); CE(X[13], X[14]); CE(X[8], X[12]); CE(X[10], X[14]); CE(X[10], X[12]); CE(X[9], X[13]); CE(X[11], X[15]); CE(X[11], X[13]); CE(X[9], X[10]); CE(X[11], X[12]); CE(X[13], X[14]); CE(X[0], X[8]); CE(X[4], X[12]); CE(X[4], X[8]); CE(X[2], X[10]); CE(X[6], X[14]); CE(X[6], X[10]); CE(X[2], X[4]); CE(X[6], X[8]); CE(X[10], X[12]); CE(X[1], X[9]); CE(X[5], X[13]); CE(X[5], X[9]); CE(X[3], X[11]); CE(X[7], X[15]); CE(X[7], X[11]); CE(X[3], X[5]); CE(X[7], X[9]); CE(X[11], X[13]); CE(X[1], X[2]); CE(X[3], X[4]); CE(X[5], X[6]); CE(X[7], X[8]); CE(X[9], X[10]); CE(X[11], X[12]); CE(X[13], X[14]); } while (0)
#define MERGE16(L, N) do { L[0] = max(L[0], N[15]); L[1] = max(L[1], N[14]); L[2] = max(L[2], N[13]); L[3] = max(L[3], N[12]); L[4] = max(L[4], N[11]); L[5] = max(L[5], N[10]); L[6] = max(L[6], N[9]); L[7] = max(L[7], N[8]); L[8] = max(L[8], N[7]); L[9] = max(L[9], N[6]); L[10] = max(L[10], N[5]); L[11] = max(L[11], N[4]); L[12] = max(L[12], N[3]); L[13] = max(L[13], N[2]); L[14] = max(L[14], N[1]); L[15] = max(L[15], N[0]); CE(L[0], L[8]); CE(L[1], L[9]); CE(L[2], L[10]); CE(L[3], L[11]); CE(L[4], L[12]); CE(L[5], L[13]); CE(L[6], L[14]); CE(L[7], L[15]); CE(L[0], L[4]); CE(L[1], L[5]); CE(L[2], L[6]); CE(L[3], L[7]); CE(L[8], L[12]); CE(L[9], L[13]); CE(L[10], L[14]); CE(L[11], L[15]); CE(L[0], L[2]); CE(L[1], L[3]); CE(L[4], L[6]); CE(L[5], L[7]); CE(L[8], L[10]); CE(L[9], L[11]); CE(L[12], L[14]); CE(L[13], L[15]); CE(L[0], L[1]); CE(L[2], L[3]); CE(L[4], L[5]); CE(L[6], L[7]); CE(L[8], L[9]); CE(L[10], L[11]); CE(L[12], L[13]); CE(L[14], L[15]); } while (0)
#define TK_MERGE(L) do { unsigned N[16]; _Pragma("unroll") for (int j_ = 0; j_ < 16; ++j_) { auto rr_ = __builtin_amdgcn_permlane32_swap(L[j_], L[j_], false, false); L[j_] = rr_[0]; N[j_] = rr_[1]; } MERGE16(L, N); } while (0)
typedef __bf16 bf16x2_t __attribute__((ext_vector_type(2)));
__device__ __forceinline__ float dot2bf(unsigned a, unsigned b, float c) { return __builtin_amdgcn_fdot2_f32_bf16(__builtin_bit_cast(bf16x2_t, a), __builtin_bit_cast(bf16x2_t, b), c, false); }

__device__ __forceinline__ void route_unit(Frame& F, char* lds, int t0, int hh) {
    const int lane = F.lane, r32 = lane & 31, hi = lane >> 5, wid = F.wave;
    const bf16* QP = (const bf16*)(F.ws + WS_QP); const bf16* SK = (const bf16*)(F.ws + WS_SK);
    int* IDX = (int*)(F.ws + WS_IDX); float* GATE = (float*)(F.ws + WS_GATE);
    float fa[16], fb[16];
    int* tab = (int*)(lds) + (wid * 64 + lane) * 33;
#pragma unroll
    for (int c = 0; c < 2; ++c) {
        unsigned L[16];
#pragma unroll
        for (int j = 0; j < 16; ++j) L[j] = 0u;
        const bf16* qrow = QP + (size_t)(t0 + r32) * 2048 + hh * 256 + c * 128 + hi * 8;
        bf16x8 qf[8];
#pragma unroll
        for (int ks = 0; ks < 8; ++ks) qf[ks] = *reinterpret_cast<const bf16x8*>(qrow + ks * 16);
        const bf16* skb = SK + (size_t)((hh * 2 + c) * 128 + r32) * 128 + hi * 8;
        const unsigned nbase = 127u - 4u * (unsigned)hi;
        bf16x8 an[8];
        { const bf16* sp = skb; asm volatile("" : "+v"(sp));
#pragma unroll
          for (int ks = 0; ks < 8; ++ks) an[ks] = *reinterpret_cast<const bf16x8*>(sp + ks * 16); }
#pragma unroll
        for (int nb = 0; nb < 4; ++nb) { f32x16 acc = {};
#pragma unroll
            for (int ks = 0; ks < 8; ++ks) acc = __builtin_amdgcn_mfma_f32_32x32x16_bf16(an[ks], qf[ks], acc, 0, 0, 0);
            if (nb < 3) { const bf16* sp = skb + (size_t)(nb + 1) * 32 * 128; asm volatile("" : "+v"(sp));
#pragma unroll
                for (int ks = 0; ks < 8; ++ks) an[ks] = *reinterpret_cast<const bf16x8*>(sp + ks * 16); }
            { unsigned X[16];
#pragma unroll
              for (int r = 0; r < 16; ++r) X[r] = (fkey(acc[r]) & ~127u) | (nbase - (unsigned)(32 * nb + (r & 3) + 8 * (r >> 2)));
              SORT16(X); if (nb == 0) {
#pragma unroll
                  for (int r = 0; r < 16; ++r) L[r] = X[r]; } else { unsigned* N = X; MERGE16(L, N); } }
            SBAR(); }
        TK_MERGE(L);
#pragma unroll
        for (int j = 0; j < 16; ++j) { const float f = funkey(L[j] & ~127u); if (c == 0) fa[j] = f; else fb[j] = f; tab[16 * c + j] = 127 - (int)(L[j] & 127u); }
        SBAR();
    }
    unsigned C[16];
    {
        unsigned K2[16]; float pa_ = 0.f, pb_ = 0.f; int pf_ = 0; int cnt = 0;
#pragma unroll
        for (int j = 0; j < 16; ++j) K2[j] = 0u;
#pragma unroll
        for (int i = 0; i < 16; ++i)
#pragma unroll
            for (int j = 0; j < 16; ++j) if ((i + 1) * (j + 1) <= 16) {
                if ((cnt & 1) == 0) { pa_ = fa[i]; pb_ = fb[j]; pf_ = i * 16 + j; }
                else { const float s = hi ? fa[i] + fb[j] : pa_ + pb_; const int fl = hi ? i * 16 + j : pf_; const unsigned key = (fkey(s) & ~255u) | (unsigned)(255 - fl); const int q = cnt >> 1; if (q < 16) C[q] = key; else K2[q - 16] = key; }
                ++cnt; }
        { unsigned* X = C; SORT16(X); } { unsigned* X = K2; SORT16(X); }
        { unsigned* L = C; unsigned* N = K2; MERGE16(L, N); }
    }
    { unsigned* L = C; TK_MERGE(L); }
    asm volatile("s_waitcnt lgkmcnt(0)" ::: "memory");
    const float vmax = funkey(C[0] & ~255u); float ev[16]; float es = 0.f;
#pragma unroll
    for (int k = 0; k < 16; ++k) { ev[k] = __expf(funkey(C[k] & ~255u) - vmax); es += ev[k]; }
    const float ri = 1.0f / es;
    const size_t ob = (size_t)(t0 + r32) * 128 + hh * 16;
    int* dstp = hi ? (int*)GATE + ob : IDX + ob; int w[16];
#pragma unroll
    for (int k = 0; k < 16; ++k) { const int fl = 255 - (int)(C[k] & 255u); const int e = tab[fl >> 4] * 128 + tab[16 + (fl & 15)]; w[k] = hi ? (int)__float_as_uint(ev[k] * ri) : e; }
#pragma unroll
    for (int q = 0; q < 4; ++q) { typedef int i32x4 __attribute__((ext_vector_type(4))); *(i32x4*)(dstp + 4 * q) = (i32x4){w[4 * q], w[4 * q + 1], w[4 * q + 2], w[4 * q + 3]}; }
    asm volatile("s_waitcnt lgkmcnt(0)" ::: "memory");
}

__device__ __forceinline__ float gelu_tanh(float x) { const float z = 0.7978845608028654f * (x + 0.044715f * x * x * x); return x * __builtin_amdgcn_rcpf(1.0f + __builtin_amdgcn_exp2f(-2.0f * LOG2E * z)); }
constexpr float USCALE = 64.0f, VSCALE = 2.7f;
constexpr int ROW6 = DM * 6 / 8;
typedef __bf16 bf16x32_t __attribute__((ext_vector_type(32)));
typedef unsigned u32x6 __attribute__((ext_vector_type(6)));
typedef unsigned u32x3 __attribute__((ext_vector_type(3)));
typedef unsigned u32x16 __attribute__((ext_vector_type(16)));
__device__ __forceinline__ u32x16 fp6row6(unsigned a, unsigned b, unsigned c, unsigned d, unsigned e, unsigned f) { const u32x6 p = {a, b, c, d, e, f}; return __builtin_bit_cast(u32x16, __builtin_amdgcn_cvt_scalef32_pk32_bf16_fp6(p, 1.0f)); }
__device__ __forceinline__ u32x16 fp6row_to_bf16(u32x3 a, u32x3 b) { const u32x6 p = {a[0], a[1], a[2], b[0], b[1], b[2]}; return __builtin_bit_cast(u32x16, __builtin_amdgcn_cvt_scalef32_pk32_bf16_fp6(p, 1.0f)); }
typedef int i32x8 __attribute__((ext_vector_type(8)));
constexpr int P4_ROW = 128;
constexpr size_t SLICE_TAB4 = (size_t)NEXP * P4_ROW;
constexpr int PW_BYTES = 16384, PM_OFF = 12288, PRING = 12;
constexpr int ACT_STRIDE = 144;
constexpr float XS8 = 16.0f;
#ifndef FP4_SPLIT
#define FP4_SPLIT 0
#endif
#define PDMA(voff, sbase, ldsdst, imm) asm volatile("s_add_u32 m0, %2, %3\n\ts_nop 0\n\tglobal_load_lds_dwordx4 %0, %1" : : "v"(voff), "s"(sbase), "s"(ldsdst), "i"(imm) : "memory", "scc")
#define PWAIT(n) asm volatile("s_waitcnt vmcnt(" #n ")" ::: "memory")
#define PEER_SETUP() \
    const int lane = F.lane, m = lane & 15, g = lane >> 4; \
    const int members_ = F.G / 8, sl = F.vcu / members_, mem_ = F.vcu % members_, tstep = members_ * NWAVES, t0 = mem_ * NWAVES + F.wave, NTOK = (T - t0 + tstep - 1) / tstep, tl = t0 + (NTOK - 1) * tstep; \
    LAS unsigned char* W = F.lds + F.wave * PW_BYTES; \
    const unsigned ldsW = (unsigned)__builtin_amdgcn_readfirstlane((int)(unsigned)(uintptr_t)W); \
    const unsigned char* wsb = F.ws;
#define TOKC(nn) min(t0 + (nn) * tstep, tl)
#define META(tt, mb) do { const unsigned vo_ = mbase + (unsigned)(tt) * mstride; const unsigned ld_ = (unsigned)__builtin_amdgcn_readfirstlane((int)(ldsW + (unsigned)(PM_OFF + 1024 * (mb)))); PDMA(vo_, wsb, ld_, 0); } while (0)

__device__ __forceinline__ void peer_udots(Frame& F) {
    PEER_SETUP()
    bf16* PART = (bf16*)(F.ws + WS_PART);
    const unsigned char* tabs = F.ws + WS_UB + (size_t)sl * SLICE_TAB4;
    const unsigned r8 = lane >> 3, p8 = lane & 7;
    const unsigned co0 = 16u * (p8 ^ ((r8 >> 1) & 7)), co1 = 16u * (p8 ^ (((r8 + 8) >> 1) & 7));
    unsigned mbase, mstride;
    if (lane < 16) { mbase = (unsigned)WS_X8 + 256u * sl + 16u * lane; mstride = (unsigned)DM; } else { mbase = (unsigned)WS_IDX + 16u * (lane < 48 ? lane - 16 : 0); mstride = 512u; }
#define UDMA(mb, ui, su) do { const LAS unsigned char* ip_ = W + PM_OFF + 1024 * (mb) + 256 + 64 * (ui) + 4 * r8; const unsigned e0_ = *(const LAS unsigned*)ip_, e1_ = *(const LAS unsigned*)(ip_ + 32); \
        const unsigned ld_ = (unsigned)__builtin_amdgcn_readfirstlane((int)(ldsW + 2048u * (unsigned)(su))); \
        const unsigned v0_ = e0_ * (unsigned)P4_ROW + co0, v1_ = e1_ * (unsigned)P4_ROW + co1; PDMA(v0_, tabs, ld_, 0); PDMA(v1_, tabs, ld_, 1024); } while (0)
    META(TOKC(0), 0); META(TOKC(1), 1); PWAIT(0);
    int si = 0;
#pragma unroll
    for (int r = 0; r < 5; ++r) { UDMA(0, r, si); ++si; }
    int mb0 = 0, mb1 = 1, mb2 = 2, sc = 0;
#pragma unroll 1
    for (int n = 0; n < NTOK; ++n) {
        const int t = t0 + n * tstep;
        i32x8 xb[2]; f32x4 acc[8];
#pragma unroll
        for (int r = 0; r < 8; ++r) {
            if (r == 4) META(TOKC(n + 2), mb2);
            if (r < 3) UDMA(mb0, r + 5, si); else UDMA(mb1, r - 3, si);
            si = si == 5 ? 0 : si + 1;
            if (r >= 4) PWAIT(11); else PWAIT(10);
            if (r == 0) {
#pragma unroll
                for (int h = 0; h < 2; ++h) { const LAS unsigned char* xp_ = W + PM_OFF + 1024 * mb0 + 128 * h + (FP4_SPLIT ? 32 * g : 16 * g); const v4u a0 = *(const LAS v4u*)xp_, a1 = *(const LAS v4u*)(xp_ + (FP4_SPLIT ? 16 : 64));
                    xb[h] = (i32x8){(int)a0[0], (int)a0[1], (int)a0[2], (int)a0[3], (int)a1[0], (int)a1[1], (int)a1[2], (int)a1[3]}; } }
            f32x4 c = {0.f, 0.f, 0.f, 0.f};
#pragma unroll
            for (int h = 0; h < 2; ++h) { const v4u a0 = *(const LAS v4u*)(W + 2048 * sc + m * P4_ROW + 16 * ((4 * h + g) ^ ((m >> 1) & 7)));
                const i32x8 a = {(int)a0[0], (int)a0[1], (int)a0[2], (int)a0[3], 0, 0, 0, 0};
                c = __builtin_amdgcn_mfma_scale_f32_16x16x128_f8f6f4(a, xb[h], c, 4, 0, 0, 127, 0, 127); }
            acc[r] = c;
            sc = sc == 5 ? 0 : sc + 1;
        }
        f32x4 v = acc[0];
#pragma unroll
        for (int b = 1; b < 8; ++b) { const bool s_ = (m & 7) == b; v[0] = s_ ? acc[b][0] : v[0]; v[1] = s_ ? acc[b][1] : v[1]; v[2] = s_ ? acc[b][2] : v[2]; v[3] = s_ ? acc[b][3] : v[3]; }
        asm volatile("" : "+v"(v[0]), "+v"(v[1]), "+v"(v[2]), "+v"(v[3]));
        if (m < 8) *(u32x2*)(PART + ((size_t)sl * T + t) * 128 + 16 * m + 4 * g) = (u32x2){cvtpk(v[0], v[1]), cvtpk(v[2], v[3])};
        { const int o_ = mb0; mb0 = mb1; mb1 = mb2; mb2 = o_; }
    }
    PWAIT(0);
#undef UDMA
}
__device__ __forceinline__ void peer_act(Frame& F) {
    const int gw = F.vcu * NWAVES + F.wave, NGW = F.G * NWAVES, lane = F.lane;
    const unsigned* PART2 = (const unsigned*)(F.ws + WS_PART); const float* GATEA = (const float*)(F.ws + WS_GATE); unsigned char* ACT8 = (unsigned char*)(F.ws + WS_ACT);
    const int* IDXA = (const int*)(F.ws + WS_IDX); const float* SCU = (const float*)(F.ws + WS_SCU); const float* SCV = (const float*)(F.ws + WS_SCV); const float* SSQ = (const float*)(F.ws + WS_SSQ);
    for (int t = gw; t < T; t += NGW) {
        unsigned pw[8];
#pragma unroll
        for (int j = 0; j < 8; ++j) pw[j] = PART2[((size_t)j * T + t) * 64 + lane];
        const u32x2 ev = *(const u32x2*)(IDXA + (size_t)t * 128 + 2 * lane); const u32x2 gv = *(const u32x2*)(GATEA + (size_t)t * 128 + 2 * lane);
        float a0 = 0.f, a1 = 0.f;
#pragma unroll
        for (int j = 0; j < 8; ++j) { a0 += bflo(pw[j]); a1 += bfhi(pw[j]); }
        const float su0 = SCU[ev[0]], su1 = SCU[ev[1]], sv0 = SCV[ev[0]], sv1 = SCV[ev[1]];
        float v[2]; v[0] = gelu_tanh(a0 * su0 * (1.0f / XS8)) * __uint_as_float(gv[0]) * sv0; v[1] = gelu_tanh(a1 * su1 * (1.0f / XS8)) * __uint_as_float(gv[1]) * sv1;
        float am = fmaxf(fabsf(v[0]), fabsf(v[1]));
#pragma unroll
        for (int o = 1; o < 64; o <<= 1) am = fmaxf(am, __shfl_xor(am, o));
        const float ts = am > 0.f ? 224.0f / am : 1.0f;
#pragma unroll
        for (int hk = 0; hk < 2; ++hk) { const int k = 2 * lane + hk, r = k & 7, j = k >> 3, gg = r & 3, ga = 2 * (gg & 1) + (r >> 2), half = gg >> 1;
            const int p = __builtin_amdgcn_cvt_pk_fp8_f32(v[hk] * ts, 0.f, 0, false);
            ACT8[(size_t)t * ACT_STRIDE + 32 * ga + 2 * j + half] = (unsigned char)(p & 255); }
        if (lane == 0) *(float*)(ACT8 + (size_t)t * ACT_STRIDE + 128) = 1.0f / ts;
    }
}
__device__ __forceinline__ void peer_vacc(Frame& F) {
    PEER_SETUP()
    bf16* Y = (bf16*)(F.ws + WS_Y);
    const unsigned char* tabs = F.ws + WS_VB6 + (size_t)sl * SLICE_TAB4;
    const unsigned r8 = lane >> 3, co = 16u * (lane & 7);
    unsigned mbase, mstride;
    if (lane < 9) { mbase = (unsigned)WS_ACT + 16u * lane; mstride = (unsigned)ACT_STRIDE; } else { mbase = (unsigned)WS_IDX + 16u * ((lane >= 16 && lane < 48) ? lane - 16 : 0); mstride = 512u; }
    const int sh = 8 * (m & 3), mq = m >> 2;
#define VDMA(mb, ui, su) do { const unsigned e_ = *(const LAS unsigned*)(W + PM_OFF + 1024 * (mb) + 256 + 32 * (ui) + 4 * r8); \
        const unsigned ld_ = (unsigned)__builtin_amdgcn_readfirstlane((int)(ldsW + 1024u * (unsigned)(su))); const unsigned v_ = e_ * (unsigned)P4_ROW + co; PDMA(v_, tabs, ld_, 0); } while (0)
    META(TOKC(0), 0); META(TOKC(1), 1); PWAIT(0);
    int si = 0;
#pragma unroll
    for (int r = 0; r < 11; ++r) { VDMA(0, r, si); ++si; }
    int mb0 = 0, mb1 = 1, mb2 = 2, sc = 0;
#pragma unroll 1
    for (int n = 0; n < NTOK; ++n) {
        const int t = t0 + n * tstep;
        f32x4 d = {0.f, 0.f, 0.f, 0.f};
#pragma unroll
        for (int r = 0; r < 16; ++r) {
            if (r == 4) META(TOKC(n + 2), mb2);
            if (r < 5) VDMA(mb0, r + 11, si); else VDMA(mb1, r - 5, si);
            si = si == PRING - 1 ? 0 : si + 1;
            if (r >= 4 && r <= 14) PWAIT(12); else PWAIT(11);
            const LAS unsigned char* r0 = W + 1024 * sc + (FP4_SPLIT ? 2 * g : g) * P4_ROW + 8 * m;
            const u32x2 b0 = *(const LAS u32x2*)r0, b1 = *(const LAS u32x2*)(r0 + (FP4_SPLIT ? 1 : 4) * P4_ROW);
            const i32x8 b = {(int)b0[0], (int)b0[1], (int)b1[0], (int)b1[1], 0, 0, 0, 0};
            const unsigned pair = *(const LAS unsigned short*)(W + PM_OFF + 1024 * mb0 + 32 * g + 2 * r);
            const int lo = (int)((pair & 255u) << sh), hi = (int)((pair >> 8) << sh);
            const i32x8 a = {mq == 0 ? lo : 0, mq == 1 ? lo : 0, mq == 2 ? lo : 0, mq == 3 ? lo : 0, mq == 0 ? hi : 0, mq == 1 ? hi : 0, mq == 2 ? hi : 0, mq == 3 ? hi : 0};
            d = __builtin_amdgcn_mfma_scale_f32_16x16x128_f8f6f4(a, b, d, 0, 4, 0, 127, 0, 127);
            sc = sc == PRING - 1 ? 0 : sc + 1;
        }
        const float inv = *(const LAS float*)(W + PM_OFF + 1024 * mb0 + 128);
        *(u32x2*)(Y + (size_t)t * DM + 256 * sl + 16 * m + 4 * g) = (u32x2){cvtpk(d[0] * inv, d[1] * inv), cvtpk(d[2] * inv, d[3] * inv)};
        { const int o_ = mb0; mb0 = mb1; mb1 = mb2; mb2 = o_; }
    }
    PWAIT(0);
#undef VDMA
}
#undef META
#undef TOKC
#undef PEER_SETUP

__device__ __forceinline__ void peer_final(Frame& F) {
    const int gw = F.vcu * NWAVES + F.wave, NGW = F.G * NWAVES, lane = F.lane;
    const bf16* Y = (const bf16*)(F.ws + WS_Y); const bf16* X1B = (const bf16*)(F.ws + WS_X1B); const float* norm_final = F.in[17];
    f32x4 gv[8];
#pragma unroll
    for (int q = 0; q < 4; ++q) { gv[2 * q] = *(const f32x4*)(norm_final + 8 * lane + 512 * q); gv[2 * q + 1] = *(const f32x4*)(norm_final + 8 * lane + 512 * q + 4); }
    for (int t = gw; t < T; t += NGW) {
        v4u xa[4], ya[4]; f32x4 v[8]; float ss = 0.f;
#pragma unroll
        for (int q = 0; q < 4; ++q) { xa[q] = *(const v4u*)(X1B + (size_t)t * DM + 8 * lane + 512 * q); ya[q] = *(const v4u*)(Y + (size_t)t * DM + 8 * lane + 512 * q); }
#pragma unroll
        for (int q = 0; q < 4; ++q) {
            v[2 * q] = (f32x4){bflo(xa[q][0]) + bflo(ya[q][0]), bfhi(xa[q][0]) + bfhi(ya[q][0]), bflo(xa[q][1]) + bflo(ya[q][1]), bfhi(xa[q][1]) + bfhi(ya[q][1])};
            v[2 * q + 1] = (f32x4){bflo(xa[q][2]) + bflo(ya[q][2]), bfhi(xa[q][2]) + bfhi(ya[q][2]), bflo(xa[q][3]) + bflo(ya[q][3]), bfhi(xa[q][3]) + bfhi(ya[q][3])}; }
#pragma unroll
        for (int q = 0; q < 8; ++q) ss += (v[q][0] * v[q][0] + v[q][1] * v[q][1]) + (v[q][2] * v[q][2] + v[q][3] * v[q][3]);
        ss = wave_sum(ss);
        const float rf = 1.0f / sqrtf(ss * (1.0f / DM) + EPS);
        float* orow = F.out + (size_t)t * DM + 8 * lane;
#pragma unroll
        for (int q = 0; q < 4; ++q) { *(f32x4*)(orow + 512 * q) = v[2 * q] * rf * gv[2 * q]; *(f32x4*)(orow + 512 * q + 4) = v[2 * q + 1] * rf * gv[2 * q + 1]; }
    }
}

__device__ __forceinline__ unsigned e2m1_code(float x) {
    const float a = fabsf(x); const unsigned c = (unsigned)(a >= 0.25f) + (unsigned)(a >= 0.75f) + (unsigned)(a >= 1.25f) + (unsigned)(a >= 1.75f) + (unsigned)(a >= 2.5f) + (unsigned)(a >= 3.5f) + (unsigned)(a >= 5.0f);
    return c | (x < 0.f ? 8u : 0u); }
__device__ __forceinline__ void p5_expert_cvt(Frame& F) {
    const int gw = F.vcu * NWAVES + F.wave, NGW = F.G * NWAVES, lane = F.lane;
    const float* eu = F.in[15]; const float* ev = F.in[16]; const float* g = F.in[12];
    unsigned char* UB = (unsigned char*)(F.ws + WS_UB); unsigned char* VB = (unsigned char*)(F.ws + WS_VB6); float* SCU = (float*)(F.ws + WS_SCU); float* SCV = (float*)(F.ws + WS_SCV);
    LAS float* row = (LAS float*)(F.lds + RING_OFF + F.wave * 8192);
    f32x4 gv[8];
#pragma unroll
    for (int j = 0; j < 8; ++j) gv[j] = *(const f32x4*)(g + 4 * lane + 256 * j);
    for (int r = gw; r < 2 * NEXP; r += NGW) {
        const bool isv = r >= NEXP; const int e = isv ? r - NEXP : r;
        const GAS f32x4* src = (const GAS f32x4*)((isv ? ev : eu) + (size_t)e * DM) + lane;
        f32x4 v[8]; float ss = 0.f;
#pragma unroll
        for (int j = 0; j < 8; ++j) v[j] = src[64 * j];
#pragma unroll
        for (int j = 0; j < 8; ++j) { if (!isv) v[j] = v[j] * gv[j]; ss += (v[j][0] * v[j][0] + v[j][1] * v[j][1]) + (v[j][2] * v[j][2] + v[j][3] * v[j][3]); }
        ss = wave_sum(ss);
        const float sc = 0.5f * sqrtf(ss * (1.0f / DM)) + 1e-30f, isc = 1.0f / sc;
        if (lane == 0) (isv ? SCV : SCU)[e] = sc;
#pragma unroll
        for (int j = 0; j < 8; ++j) *(LAS f32x4*)(row + 4 * (lane + 64 * j)) = v[j] * isc;
        LDS_WAIT(); asm volatile("" ::: "memory");
        v4u w;
#pragma unroll
        for (int q = 0; q < 4; ++q) { const f32x4 a = *(const LAS f32x4*)(row + 32 * lane + 8 * q), b = *(const LAS f32x4*)(row + 32 * lane + 8 * q + 4);
            w[q] = e2m1_code(a[0]) | (e2m1_code(a[1]) << 4) | (e2m1_code(a[2]) << 8) | (e2m1_code(a[3]) << 12) | (e2m1_code(b[0]) << 16) | (e2m1_code(b[1]) << 20) | (e2m1_code(b[2]) << 24) | (e2m1_code(b[3]) << 28); }
        LDS_WAIT(); asm volatile("" ::: "memory");
        *(v4u*)((isv ? VB : UB) + (size_t)(lane >> 3) * SLICE_TAB4 + (size_t)e * P4_ROW + 16 * (lane & 7)) = w;
    }
}

__device__ __forceinline__ void p7_xquant(Frame& F) {
    const int gw = F.vcu * NWAVES + F.wave, NGW = F.G * NWAVES, lane = F.lane;
    const float* SSQ = (const float*)(F.ws + WS_SSQ); const bf16* X1B = (const bf16*)(F.ws + WS_X1B); unsigned char* X8 = (unsigned char*)(F.ws + WS_X8);
    for (int t = gw; t < T; t += NGW) {
        float ss = lane < 32 ? SSQ[(size_t)t * 32 + lane] : 0.f; ss = wave_sum(ss);
        const float sc = (1.0f / sqrtf(ss * (1.0f / DM) + EPS)) * XS8;
        const bf16* xs = X1B + (size_t)t * DM + 32 * lane; v4u o[2];
#pragma unroll
        for (int q = 0; q < 4; ++q) { const v4u a = *(const v4u*)(xs + 8 * q);
#pragma unroll
            for (int d = 0; d < 2; ++d) { const float f0 = fminf(fmaxf(bflo(a[2 * d]) * sc, -440.f), 440.f), f1 = fminf(fmaxf(bfhi(a[2 * d]) * sc, -440.f), 440.f), f2 = fminf(fmaxf(bflo(a[2 * d + 1]) * sc, -440.f), 440.f), f3 = fminf(fmaxf(bfhi(a[2 * d + 1]) * sc, -440.f), 440.f);
                int p = __builtin_amdgcn_cvt_pk_fp8_f32(f0, f1, 0, false); p = __builtin_amdgcn_cvt_pk_fp8_f32(f2, f3, p, true); o[q >> 1][2 * (q & 1) + d] = (unsigned)p; } }
        *(v4u*)(X8 + (size_t)t * DM + 32 * lane) = o[0]; *(v4u*)(X8 + (size_t)t * DM + 32 * lane + 16) = o[1];
    }
}

#ifndef MK_PER_PHASE
#define MK_PER_PHASE 0
#endif
constexpr int N_PHASES = 12;
struct Args { const float* in[18]; float* out; unsigned char* ws; int ph_lo, ph_hi; };
__global__ void __launch_bounds__(NWAVES * 64, 2) fwd_kernel(Args args) {
    extern __shared__ __attribute__((aligned(16))) unsigned char lds[];
    Frame F;
    F.lds = (LAS unsigned char*)lds;
    F.MISC = (volatile LAS unsigned*)(F.lds + MISC_OFF);
    F.wave = __builtin_amdgcn_readfirstlane((int)(threadIdx.x >> 6)); F.lane = (int)__builtin_amdgcn_mbcnt_hi(~0u, __builtin_amdgcn_mbcnt_lo(~0u, 0u)); F.tid = F.wave * 64 + F.lane;
    F.G = gridDim.x; { const int bx = blockIdx.x; F.vcu = (F.G % 8 == 0) ? (bx % 8) * (F.G / 8) + bx / 8 : bx; }
    F.ws = args.ws; F.ctl = (gu32*)(args.ws + WS_CTL); F.out = args.out;
    F.in = (const float* const*)__builtin_amdgcn_kernarg_segment_ptr();
    for (int u = F.tid; u < (LDS_BYTES - LDSCTL_OFF) / 4; u += NWAVES * 64) ((LAS unsigned*)(F.lds + LDSCTL_OFF))[u] = 0u;
    __syncthreads();
    XcdBarrier bar; bar.bar = (unsigned*)(F.ctl + CW_BAR); bar.x = 0; bar.st = nullptr; bar.w0 = F.wave == 0;
    if (!MK_PER_PHASE) bar = xcd_barrier_post((unsigned*)(F.ctl + CW_BAR), F.MISC + 8, F.wave);
    const int lo = args.ph_lo, hi = args.ph_hi;
#define IN(k) (lo <= (k) && (k) < hi)
    char* gl = (char*)lds + RING_OFF;
#define REFRESH() do { int l_ = (int)__builtin_amdgcn_mbcnt_hi(~0u, __builtin_amdgcn_mbcnt_lo(~0u, 0u)); asm volatile("" : "+v"(l_)); F.lane = l_; F.tid = F.wave * 64 + l_; } while (0)
#define PH0 if (IN(0)) { p0_prep(F); }
#define PH1 if (IN(1)) { \
        if (F.vcu & 1) p1_ifgates(F); \
        { pg8::Gemm g{(const bf16*)F.out, (const bf16*)(F.ws + WS_WIN), T, NPROJ - NSENS, DM / 2}; pg8::StaticOrder S; S.init(T, NPROJ - NSENS, F.G, (int)blockIdx.x); \
          pg8::EpiProj E{(bf16*)(F.ws + WS_QA), SEG_STRIDE / 2, (bf16*)(F.ws + WS_GATES), nullptr, 1.0f / WIN_SCALE, 0.125f * LOG2E, NSENS / 256, nullptr}; \
          pg8::gemm_phase<pg8::EpiProj, pg8::StaticOrder, true, true, true>(F.lds + RING_OFF, g, S, E, F.wave); } \
        }
  \
#define PH2 if (IN(2)) { \
          \
        if (F.vcu & 1) { p2_conv_scan(F); __syncthreads(); } \
        { pg8::Gemm g{(const bf16*)(F.ws + WS_XB), (const bf16*)(F.ws + WS_WINB), T, NSENS, DM}; pg8::StaticOrder S; S.init(T, NSENS, F.G, (int)blockIdx.x); \
          pg8::EpiProj E{(bf16*)(F.ws + WS_QA), SEG_STRIDE / 2, (bf16*)(F.ws + WS_GATES), (const float*)(F.ws + WS_RSTD1), 1.0f, 0.125f * LOG2E, 0, (unsigned*)(F.ctl + CW_KMAX)}; \
          pg8::gemm_phase<pg8::EpiProj, pg8::StaticOrder, true, true, false>(F.lds + RING_OFF, g, S, E, F.wave); } \
        REFRESH(); if (!(F.vcu & 1)) p2_conv_scan(F); }
#define PH3(BA_, BB_, QI_) if (IN(3)) { const int v = F.vcu; \
        if (v < 16 * NSEG) mlstm_seg_task(F, gl, v >> 3, v & 7); \
          \
        _Pragma("unroll 1") for (; (QI_) != 2;) { \
            if (F.tid == 0) F.MISC[16] = __hip_atomic_fetch_add((unsigned*)(F.ctl + CW_QUEUE + 64 * (QI_)), 1u, __ATOMIC_RELAXED, __HIP_MEMORY_SCOPE_AGENT); \
            __syncthreads(); const int q = (int)F.MISC[16]; __syncthreads(); \
            if (q >= 1024) break; \
            REFRESH(); \
            { const int u = 63 - (q >> 4), rem = q & 15; attn_unit(F, gl, rem & 1, 7 - (rem >> 1), u, BA_); } } \
        REFRESH(); \
        if (v < 256) { const int bh = v >> 4, sj = (v >> 1) & 7, pr = v & 1; mlstm_unit(F, gl, bh, sj, pr, BB_); mlstm_unit(F, gl, bh, sj, 3 - pr, BB_); } }
#define PH4 if (IN(4)) { \
        { pg8::Gemm g{(const bf16*)(F.ws + WS_QA), (const bf16*)(F.ws + WS_WA), T, DM, 1024}; pg8::StaticOrder S; S.init(T, DM, F.G, (int)blockIdx.x); \
          pg8::EpiGate<0> E{(bf16*)(F.ws + WS_MERGED), (const bf16*)(F.ws + WS_GATES)}; \
          pg8::gemm_phase<pg8::EpiGate<0>, pg8::StaticOrder, true, true>(F.lds + RING_OFF, g, S, E, F.wave); } \
        { pg8::Gemm g{(const bf16*)(F.ws + WS_BB), (const bf16*)(F.ws + WS_WB), T, DM, 1024}; pg8::StaticOrder S; S.init(T, DM, F.G, (int)blockIdx.x); \
          pg8::EpiGate<1> E{(bf16*)(F.ws + WS_MERGED), (const bf16*)(F.ws + WS_GATES)}; \
          pg8::gemm_phase<pg8::EpiGate<1>, pg8::StaticOrder, true, true>(F.lds + RING_OFF, g, S, E, F.wave); } }
#define PH5 if (IN(5)) { \
          \
        if (F.vcu & 1) { p5_expert_cvt(F); __syncthreads(); } \
        { pg8::Gemm g{(const bf16*)(F.ws + WS_MERGED), (const bf16*)(F.ws + WS_WOUT), T, DM, DM}; pg8::StaticOrder S; S.init(T, DM, F.G, (int)blockIdx.x); \
          pg8::EpiRes E{F.in[0], (bf16*)(F.ws + WS_X1B), (float*)(F.ws + WS_SSQ)}; \
          pg8::gemm_phase<pg8::EpiRes, pg8::StaticOrder, true, true>(F.lds + RING_OFF, g, S, E, F.wave); } \
        REFRESH(); if (!(F.vcu & 1)) p5_expert_cvt(F); }
#define PH6 if (IN(6)) { \
          \
        if (F.vcu & 1) p7_xquant(F); \
        pg8::Gemm g{(const bf16*)(F.ws + WS_X1B), (const bf16*)(F.ws + WS_WQ), T, DM, DM}; pg8::StaticOrder S; S.init(T, DM, F.G, (int)blockIdx.x); \
          \
        { float* R2 = (float*)(F.ws + WS_RSTD2); const float* SSQ = (const float*)(F.ws + WS_SSQ); pg8::Unit uu; \
          for (int i = 0; S.next(i, uu); ++i) if (F.tid < 256) { const int row = uu.pm * 256 + F.tid; const f32x4* sp = (const f32x4*)(SSQ + (size_t)row * 32); float s = 0.f; \
              _Pragma("unroll") for (int q = 0; q < 8; ++q) { const f32x4 t = sp[q]; s += (t[0] + t[1]) + (t[2] + t[3]); } \
              R2[row] = 1.0f / sqrtf(s * (1.0f / 2048.0f) + EPS); } \
          asm volatile("s_waitcnt vmcnt(0)" ::: "memory"); __syncthreads(); } \
        pg8::EpiQ E{(bf16*)(F.ws + WS_QP), (const float*)(F.ws + WS_RSTD2)}; \
        pg8::gemm_phase<pg8::EpiQ, pg8::StaticOrder, true, true>(F.lds + RING_OFF, g, S, E, F.wave); \
        REFRESH(); if (!(F.vcu & 1)) p7_xquant(F); }
#define PH7 if (IN(7)) { const int gw = F.vcu * NWAVES + F.wave, NGW = F.G * NWAVES; \
        for (int it = gw; it < (T / 32) * NH; it += NGW) route_unit(F, gl, (it >> 3) * 32, it & 7); }
#define PH8 if (IN(8)) { REFRESH(); peer_udots(F); }
#define PH9 if (IN(9)) { peer_act(F); }
#define PH10 if (IN(10)) { REFRESH(); peer_vacc(F); }
#define PH11 if (IN(11)) { peer_final(F); }
#define SEAM(k) do { if (IN(k) && IN((k) + 1)) xcd_barrier(bar); } while (0)
#define BAR_ALWAYS() xcd_barrier(bar)
#ifndef DUP
#define DUP -1
#endif
#ifdef ONLY_PH1
    PH1
#else
    PH0 SEAM(0);
#if DUP == 0
    PH0 BAR_ALWAYS();
#endif
    PH1 SEAM(1);
#if DUP == 1
    PH1 BAR_ALWAYS();
#endif
    PH2 SEAM(2);
#if DUP == 2
    PH2 BAR_ALWAYS();
#endif
#if DUP == 3
    PH3((bf16*)(F.ws + WS_MQ), (bf16*)(F.ws + WS_MK), 1) BAR_ALWAYS();
#endif
#if DUP == 31
    PH3((bf16*)(F.ws + WS_MQ), (bf16*)(F.ws + WS_MK), 2) BAR_ALWAYS();
#endif
    PH3((bf16*)(F.ws + WS_QA), (bf16*)(F.ws + WS_BB), 0) SEAM(3);
    PH4 SEAM(4);
#if DUP == 4
    PH4 BAR_ALWAYS();
#endif
    PH5 SEAM(5);
#if DUP == 5
    PH5 BAR_ALWAYS();
#endif
    PH6 SEAM(6);
#if DUP == 6
    PH6 BAR_ALWAYS();
#endif
    PH7 SEAM(7);
#if DUP == 7
    PH7 BAR_ALWAYS();
#endif
    PH8 SEAM(8);
#if DUP == 8
    PH8 BAR_ALWAYS();
#endif
    PH9 SEAM(9);
#if DUP == 9
    PH9 BAR_ALWAYS();
#endif
#if DUP == 10
    PH10 BAR_ALWAYS();
#endif
    PH10 SEAM(10);
    PH11
#if DUP == 11
    BAR_ALWAYS(); PH11
#endif
#endif
#undef IN
#undef SEAM
}

extern "C" void kernel_launch(void* const* d_in, const int* in_sizes, int n_in, void* d_out, int out_size, void* d_ws, size_t ws_size, hipStream_t stream) {
    static int grid = 0;
    if (grid == 0) {
        if (n_in != 18 || in_sizes[0] != T * DM || out_size != T * DM || ws_size < WS_END) { fprintf(stderr, "kernel_launch: unexpected shapes: n_in %d in0 %d out %d ws %zu (need %zu)\n", n_in, n_in > 0 ? in_sizes[0] : -1, out_size, ws_size, (size_t)WS_END); grid = -1; return; }
        int dev = 0, cus = 0, per_cu = 0;
        if (hipGetDevice(&dev) != hipSuccess || hipDeviceGetAttribute(&cus, hipDeviceAttributeMultiprocessorCount, dev) != hipSuccess) { grid = -1; return; }
        if (hipFuncSetAttribute((const void*)fwd_kernel, hipFuncAttributeMaxDynamicSharedMemorySize, LDS_BYTES) != hipSuccess) { fprintf(stderr, "kernel_launch: hipFuncSetAttribute failed\n"); grid = -1; return; }
        if (hipOccupancyMaxActiveBlocksPerMultiprocessor(&per_cu, (const void*)fwd_kernel, NWAVES * 64, LDS_BYTES) != hipSuccess || per_cu < 1) { fprintf(stderr, "kernel_launch: occupancy query says %d\n", per_cu); per_cu = 1; }
        (void)hipGetLastError();
        grid = cus;
    }
    if (grid < 0) return;
    (void)hipMemsetAsync((char*)d_ws + WS_CTL, 0, CTL_ZERO_BYTES, stream);
    Args a{};
    for (int i = 0; i < 18; ++i) a.in[i] = (const float*)d_in[i];
    a.out = (float*)d_out; a.ws = (unsigned char*)d_ws;
#if MK_PER_PHASE
    for (int p = 0; p < N_PHASES; ++p) { a.ph_lo = p; a.ph_hi = p + 1; hipLaunchKernelGGL(fwd_kernel, dim3(grid), dim3(NWAVES * 64), LDS_BYTES, stream, a); }
#else
    a.ph_lo = 0; a.ph_hi = N_PHASES;
    hipLaunchKernelGGL(fwd_kernel, dim3(grid), dim3(NWAVES * 64), LDS_BYTES, stream, a);
#endif
    const hipError_t le = hipPeekAtLastError();
    if (le != hipSuccess) fprintf(stderr, "kernel_launch: launch failed: %s\n", hipGetErrorName(le));
}
```

```cpp
#include <hip/hip_runtime.h>
#include <cstdio>
#include <cstdint>
namespace pg8 {
#define PG8_LAS __attribute__((address_space(3)))
typedef unsigned short bf16_t;
typedef short bf16x8 __attribute__((ext_vector_type(8)));
typedef float f32x4 __attribute__((ext_vector_type(4)));
typedef unsigned u32x4 __attribute__((ext_vector_type(4)));
constexpr int BM = 256, BK = 64, HALF = 128, HTB = HALF * BK * 2  , STAGE_BYTES = 8 * HTB, NXCD = 8, WGM = 8;

__host__ __device__ __forceinline__ int lds_byte(int r, int c) { const int st = (r >> 4) * 2 + (c >> 5), rr = r & 15, cc = c & 31, ob = rr * 64 + cc * 2; return st * 1024 + (ob ^ (((ob >> 9) & 1) << 5)); }
__host__ __device__ __forceinline__ void stage_rc(int b, int& R, int& C) { const int st = b / 1024, sb = b % 1024, swz = sb ^ (((sb >> 9) & 1) << 5); R = (st >> 1) * 16 + swz / 64; C = (st & 1) * 32 + (swz % 64) / 2; }
__host__ __device__ __forceinline__ int perm32(int rho) { const int n = rho >> 4, i = rho & 15; return 8 * (i >> 2) + 4 * n + (i & 3); }

struct Unit { int pm, pn; };
struct Gemm { const bf16_t* A; const bf16_t* Bt; int M, N, K; };

struct StaticOrder {
    int nM, nN, nwg, G, c;
    __host__ __device__ void init(int M, int N, int G_, int c_) { nM = M / BM; nN = N / BM; nwg = nM * nN; G = G_; c = c_; }
    __host__ __device__ bool next(int i, Unit& u) const {
        const long L = (long)i * G + c; if (L >= nwg) return false;
        int wgid = (int)L; { const int q = nwg / NXCD, r = nwg % NXCD, xcd = wgid % NXCD, off = wgid / NXCD; wgid = (xcd < r ? xcd * (q + 1) : r * (q + 1) + (xcd - r) * q) + off; }
        const int nig = WGM * nN, gid = wgid / nig, fm = gid * WGM, gsz = (nM - fm) < WGM ? (nM - fm) : WGM;
        u.pm = fm + ((wgid % nig) % gsz); u.pn = (wgid % nig) / gsz; return true;
    }
    __device__ __forceinline__ void a_ready(const Unit&) const {}
    __device__ __forceinline__ void done(const Unit&) const {}
};

__device__ __forceinline__ unsigned cvt_pk_bf16(float lo, float hi) { unsigned r; asm volatile("v_cvt_pk_bf16_f32 %0, %1, %2" : "=v"(r) : "v"(lo), "v"(hi)); return r; }
typedef float f32x2 __attribute__((ext_vector_type(2)));
__device__ __forceinline__ float sigmoidf_fast(float x) { return __builtin_amdgcn_rcpf(1.0f + __builtin_amdgcn_exp2f(-1.4426950408889634f * x)); }
__device__ __forceinline__ float bf_lo(unsigned w) { return __uint_as_float(w << 16); }
__device__ __forceinline__ float bf_hi(unsigned w) { return __uint_as_float(w & 0xffff0000u); }

struct EpiProj {
    static constexpr bool PERM = true, AFTER_DRAIN = false;
    bf16_t* segbase;
    size_t segstride;
    bf16_t* gates;
    const float* rstd;
    float cscale;
    float qscale;
    int pn_off;
    unsigned* kmax;
    __device__ __forceinline__ void operator()(const f32x4 (&acc)[2][2][4][2], const Unit& u, int wr, int wc, int fr, int fq) const {
        const int pn = u.pn + pn_off; bf16_t* base; int ldc, colt, mode;
        if (pn < 28) { const int seg = pn >> 2; base = segbase + (size_t)seg * segstride; ldc = 1024; colt = (pn & 3) * 256; mode = seg == 0 ? 1 : (seg == 6 ? 2 : 0); }
        else { base = gates; ldc = 4096; colt = (pn - 28) * 256; mode = 2; }
        const int row0 = u.pm * BM + wr * 64 + fr, col0 = colt + wc * 32 + 8 * fq; float kmx[2] = {0.f, 0.f};
        float rr[2][4];
#pragma unroll
        for (int ai = 0; ai < 2; ++ai)
#pragma unroll
            for (int m = 0; m < 4; ++m) rr[ai][m] = rstd ? rstd[row0 + ai * HALF + m * 16] : cscale;
#pragma unroll
        for (int ai = 0; ai < 2; ++ai)
#pragma unroll
            for (int m = 0; m < 4; ++m) { const int row = row0 + ai * HALF + m * 16; float r = rr[ai][m]; if (mode == 1) r *= qscale;
                bf16_t* rowp = base + (size_t)row * ldc + col0;
#pragma unroll
                for (int bj = 0; bj < 2; ++bj) { f32x4 v0 = acc[ai][bj][m][0] * r, v1 = acc[ai][bj][m][1] * r;
                    if (mode == 2) {
#pragma unroll
                        for (int e = 0; e < 4; ++e) { v0[e] = sigmoidf_fast(v0[e]); v1[e] = sigmoidf_fast(v1[e]); } }
                    u32x4 w; w.x = cvt_pk_bf16(v0[0], v0[1]); w.y = cvt_pk_bf16(v0[2], v0[3]); w.z = cvt_pk_bf16(v1[0], v1[1]); w.w = cvt_pk_bf16(v1[2], v1[3]);
                    *(u32x4*)(rowp + bj * HALF) = w;
                    if (kmax && pn >= 4 && pn < 8) {
                        float s = ((v0[0] * v0[0] + v0[1] * v0[1]) + (v0[2] * v0[2] + v0[3] * v0[3])) + ((v1[0] * v1[0] + v1[1] * v1[1]) + (v1[2] * v1[2] + v1[3] * v1[3]));
                        s += __shfl_xor(s, 16); s += __shfl_xor(s, 32); kmx[bj] = fmaxf(kmx[bj], s); } } }
        if (kmax && pn >= 4 && pn < 8 && fq == 0) {
#pragma unroll
            for (int bj = 0; bj < 2; ++bj) { float m = kmx[bj];
#pragma unroll
                for (int o = 1; o < 16; o <<= 1) m = fmaxf(m, __shfl_xor(m, o));
                if (fr == 0) atomicMax(kmax + (row0 >> 13) * 32 + ((colt + bj * HALF + wc * 32) >> 5), __float_as_uint(m)); } }
    }
};
template <int PASS> struct EpiGate {
    static constexpr bool PERM = true, AFTER_DRAIN = false;
    bf16_t* merged; const bf16_t* gates;
    __device__ __forceinline__ void operator()(const f32x4 (&acc)[2][2][4][2], const Unit& u, int wr, int wc, int fr, int fq) const {
        const int row0 = u.pm * BM + wr * 64 + fr, col0 = u.pn * BM + wc * 32 + 8 * fq;
        u32x4 gq[2][4][2];
#pragma unroll
        for (int ai = 0; ai < 2; ++ai)
#pragma unroll
            for (int m = 0; m < 4; ++m)
#pragma unroll
                for (int bj = 0; bj < 2; ++bj) gq[ai][m][bj] = *(const u32x4*)(gates + (size_t)(row0 + ai * HALF + m * 16) * 4096 + PASS * 2048 + col0 + bj * HALF);
#pragma unroll
        for (int ai = 0; ai < 2; ++ai) {
            u32x4 pq[4][2];
            if (PASS == 1) {
#pragma unroll
                for (int m = 0; m < 4; ++m)
#pragma unroll
                    for (int bj = 0; bj < 2; ++bj) pq[m][bj] = *(const u32x4*)(merged + (size_t)(row0 + ai * HALF + m * 16) * 2048 + col0 + bj * HALF); }
#pragma unroll
            for (int m = 0; m < 4; ++m)
#pragma unroll
                for (int bj = 0; bj < 2; ++bj) { const int row = row0 + ai * HALF + m * 16, col = col0 + bj * HALF; const u32x4 g = gq[ai][m][bj];
                    f32x4 v0 = acc[ai][bj][m][0], v1 = acc[ai][bj][m][1];
                    v0[0] *= bf_lo(g.x); v0[1] *= bf_hi(g.x); v0[2] *= bf_lo(g.y); v0[3] *= bf_hi(g.y); v1[0] *= bf_lo(g.z); v1[1] *= bf_hi(g.z); v1[2] *= bf_lo(g.w); v1[3] *= bf_hi(g.w);
                    if (PASS == 1) { const u32x4 p = pq[m][bj];
                        v0[0] += bf_lo(p.x); v0[1] += bf_hi(p.x); v0[2] += bf_lo(p.y); v0[3] += bf_hi(p.y); v1[0] += bf_lo(p.z); v1[1] += bf_hi(p.z); v1[2] += bf_lo(p.w); v1[3] += bf_hi(p.w); }
                    u32x4 w; w.x = cvt_pk_bf16(v0[0], v0[1]); w.y = cvt_pk_bf16(v0[2], v0[3]); w.z = cvt_pk_bf16(v1[0], v1[1]); w.w = cvt_pk_bf16(v1[2], v1[3]);
                    *(u32x4*)(merged + (size_t)row * 2048 + col) = w; }
        }
    }
};
struct EpiRes {
    static constexpr bool PERM = false, AFTER_DRAIN = false;
    const float* x; bf16_t* x1b; float* ssq;
    __device__ __forceinline__ void operator()(const f32x4 (&acc)[2][2][4][2], const Unit& u, int wr, int wc, int fr, int fq) const {
        const int row0 = u.pm * BM + wr * 64 + fr, col0 = u.pn * BM + wc * 32 + 4 * fq;
#pragma unroll
        for (int ai = 0; ai < 2; ++ai) {
            f32x4 xq[4][2][2];
#pragma unroll
            for (int m = 0; m < 4; ++m)
#pragma unroll
                for (int bj = 0; bj < 2; ++bj)
#pragma unroll
                    for (int n = 0; n < 2; ++n) xq[m][bj][n] = *(const f32x4*)(x + (size_t)(row0 + ai * HALF + m * 16) * 2048 + col0 + bj * HALF + n * 16);
#pragma unroll
            for (int m = 0; m < 4; ++m) { const int row = row0 + ai * HALF + m * 16; const size_t off = (size_t)row * 2048 + col0; float s = 0.f;
#pragma unroll
                for (int bj = 0; bj < 2; ++bj)
#pragma unroll
                    for (int n = 0; n < 2; ++n) { const size_t o = off + bj * HALF + n * 16; const f32x4 v = xq[m][bj][n] + acc[ai][bj][m][n];
                        typedef unsigned u32x2v __attribute__((ext_vector_type(2))); u32x2v w; w.x = cvt_pk_bf16(v[0], v[1]); w.y = cvt_pk_bf16(v[2], v[3]);
                        *(u32x2v*)(x1b + o) = w; s += (v[0] * v[0] + v[1] * v[1]) + (v[2] * v[2] + v[3] * v[3]); }
                s += __shfl_xor(s, 16); s += __shfl_xor(s, 32);
                if (fq == 0) ssq[(size_t)row * 32 + u.pn * 4 + wc] = s; }
        }
    }
};
struct EpiQ {
    static constexpr bool PERM = true, AFTER_DRAIN = false;
    bf16_t* out; const float* rstd2;
    __device__ __forceinline__ void operator()(const f32x4 (&acc)[2][2][4][2], const Unit& u, int wr, int wc, int fr, int fq) const {
        const int row0 = u.pm * BM + wr * 64 + fr, col0 = u.pn * BM + wc * 32 + 8 * fq;
        float rr[2][4];
#pragma unroll
        for (int ai = 0; ai < 2; ++ai)
#pragma unroll
            for (int m = 0; m < 4; ++m) rr[ai][m] = rstd2[row0 + ai * HALF + m * 16];
#pragma unroll
        for (int ai = 0; ai < 2; ++ai)
#pragma unroll
            for (int m = 0; m < 4; ++m) { const int row = row0 + ai * HALF + m * 16; const float r = rr[ai][m];
#pragma unroll
                for (int bj = 0; bj < 2; ++bj) { const f32x4 v0 = acc[ai][bj][m][0] * r, v1 = acc[ai][bj][m][1] * r;
                    u32x4 w; w.x = cvt_pk_bf16(v0[0], v0[1]); w.y = cvt_pk_bf16(v0[2], v0[3]); w.z = cvt_pk_bf16(v1[0], v1[1]); w.w = cvt_pk_bf16(v1[2], v1[3]);
                    *(u32x4*)(out + (size_t)row * 2048 + col0 + bj * HALF) = w; } }
    }
};

template <class Epi, class Sched, bool ALIGN_EPI = false, bool SP2 = false, bool FP8 = false>
__device__ __forceinline__ void gemm_phase(PG8_LAS unsigned char* lds, const Gemm g, const Sched& S, const Epi& E, const int wid_in) {
    const int wid = wid_in, lane = (int)__builtin_amdgcn_mbcnt_hi(~0u, __builtin_amdgcn_mbcnt_lo(~0u, 0u)), tid = wid * 64 + lane, wr = wid >> 2, wc = wid & 3, fr = lane & 15, fq = lane >> 4;
    const int K = g.K, nt = K / BK;
    unsigned voffA[2], voffB[2];
#pragma unroll
    for (int i = 0; i < 2; ++i) { int R, C; stage_rc(tid * 16 + i * 8192, R, C); const int Rb = Epi::PERM ? ((R & ~31) + perm32(R & 31)) : R;
        voffA[i] = (unsigned)(R * K + C) * 2u; voffB[i] = (unsigned)(Rb * K + C) * 2u; }
    const size_t half64 = (size_t)64 * K * 2;
    const size_t kstep = (size_t)(BK * 2);
    const size_t hstep = (size_t)HALF * K * 2;
    const size_t tstep = 2 * hstep;
    const unsigned ldsw = (unsigned)wid * 1024u; const unsigned ldsw_base = (unsigned)__builtin_amdgcn_readfirstlane((int)((unsigned)(uintptr_t)lds + ldsw));
    const int aoff = lds_byte(wr * 64 + fr, fq * 8), boff = lds_byte(wc * 32 + fr, fq * 8);
    const PG8_LAS unsigned char* const ldsA = lds + aoff; const PG8_LAS unsigned char* const ldsB = lds + 4 * HTB + boff;
#define PG8_SA(b, h) (((b) * 2 + (h)) * HTB)
#define PG8_SB(b, h) ((4 + (b) * 2 + (h)) * HTB)
#define PG8_STAGE(bufoff, gbase, voff) do { _Pragma("unroll") for (int _i = 0; _i < 2; ++_i) \
        asm volatile("s_add_u32 m0, %2, %3\n\ts_nop 0\n\tglobal_load_lds_dwordx4 %0, %1" : : "v"((voff)[0]), "s"((const char*)(gbase) + (size_t)_i * half64), "s"(ldsw_base), "i"((bufoff) + _i * 8192) : "memory", "scc"); } while (0)
#define PG8_LDA(dst, b, h) do { _Pragma("unroll") for (int m = 0; m < 4; ++m) { if constexpr (FP8) { const i32x4_ r0_ = *(const PG8_LAS i32x4_*)(ldsA + PG8_SA(b, h) + m * 2048), r1_ = *(const PG8_LAS i32x4_*)(ldsA + PG8_SA(b, h) + m * 2048 + 1024); dst##8[m] = __builtin_shufflevector(r0_, r1_, 0, 1, 2, 3, 4, 5, 6, 7); } \
        else { _Pragma("unroll") for (int k = 0; k < 2; ++k) dst[m][k] = *(const PG8_LAS bf16x8*)(ldsA + PG8_SA(b, h) + m * 2048 + k * 1024); } } } while (0)
#define PG8_LDB(dst, b, h) do { _Pragma("unroll") for (int n = 0; n < 2; ++n) { if constexpr (FP8) { const i32x4_ r0_ = *(const PG8_LAS i32x4_*)(ldsB + (PG8_SB(b, h) - 4 * HTB) + n * 2048), r1_ = *(const PG8_LAS i32x4_*)(ldsB + (PG8_SB(b, h) - 4 * HTB) + n * 2048 + 1024); dst##8[n] = __builtin_shufflevector(r0_, r1_, 0, 1, 2, 3, 4, 5, 6, 7); } \
        else { _Pragma("unroll") for (int k = 0; k < 2; ++k) dst[n][k] = *(const PG8_LAS bf16x8*)(ldsB + (PG8_SB(b, h) - 4 * HTB) + n * 2048 + k * 1024); } } } while (0)
#define PG8_MMA(ai, bj, At, Bt) do { __builtin_amdgcn_s_setprio(1); _Pragma("unroll") for (int m = 0; m < 4; ++m) _Pragma("unroll") for (int n = 0; n < 2; ++n) { \
        if constexpr (FP8) acc[ai][bj][m][n] = __builtin_amdgcn_mfma_scale_f32_16x16x128_f8f6f4(Bt##8[n], At##8[m], acc[ai][bj][m][n], 0, 0, 0, 127, 0, 127); \
        else { _Pragma("unroll") for (int k = 0; k < 2; ++k) acc[ai][bj][m][n] = __builtin_amdgcn_mfma_f32_16x16x32_bf16(Bt[n][k], At[m][k], acc[ai][bj][m][n], 0, 0, 0); } } \
        __builtin_amdgcn_s_setprio(0); } while (0)
#define PG8_WAIT_V(n) asm volatile("s_waitcnt vmcnt(" #n ")" ::: "memory")
#define PG8_WAIT_L(n) asm volatile("s_waitcnt lgkmcnt(" #n ")" ::: "memory")
#define PG8_BAR __builtin_amdgcn_s_barrier()
#define PG8_SCHED __builtin_amdgcn_sched_barrier(0)
    Unit cur, nxt; int ui = 0;
    if (!S.next(0, cur)) return;
    f32x4 acc[2][2][4][2];
#pragma unroll
    for (int a = 0; a < 2; ++a)
#pragma unroll
        for (int b = 0; b < 2; ++b)
#pragma unroll
            for (int m = 0; m < 4; ++m)
#pragma unroll
                for (int n = 0; n < 2; ++n) acc[a][b][m][n] = (f32x4){0.f, 0.f, 0.f, 0.f};
    typedef int i32x8_ __attribute__((ext_vector_type(8))); typedef int i32x4_ __attribute__((ext_vector_type(4)));
    bf16x8 At[4][2], B0[2][2], B1[2][2]; i32x8_ At8[4], B08[2], B18[2];
    const char* cA = (const char*)g.A + (size_t)cur.pm * tstep; const char* cB = (const char*)g.Bt + (size_t)cur.pn * tstep;
    S.a_ready(cur);
    if constexpr (SP2) {
        PG8_STAGE(PG8_SB(0, 0), cB, voffB); PG8_STAGE(PG8_SB(0, 1), cB + hstep, voffB); PG8_STAGE(PG8_SA(0, 0), cA, voffA); PG8_STAGE(PG8_SA(0, 1), cA + hstep, voffA);
        if (wr == 1) PG8_BAR;
        PG8_WAIT_V(2); PG8_BAR;
        PG8_STAGE(PG8_SB(1, 0), cB + kstep, voffB); PG8_STAGE(PG8_SA(1, 0), cA + kstep, voffA); PG8_STAGE(PG8_SB(1, 1), cB + hstep + kstep, voffB);
        PG8_WAIT_V(6); PG8_BAR;
    } else {
        PG8_STAGE(PG8_SB(0, 0), cB, voffB); PG8_STAGE(PG8_SA(0, 0), cA, voffA); PG8_STAGE(PG8_SB(0, 1), cB + hstep, voffB); PG8_STAGE(PG8_SA(0, 1), cA + hstep, voffA);
        if (wr == 1) PG8_BAR;
        PG8_WAIT_V(4); PG8_BAR;
        PG8_STAGE(PG8_SB(1, 0), cB + kstep, voffB); PG8_STAGE(PG8_SA(1, 0), cA + kstep, voffA); PG8_STAGE(PG8_SB(1, 1), cB + hstep + kstep, voffB);
        PG8_WAIT_V(6); PG8_BAR;
    }
    for (;;) {
        const bool has_next = S.next(ui + 1, nxt);
        const char* nA = has_next ? (const char*)g.A + (size_t)nxt.pm * tstep : cA; const char* nB = has_next ? (const char*)g.Bt + (size_t)nxt.pn * tstep : cB;
        for (int t = 0; t < nt; t += 2) {
            const bool last = (t == nt - 2);
            const char* a1 = cA + (size_t)(t + 1) * kstep;
            const char* a2 = last ? nA : cA + (size_t)(t + 2) * kstep; const char* b2 = last ? nB : cB + (size_t)(t + 2) * kstep;
            const char* a3 = a2 + kstep; const char* b3 = b2 + kstep;
            if (last && has_next) S.a_ready(nxt);
            if constexpr (SP2) {
            PG8_LDB(B0, 0, 0); PG8_LDB(B1, 0, 1); PG8_SCHED; PG8_LDA(At, 0, 0); PG8_STAGE(PG8_SA(1, 1), a1 + hstep, voffA);
            PG8_WAIT_V(8); PG8_WAIT_L(0); PG8_BAR; PG8_MMA(0, 0, At, B0); PG8_MMA(0, 1, At, B1); PG8_BAR; PG8_SCHED;
            PG8_LDA(At, 0, 1); PG8_STAGE(PG8_SB(0, 0), b2, voffB); PG8_STAGE(PG8_SB(0, 1), b2 + hstep, voffB); PG8_STAGE(PG8_SA(0, 0), a2, voffA);
            PG8_WAIT_V(8); PG8_WAIT_L(0); PG8_BAR; PG8_MMA(1, 0, At, B0); PG8_MMA(1, 1, At, B1); PG8_BAR; PG8_SCHED;
            PG8_LDB(B0, 1, 0); PG8_LDB(B1, 1, 1); PG8_SCHED; PG8_LDA(At, 1, 0); PG8_STAGE(PG8_SA(0, 1), a2 + hstep, voffA);
            PG8_WAIT_V(8); PG8_WAIT_L(0); PG8_BAR; PG8_MMA(0, 0, At, B0); PG8_MMA(0, 1, At, B1); PG8_BAR; PG8_SCHED;
            PG8_LDA(At, 1, 1); PG8_STAGE(PG8_SB(1, 0), b3, voffB); PG8_STAGE(PG8_SB(1, 1), b3 + hstep, voffB); PG8_STAGE(PG8_SA(1, 0), a3, voffA);
            PG8_WAIT_V(8); PG8_WAIT_L(0); PG8_BAR; PG8_MMA(1, 0, At, B0); PG8_MMA(1, 1, At, B1); PG8_BAR; PG8_SCHED;
            } else {
            PG8_LDB(B0, 0, 0); PG8_SCHED; PG8_LDA(At, 0, 0); PG8_STAGE(PG8_SA(1, 1), a1 + hstep, voffA);
            PG8_WAIT_L(8); PG8_BAR; PG8_WAIT_L(0); PG8_MMA(0, 0, At, B0); PG8_BAR; PG8_SCHED;
            PG8_LDB(B1, 0, 1); PG8_STAGE(PG8_SB(0, 0), b2, voffB);
            PG8_BAR; PG8_WAIT_L(0); PG8_MMA(0, 1, At, B1); PG8_BAR;
            PG8_LDA(At, 0, 1); PG8_STAGE(PG8_SA(0, 0), a2, voffA);
            PG8_BAR; PG8_WAIT_L(0); PG8_MMA(1, 0, At, B0); PG8_BAR; PG8_SCHED;
            PG8_STAGE(PG8_SB(0, 1), b2 + hstep, voffB);
            PG8_WAIT_V(6); PG8_BAR; PG8_MMA(1, 1, At, B1); PG8_BAR;
            PG8_LDB(B0, 1, 0); PG8_SCHED; PG8_LDA(At, 1, 0); PG8_STAGE(PG8_SA(0, 1), a2 + hstep, voffA);
            PG8_WAIT_L(8); PG8_BAR; PG8_WAIT_L(0); PG8_MMA(0, 0, At, B0); PG8_BAR; PG8_SCHED;
            PG8_LDB(B1, 1, 1); PG8_STAGE(PG8_SB(1, 0), b3, voffB);
            PG8_BAR; PG8_WAIT_L(0); PG8_MMA(0, 1, At, B1); PG8_BAR;
            PG8_LDA(At, 1, 1); PG8_STAGE(PG8_SA(1, 0), a3, voffA);
            PG8_BAR; PG8_WAIT_L(0); PG8_MMA(1, 0, At, B0); PG8_BAR; PG8_SCHED;
            PG8_STAGE(PG8_SB(1, 1), b3 + hstep, voffB);
            PG8_WAIT_V(6); PG8_BAR; PG8_MMA(1, 1, At, B1); PG8_BAR;
            }
        }
        if constexpr (ALIGN_EPI) { if (wr == 0) PG8_BAR; }
        if constexpr (!Epi::AFTER_DRAIN) { int laneE = (int)__builtin_amdgcn_mbcnt_hi(~0u, __builtin_amdgcn_mbcnt_lo(~0u, 0u)); asm volatile("" : "+v"(laneE));
            const int widE = wid_in; E(acc, cur, widE >> 2, widE & 3, laneE & 15, laneE >> 4); S.done(cur); }
        if (!has_next) break;
#pragma unroll
        for (int a = 0; a < 2; ++a)
#pragma unroll
            for (int b = 0; b < 2; ++b)
#pragma unroll
                for (int m = 0; m < 4; ++m)
#pragma unroll
                    for (int n = 0; n < 2; ++n) acc[a][b][m][n] = (f32x4){0.f, 0.f, 0.f, 0.f};
        cur = nxt; cA = nA; cB = nB; ++ui;
        if constexpr (ALIGN_EPI) { if (wr == 1) PG8_BAR; }
    }
    PG8_WAIT_V(0);
    if constexpr (!ALIGN_EPI) { if (wr == 0) PG8_BAR; }
    PG8_BAR;
    if constexpr (Epi::AFTER_DRAIN) { E.fused(acc, cur, wr, wc, fr, fq, lds, wid, lane); S.done(cur); }
#undef PG8_SA
#undef PG8_SB
#undef PG8_STAGE
#undef PG8_LDA
#undef PG8_LDB
#undef PG8_MMA
#undef PG8_WAIT_V
#undef PG8_WAIT_L
#undef PG8_BAR
#undef PG8_SCHED
}
}

constexpr int NWAVES = 8;
constexpr int BATCH = 2, SEQ = 8192, DM = 2048, T = BATCH * SEQ;
constexpr int IN_WIDTH = 11280, NPROJ = 11264;
constexpr int NH = 8, HD = 128;
constexpr int NEXP = 16384, NKEYS = 128, TOPK = 16;
constexpr float EPS = 1e-6f;
constexpr float LOG2E = 1.4426950408889634f;
constexpr int SEGTOK = 1024, NSEG = SEQ / SEGTOK;

constexpr size_t MiB = 1u << 20;
constexpr size_t WS_CTL = 0, CTL_ZERO_BYTES = 1 * MiB;
constexpr size_t WS_IF = 1 * MiB;
constexpr size_t WS_RSTD1 = 2 * MiB;
constexpr size_t WS_LAM = 2 * MiB + 64 * 1024;
constexpr size_t WS_FCUM = 2 * MiB + 128 * 1024;
constexpr size_t WS_LIT = 2 * MiB + 640 * 1024;
constexpr size_t WS_WA = 4 * MiB, WS_WB = 8 * MiB, WS_WOUT = 12 * MiB, WS_WQ = 20 * MiB;
constexpr size_t WS_SK = 28 * MiB;
constexpr size_t WS_WIF = 28 * MiB + 512 * 1024;
constexpr size_t WS_SSQ = 29 * MiB;
constexpr size_t WS_WIN = 32 * MiB;
constexpr size_t WS_CSEG = 32 * MiB;
constexpr int NSENS = 2048;
constexpr size_t WS_WINB = 60 * MiB;
constexpr size_t WS_XB = 76 * MiB;
constexpr size_t OUT_MQC = 0, OUT_MKC = 32 * MiB;
constexpr size_t WS_BB = 76 * MiB;
constexpr size_t WS_QA = 140 * MiB;
constexpr size_t SEG_STRIDE = 32 * MiB;
constexpr size_t WS_KA = WS_QA + SEG_STRIDE, WS_VA = WS_QA + 2 * SEG_STRIDE, WS_MQ = WS_QA + 3 * SEG_STRIDE, WS_MK = WS_QA + 4 * SEG_STRIDE, WS_MV = WS_QA + 5 * SEG_STRIDE, WS_MO = WS_QA + 6 * SEG_STRIDE;
constexpr size_t WS_MERGED = WS_KA;
constexpr size_t WS_X1B = WS_MQ;
constexpr size_t WS_QP = WS_MV;
constexpr size_t WS_GATES = 364 * MiB;
constexpr size_t WS_UB = 364 * MiB, WS_VB = 428 * MiB, WS_VB6 = 396 * MiB;
constexpr size_t WS_PART = 140 * MiB;
constexpr size_t WS_ACT = 204 * MiB;
constexpr size_t WS_SSQ2 = 212 * MiB;
constexpr size_t WS_RSTD2 = 215 * MiB;
constexpr size_t WS_X8 = 420 * MiB;
constexpr size_t WS_X6 = 420 * MiB;
constexpr size_t WS_Y = 300 * MiB;
constexpr size_t WS_SCU = 31 * MiB, WS_SCV = 31 * MiB + 256 * 1024;
constexpr size_t WS_IDX = 492 * MiB, WS_GATE = 500 * MiB;
constexpr size_t WS_END = 508 * MiB;
constexpr int CSEG_STRIDE = 128 * 128 + 128 + 8;
static_assert((size_t)16 * NSEG * CSEG_STRIDE * 4 <= 44 * MiB, "CSEG fits W_in region");
constexpr int CW_BAR = 4096;
constexpr int CW_KMAX = 20480;
constexpr int CW_QUEUE = 24576;
constexpr int CW_SEGCNT = 16384;

constexpr int RING_OFF = 0, RING_BYTES = 131072;
constexpr int LDSCTL_OFF = RING_BYTES, MISC_OFF = LDSCTL_OFF + 320;
constexpr int LDS_BYTES = 147456;

#define GAS __attribute__((address_space(1)))
#define LAS __attribute__((address_space(3)))
typedef unsigned short bf16;
typedef unsigned v4u __attribute__((ext_vector_type(4)));
typedef float f32x4 __attribute__((ext_vector_type(4)));
typedef short bf16x8 __attribute__((ext_vector_type(8)));
typedef GAS unsigned gu32;
typedef GAS unsigned long long gu64;
#define RLX_AGENT __ATOMIC_RELAXED, __HIP_MEMORY_SCOPE_AGENT
#define LDS_WAIT() asm volatile("s_waitcnt lgkmcnt(0)" ::: "memory")
#define VM_WAIT() asm volatile("s_waitcnt vmcnt(0)" ::: "memory")
__device__ __forceinline__ unsigned long long rt() { return __builtin_amdgcn_s_memrealtime(); }
__device__ __forceinline__ unsigned f2bf(float f) { unsigned u = __builtin_bit_cast(unsigned, f); return (u + 0x7fffu + ((u >> 16) & 1u)) >> 16; }
__device__ __forceinline__ unsigned pk2(float lo, float hi) { return f2bf(lo) | (f2bf(hi) << 16); }

#define XB_TMO      128
#define XB_XCNT(j)  (256  + 64 * (j))
#define XB_XSUB(j)  (1280 + 64 * (j))
#define XB_XGEN(j)  (2304 + 64 * (j))
#define XB_TOP      3328
#define XB_TOPGEN   3392
#define XCD_BAR_WORDS 3456
#define XB_SPIN_CAP (1u << 18)

__device__ __forceinline__ unsigned xb_ld(unsigned* p)              { return __hip_atomic_load(p, __ATOMIC_RELAXED, __HIP_MEMORY_SCOPE_AGENT); }
__device__ __forceinline__ unsigned xb_add(unsigned* p, unsigned v) { return __hip_atomic_fetch_add(p, v, __ATOMIC_RELAXED, __HIP_MEMORY_SCOPE_AGENT); }
__device__ __forceinline__ unsigned xb_xcc_id() { return (unsigned)__builtin_amdgcn_s_getreg((3 << 11) | 20) & 0xFu; }
#define XB_SPIN(cond, bar) do { unsigned _sp = 0; while (cond) { __builtin_amdgcn_s_sleep(1); \
    if ((++_sp & 255u) == 0u) { if (xb_ld(&(bar)[XB_TMO])) break; if (_sp > XB_SPIN_CAP) { atomicAdd(&(bar)[XB_TMO], 1u); break; } } } } while (0)

struct XcdBarrier {
    unsigned* bar; unsigned x;
    volatile LAS unsigned* st;
    bool w0;
};
__device__ __forceinline__ int xb_lane_id() { return (int)__builtin_amdgcn_mbcnt_hi(~0u, __builtin_amdgcn_mbcnt_lo(~0u, 0u)); }

__device__ __forceinline__ XcdBarrier xcd_barrier_post(unsigned* bar, volatile LAS unsigned* st, int wave) {
    XcdBarrier b; b.bar = bar; b.x = xb_xcc_id(); b.st = st; b.w0 = wave == 0;
    if (b.w0 && xb_lane_id() == 0) (void)xb_add(&bar[XB_XCNT(b.x)], 1u);
    return b;
}
__device__ __forceinline__ void xcd_barrier_complete(unsigned* bar, unsigned x, unsigned& nloc, unsigned& nx) {
    const unsigned G = gridDim.x * gridDim.y * gridDim.z;
    unsigned sum, cnt, mine, sp = 0u;
    for (;;) {
        sum = 0u; cnt = 0u; mine = 0u;
#pragma unroll
        for (unsigned j = 0; j < 16; ++j) { const unsigned c = xb_ld(&bar[XB_XCNT(j)]); sum += c; cnt += (c > 0u) ? 1u : 0u; mine = (j == x) ? c : mine; }
        if (sum == G) break;
        __builtin_amdgcn_s_sleep(1);
        if ((++sp & 255u) == 0u) { if (xb_ld(&bar[XB_TMO])) break; if (sp > XB_SPIN_CAP) { atomicAdd(&bar[XB_TMO], 1u); break; } }
    }
    nloc = mine > 0u ? mine : 1u; nx = cnt > 0u ? cnt : 1u;
}

__device__ __forceinline__ void xcd_barrier(const XcdBarrier& b) {
    asm volatile("s_waitcnt vmcnt(0)" ::: "memory");
    __syncthreads();
    if (b.w0 && xb_lane_id() == 0) {
        unsigned* bar = b.bar;
        __builtin_amdgcn_s_waitcnt(0);
        unsigned nloc = b.st[0], nx = b.st[1];
        if (nloc == 0u) { xcd_barrier_complete(bar, b.x, nloc, nx); b.st[0] = nloc; b.st[1] = nx; }
        const unsigned old = xb_add(&bar[XB_XSUB(b.x)], 1u);
        const unsigned gen = old / nloc;
        if (old + 1u == (gen + 1u) * nloc) {
            __builtin_amdgcn_fence(__ATOMIC_RELEASE, "agent");
            asm volatile("s_waitcnt vmcnt(0)" ::: "memory");
            const unsigned og = xb_add(&bar[XB_TOP], 1u);
            const unsigned tg = og / nx;
            if (og + 1u == (tg + 1u) * nx) xb_add(&bar[XB_TOPGEN], 1u);
            else XB_SPIN(xb_ld(&bar[XB_TOPGEN]) == tg, bar);
            __builtin_amdgcn_fence(__ATOMIC_ACQUIRE, "agent");
            xb_add(&bar[XB_XGEN(b.x)], 1u);
            asm volatile("s_waitcnt vmcnt(0)" ::: "memory");
        } else {
            XB_SPIN(xb_ld(&bar[XB_XGEN(b.x)]) == gen, bar);
            __builtin_amdgcn_fence(__ATOMIC_ACQUIRE, "agent");
            asm volatile("s_waitcnt vmcnt(0)" ::: "memory");
        }
    }
    __syncthreads();
}

struct Frame {
    LAS unsigned char* lds;
    volatile LAS unsigned* MISC;
    gu32* ctl;
    unsigned char* ws;
    int tid, lane, wave;
    int vcu, G;
    const float* const* in;
    float* out;
};
typedef unsigned u32x2 __attribute__((ext_vector_type(2)));
typedef float f32x16 __attribute__((ext_vector_type(16)));
typedef short s16x4 __attribute__((ext_vector_type(4)));

__device__ __forceinline__ float wave_sum(float v) {
#pragma unroll
    for (int o = 1; o < 64; o <<= 1) v += __shfl_xor(v, o);
    return v;
}
__device__ __forceinline__ float wave_max(float v) {
#pragma unroll
    for (int o = 1; o < 64; o <<= 1) v = fmaxf(v, __shfl_xor(v, o));
    return v;
}
__device__ __forceinline__ float bflo(unsigned w) { return __uint_as_float(w << 16); }
__device__ __forceinline__ float bfhi(unsigned w) { return __uint_as_float(w & 0xffff0000u); }
__device__ __forceinline__ unsigned cvtpk(float lo, float hi) { unsigned r; asm volatile("v_cvt_pk_bf16_f32 %0, %1, %2" : "=v"(r) : "v"(lo), "v"(hi)); return r; }

template <bool HASG> __device__ __forceinline__ void transpose_item(const float* W, int ldw, int src_col0, int k0, bf16* WT, int ldt, int dst_row0, const float* gk, LAS float* scr, int lane) {
    { const float* wp_ = W + (size_t)(k0 + (lane >> 3)) * ldw + src_col0 + 4 * (lane & 7); const float* gp_ = gk + k0 + (lane >> 3); LAS float* sp_ = scr + (lane >> 3) * 33 + 4 * (lane & 7);
      f32x4 v[8]; float gq[8];
#pragma unroll
      for (int i = 0; i < 8; ++i) { v[i] = *(const f32x4*)(wp_ + (size_t)(8 * i) * ldw); if constexpr (HASG) gq[i] = gp_[8 * i]; else gq[i] = 1.0f; }
#pragma unroll
      for (int i = 0; i < 8; ++i) { sp_[8 * i * 33] = v[i][0] * gq[i]; sp_[8 * i * 33 + 1] = v[i][1] * gq[i]; sp_[8 * i * 33 + 2] = v[i][2] * gq[i]; sp_[8 * i * 33 + 3] = v[i][3] * gq[i]; } }
    LDS_WAIT(); asm volatile("" ::: "memory");
    const int c = lane & 7;
#pragma unroll
    for (int j = 0; j < 4; ++j) { const int n = (lane >> 3) + 8 * j; const LAS float* s = scr + (8 * c) * 33 + n;
        v4u o; o.x = pk2(s[0 * 33], s[1 * 33]); o.y = pk2(s[2 * 33], s[3 * 33]); o.z = pk2(s[4 * 33], s[5 * 33]); o.w = pk2(s[6 * 33], s[7 * 33]);
        *(GAS v4u*)(WT + (size_t)(dst_row0 + n) * ldt + k0 + 8 * c) = o; }
    LDS_WAIT(); asm volatile("" ::: "memory");
}
template <bool HASG> __device__ __forceinline__ void transpose_item8(const float* W, int ldw, int src_col0, int k0, unsigned char* WT8, int ldt, int dst_row0, const float* gk, float scale, LAS float* scr, int lane) {
    { const float* wp_ = W + (size_t)(k0 + (lane >> 3)) * ldw + src_col0 + 4 * (lane & 7); const float* gp_ = gk + k0 + (lane >> 3); LAS float* sp_ = scr + (lane >> 3) * 33 + 4 * (lane & 7);
      f32x4 v[8]; float gq[8];
#pragma unroll
      for (int i = 0; i < 8; ++i) { v[i] = *(const f32x4*)(wp_ + (size_t)(8 * i) * ldw); if constexpr (HASG) gq[i] = gp_[8 * i]; else gq[i] = 1.0f; }
#pragma unroll
      for (int i = 0; i < 8; ++i) gq[i] *= scale;
#pragma unroll
      for (int i = 0; i < 8; ++i) { sp_[8 * i * 33] = v[i][0] * gq[i]; sp_[8 * i * 33 + 1] = v[i][1] * gq[i]; sp_[8 * i * 33 + 2] = v[i][2] * gq[i]; sp_[8 * i * 33 + 3] = v[i][3] * gq[i]; } }
    LDS_WAIT(); asm volatile("" ::: "memory");
    const int c = lane & 7;
#pragma unroll
    for (int j = 0; j < 4; ++j) { const int n = (lane >> 3) + 8 * j; const LAS float* s = scr + (8 * c) * 33 + n;
        int p0 = __builtin_amdgcn_cvt_pk_fp8_f32(s[0 * 33], s[1 * 33], 0, false); p0 = __builtin_amdgcn_cvt_pk_fp8_f32(s[2 * 33], s[3 * 33], p0, true);
        int p1 = __builtin_amdgcn_cvt_pk_fp8_f32(s[4 * 33], s[5 * 33], 0, false); p1 = __builtin_amdgcn_cvt_pk_fp8_f32(s[6 * 33], s[7 * 33], p1, true);
        u32x2 o; o.x = (unsigned)p0; o.y = (unsigned)p1;
        *(GAS u32x2*)(WT8 + (size_t)(dst_row0 + n) * ldt + k0 + 8 * c) = o; }
    LDS_WAIT(); asm volatile("" ::: "memory");
}
constexpr float WIN_SCALE = 64.0f;
__device__ __forceinline__ void p0_prep(Frame& F) {
    LAS float* scr = (LAS float*)(F.lds + RING_OFF + F.wave * 16384);
    const int gw = F.vcu * NWAVES + F.wave, NGW = F.G * NWAVES, lane = F.lane;
    const float* x = F.in[0]; const float* norm_mix = F.in[1]; const float* w_in = F.in[2];
    const float* da_lambda = F.in[6];
    const float* w_a = F.in[9]; const float* w_b = F.in[10]; const float* w_out = F.in[11]; const float* norm_ffn = F.in[12]; const float* peer_query = F.in[13]; const float* subkeys = F.in[14];
    bf16* WIN = (bf16*)(F.ws + WS_WIN); bf16* WA = (bf16*)(F.ws + WS_WA); bf16* WB = (bf16*)(F.ws + WS_WB); bf16* WOUT = (bf16*)(F.ws + WS_WOUT); bf16* WQ = (bf16*)(F.ws + WS_WQ);
    bf16* SK = (bf16*)(F.ws + WS_SK); bf16* WIF = (bf16*)(F.ws + WS_WIF); bf16* XB = (bf16*)(F.ws + WS_XB); float* RSTD1 = (float*)(F.ws + WS_RSTD1);
    constexpr int I_IN = 32 * 352, I_A = 16 * 64, I_B = 16 * 64, I_OUT = 32 * 64, I_Q = 32 * 64, I_IF = 512, I_SK = 512, I_LAM = 1;
    constexpr int NITEMS = I_IN + I_A + I_B + I_OUT + I_Q + I_IF + I_SK + I_LAM;
    for (int it = gw; it < NITEMS; it += NGW) {
        int r = it;
        if (r < I_IN) { const int kb = r / 352, nb = r % 352, n0 = nb * 32;
            if (n0 < NSENS) transpose_item<true>(w_in, IN_WIDTH, n0, kb * 64, (bf16*)(F.ws + WS_WINB), DM, n0, norm_mix, scr, lane);
            else transpose_item8<true>(w_in, IN_WIDTH, n0 + (n0 >= 7168 ? 16 : 0), kb * 64, (unsigned char*)WIN, DM, n0 - NSENS, norm_mix, WIN_SCALE, scr, lane);
            continue; } r -= I_IN;
        if (r < I_A) { const int kb = r / 64, nb = r % 64; transpose_item<false>(w_a, 2048, nb * 32, kb * 64, WA, 1024, nb * 32, w_a, scr, lane); continue; } r -= I_A;
        if (r < I_B) { const int kb = r / 64, nb = r % 64; transpose_item<false>(w_b, 2048, nb * 32, kb * 64, WB, 1024, nb * 32, w_b, scr, lane); continue; } r -= I_B;
        if (r < I_OUT) { const int kb = r / 64, nb = r % 64; transpose_item<false>(w_out, 2048, nb * 32, kb * 64, WOUT, 2048, nb * 32, w_out, scr, lane); continue; } r -= I_OUT;
        if (r < I_Q) { const int kb = r / 64, nb = r % 64; transpose_item<true>(peer_query, 2048, nb * 32, kb * 64, WQ, 2048, nb * 32, norm_ffn, scr, lane); continue; } r -= I_Q;
        if (r < I_IF) { const int e = r * 64 + lane, j = e >> 11, k = e & 2047; WIF[e] = (bf16)f2bf(w_in[(size_t)k * IN_WIDTH + 7168 + j] * norm_mix[k]); continue; } r -= I_IF;
        if (r < I_SK) {
#pragma unroll
            for (int q = 0; q < 2; ++q) { const int e = r * 512 + q * 256 + lane * 4; const f32x4 v = *(const f32x4*)(subkeys + e); u32x2 w; w.x = pk2(v[0], v[1]); w.y = pk2(v[2], v[3]); *(u32x2*)(SK + e) = w; }
            continue; } r -= I_SK;
        { float a = da_lambda[lane] * da_lambda[64 + lane], b = da_lambda[128 + lane] * da_lambda[192 + lane]; a = wave_sum(a); b = wave_sum(b);
          if (lane == 0) ((float*)(F.ws + WS_LAM))[0] = __expf(a) - __expf(b) + 0.2f; }
    }
    unsigned char* XB8 = (unsigned char*)F.out;
    for (int m = gw; m < T; m += NGW) {
        const GAS f32x4* xr = (const GAS f32x4*)(x + (size_t)m * DM) + lane; f32x4 v[8]; float s = 0.f;
#pragma unroll
        for (int j = 0; j < 8; ++j) { v[j] = xr[64 * j]; s += (v[j][0] * v[j][0] + v[j][1] * v[j][1]) + (v[j][2] * v[j][2] + v[j][3] * v[j][3]); }
        s = wave_sum(s);
        const float rs = 1.0f / sqrtf(s * (1.0f / DM) + EPS);
        GAS unsigned* o = (GAS unsigned*)(XB8 + (size_t)m * DM) + lane; GAS u32x2* ob = (GAS u32x2*)(XB + (size_t)m * DM) + lane;
#pragma unroll
        for (int j = 0; j < 8; ++j) { int p = __builtin_amdgcn_cvt_pk_fp8_f32(v[j][0] * rs, v[j][1] * rs, 0, false); p = __builtin_amdgcn_cvt_pk_fp8_f32(v[j][2] * rs, v[j][3] * rs, p, true); o[64 * j] = (unsigned)p;
            u32x2 w; w.x = pk2(v[j][0], v[j][1]); w.y = pk2(v[j][2], v[j][3]); ob[64 * j] = w; }
        if (lane == 0) RSTD1[m] = rs;
    }
}

__device__ __forceinline__ void p1_ifgates(Frame& F) {
    const int rank_ = F.G == 256 ? (((F.vcu >> 6) << 5) | (F.vcu & 31)) : (F.vcu >> 1);
    const int gw = rank_ * NWAVES + F.wave, NGW = (F.G >> 1) * NWAVES, lane = F.lane;
    const bf16* WIF = (const bf16*)(F.ws + WS_WIF); const float* RSTD1 = (const float*)(F.ws + WS_RSTD1);
    const float* gbias = F.in[5]; float* IFO = (float*)(F.ws + WS_IF);
    for (int it = gw; it < T / 16; it += NGW) {
        const int t0 = it * 16; f32x4 acc = {0.f, 0.f, 0.f, 0.f};
        const bf16* ap = (const bf16*)(F.ws + WS_XB) + (size_t)(t0 + (lane & 15)) * DM + 8 * (lane >> 4); const bf16* bp = WIF + (size_t)(lane & 15) * DM + 8 * (lane >> 4);
#pragma unroll 8
        for (int ks = 0; ks < 64; ++ks) { const bf16x8 a = *(const bf16x8*)(ap + ks * 32); const bf16x8 b = *(const bf16x8*)(bp + ks * 32);
            acc = __builtin_amdgcn_mfma_f32_16x16x32_bf16(a, b, acc, 0, 0, 0); }
        const int col = lane & 15; const float bs = gbias[col];
#pragma unroll
        for (int j = 0; j < 4; ++j) { const int row = t0 + (lane >> 4) * 4 + j; IFO[(size_t)row * 16 + col] = acc[j] * RSTD1[row] + bs; }
    }
}

__device__ __forceinline__ void p2_conv_scan(Frame& F) {
    const float* conv_w = F.in[3]; const float* conv_b = F.in[4];
    const bf16* MQ = (const bf16*)(F.ws + WS_MQ); const bf16* MK = (const bf16*)(F.ws + WS_MK);
    bf16* MQC = (bf16*)((unsigned char*)F.out + OUT_MQC); bf16* MKC = (bf16*)((unsigned char*)F.out + OUT_MKC);
    const int nthr = F.G * 512, gt = F.vcu * 512 + F.tid;
    for (int item = gt; item < 256 * 1024; item += nthr) {
        const int cg = item & 255, run = item >> 8; const int c0 = (cg & 127) * 8; const bool isk = cg >= 128;
        const bf16* src = (isk ? MK : MQ) + c0; bf16* dst = (isk ? MKC : MQC) + c0; const int wc0 = (isk ? 1024 : 0) + c0;
        float w[4][8], bb[8];
#pragma unroll
        for (int j = 0; j < 4; ++j) { const f32x4 a = *(const f32x4*)(conv_w + j * 2048 + wc0), b = *(const f32x4*)(conv_w + j * 2048 + wc0 + 4);
            w[j][0] = a[0]; w[j][1] = a[1]; w[j][2] = a[2]; w[j][3] = a[3]; w[j][4] = b[0]; w[j][5] = b[1]; w[j][6] = b[2]; w[j][7] = b[3]; }
        { const f32x4 a = *(const f32x4*)(conv_b + wc0), b = *(const f32x4*)(conv_b + wc0 + 4); bb[0] = a[0]; bb[1] = a[1]; bb[2] = a[2]; bb[3] = a[3]; bb[4] = b[0]; bb[5] = b[1]; bb[6] = b[2]; bb[7] = b[3]; }
        const int t0 = run * 16; const bool first = (t0 & (SEQ - 1)) == 0;
        float h0[8], h1[8], h2[8];
#pragma unroll
        for (int e = 0; e < 8; ++e) { h0[e] = 0.f; h1[e] = 0.f; h2[e] = 0.f; }
        if (!first) {
            const v4u a = *(const v4u*)(src + (size_t)(t0 - 3) * 1024), b = *(const v4u*)(src + (size_t)(t0 - 2) * 1024), c = *(const v4u*)(src + (size_t)(t0 - 1) * 1024);
            h0[0] = bflo(a.x); h0[1] = bfhi(a.x); h0[2] = bflo(a.y); h0[3] = bfhi(a.y); h0[4] = bflo(a.z); h0[5] = bfhi(a.z); h0[6] = bflo(a.w); h0[7] = bfhi(a.w);
            h1[0] = bflo(b.x); h1[1] = bfhi(b.x); h1[2] = bflo(b.y); h1[3] = bfhi(b.y); h1[4] = bflo(b.z); h1[5] = bfhi(b.z); h1[6] = bflo(b.w); h1[7] = bfhi(b.w);
            h2[0] = bflo(c.x); h2[1] = bfhi(c.x); h2[2] = bflo(c.y); h2[3] = bfhi(c.y); h2[4] = bflo(c.z); h2[5] = bfhi(c.z); h2[6] = bflo(c.w); h2[7] = bfhi(c.w);
        }
        const float osc = isk ? 0.08838834764831845f : 1.0f;
        v4u dv[16];
#pragma unroll
        for (int i = 0; i < 16; ++i) dv[i] = *(const v4u*)(src + (size_t)(t0 + i) * 1024);
#pragma unroll
        for (int i = 0; i < 16; ++i) {
            const v4u d = dv[i]; float cur[8];
            cur[0] = bflo(d.x); cur[1] = bfhi(d.x); cur[2] = bflo(d.y); cur[3] = bfhi(d.y); cur[4] = bflo(d.z); cur[5] = bfhi(d.z); cur[6] = bflo(d.w); cur[7] = bfhi(d.w);
            float y[8];
#pragma unroll
            for (int e = 0; e < 8; ++e) { float v = bb[e] + w[0][e] * h0[e] + w[1][e] * h1[e] + w[2][e] * h2[e] + w[3][e] * cur[e]; v = v * pg8::sigmoidf_fast(v) * osc; y[e] = v; h0[e] = h1[e]; h1[e] = h2[e]; h2[e] = cur[e]; }
            v4u o; o.x = cvtpk(y[0], y[1]); o.y = cvtpk(y[2], y[3]); o.z = cvtpk(y[4], y[5]); o.w = cvtpk(y[6], y[7]);
            *(v4u*)(dst + (size_t)(t0 + i) * 1024) = o;
        }
    }
    if (F.vcu < 16) {
        const int bh = F.vcu, b = bh >> 3, h = bh & 7, tid = F.tid;
        const float* IFI = (const float*)(F.ws + WS_IF) + (size_t)b * SEQ * 16;
        float* FC = (float*)(F.ws + WS_FCUM) + (size_t)bh * SEQ; float* LI = (float*)(F.ws + WS_LIT) + (size_t)bh * SEQ;
        LAS float* sh = (LAS float*)(F.lds + RING_OFF);
        float lf[16]; float run = 0.f, lmax = -3.0e38f;
#pragma unroll
        for (int i = 0; i < 16; ++i) { const int t = tid * 16 + i; const float li = IFI[(size_t)t * 16 + h], fr = IFI[(size_t)t * 16 + 8 + h];
            const float ls = fminf(fr, 0.f) - log1pf(expf(-fabsf(fr))); run += ls; lf[i] = run; LI[t] = li; lmax = fmaxf(lmax, li); }
        float incl = run;
#pragma unroll
        for (int o = 1; o < 64; o <<= 1) { const float n = __shfl_up(incl, o); if (F.lane >= o) incl += n; }
        lmax = wave_max(lmax);
        if (F.lane == 63) sh[F.wave] = incl; if (F.lane == 0) sh[8 + F.wave] = lmax; __syncthreads();
        float base = incl - run, mx = sh[8];
#pragma unroll
        for (int w = 0; w < 8; ++w) { if (w < F.wave) base += sh[w]; mx = fmaxf(mx, sh[8 + w]); }
        if (tid == 0) ((float*)(F.ws + WS_LAM))[16 + bh] = mx;
#pragma unroll
        for (int i = 0; i < 16; ++i) FC[tid * 16 + i] = base + lf[i];
        __syncthreads();
    }
}

constexpr int SHM_V = 64 * 128 * 2, SHM_K = 64 * 128 * 2;
constexpr int FL_WS = 81920;
constexpr int FL_BTAB = FL_WS + 2048;
constexpr int FL_NTAB = FL_WS + 2048 + 512;
constexpr int FL_RED = FL_WS + 4096;
constexpr int FL_OT = FL_WS + 8192;
constexpr float ATT_MARGIN = 66.0f;
#define KSWZ(row, colB) ((row) * 256 + ((colB) ^ (((row) & 7) << 4)))
#define SBAR() __builtin_amdgcn_sched_barrier(0)
__device__ __forceinline__ int crow(int r, int hi) { return (r & 3) + 8 * (r >> 2) + 4 * hi; }
__device__ __forceinline__ int v_st(int k, int c) { const int kk = (k & ~0xC) | ((k & 4) << 1) | ((k & 8) >> 1); return ((kk >> 3) * 4 + (c >> 5)) * 512 + ((kk & 7) * 32 + (c & 31)) * 2; }
__device__ __forceinline__ int v_rd_base(int lane) { return ((lane & 3) << 3) | (((lane >> 2) & 3) << 6) | (((lane >> 4) & 1) << 5) | (((lane >> 5) & 1) << 8); }
constexpr int v_rd_off(int d0, int ks, int half) { return d0 * 512 + ks * 4096 + half * 2048; }
template <int OFF> __device__ __forceinline__ s16x4 tr_read(int vb) { s16x4 r; asm volatile("ds_read_b64_tr_b16 %0, %1 offset:%2" : "=&v"(r) : "v"(vb), "i"(OFF) : "memory"); return r; }
#define PKF(L, H) (bf16x8){L[0], L[1], L[2], L[3], H[0], H[1], H[2], H[3]}
template <int D0> __device__ __forceinline__ void pv_one(f32x16& od, int vb, bf16x8 pa0, bf16x8 pa1, bf16x8 pa2, bf16x8 pa3) {
    const s16x4 l0 = tr_read<v_rd_off(D0, 0, 0)>(vb), h0 = tr_read<v_rd_off(D0, 0, 1)>(vb), l1 = tr_read<v_rd_off(D0, 1, 0)>(vb), h1 = tr_read<v_rd_off(D0, 1, 1)>(vb);
    const s16x4 l2 = tr_read<v_rd_off(D0, 2, 0)>(vb), h2 = tr_read<v_rd_off(D0, 2, 1)>(vb), l3 = tr_read<v_rd_off(D0, 3, 0)>(vb), h3 = tr_read<v_rd_off(D0, 3, 1)>(vb);
    asm volatile("s_waitcnt lgkmcnt(0)" ::: "memory"); SBAR();
    od = __builtin_amdgcn_mfma_f32_32x32x16_bf16(pa0, PKF(l0, h0), od, 0, 0, 0);
    od = __builtin_amdgcn_mfma_f32_32x32x16_bf16(pa1, PKF(l1, h1), od, 0, 0, 0);
    od = __builtin_amdgcn_mfma_f32_32x32x16_bf16(pa2, PKF(l2, h2), od, 0, 0, 0);
    od = __builtin_amdgcn_mfma_f32_32x32x16_bf16(pa3, PKF(l3, h3), od, 0, 0, 0);
}
__device__ __forceinline__ void pv_d0(f32x16* o, int vb, bf16x8 pa0, bf16x8 pa1, bf16x8 pa2, bf16x8 pa3) {
    pv_one<0>(o[0], vb, pa0, pa1, pa2, pa3); pv_one<1>(o[1], vb, pa0, pa1, pa2, pa3); pv_one<2>(o[2], vb, pa0, pa1, pa2, pa3); pv_one<3>(o[3], vb, pa0, pa1, pa2, pa3);
}
__device__ __forceinline__ void pack_p(const f32x16& p0, const f32x16& p1, bf16x8& pa0, bf16x8& pa1, bf16x8& pa2, bf16x8& pa3) {
#define PK4(P, BASE, OUT) do { unsigned a0 = cvtpk(P[BASE + 0], P[BASE + 1]), a1 = cvtpk(P[BASE + 2], P[BASE + 3]);   \
    unsigned b0 = cvtpk(P[BASE + 4], P[BASE + 5]), b1 = cvtpk(P[BASE + 6], P[BASE + 7]);                              \
    auto r0 = __builtin_amdgcn_permlane32_swap(a0, b0, false, false); auto r1 = __builtin_amdgcn_permlane32_swap(a1, b1, false, false); \
    v4u w = {r0[0], r1[0], r0[1], r1[1]}; OUT = *reinterpret_cast<bf16x8*>(&w); } while (0)
    PK4(p0, 0, pa0); PK4(p0, 8, pa1); PK4(p1, 0, pa2); PK4(p1, 8, pa3);
#undef PK4
}
__device__ __forceinline__ float half_swap_sum(float v) { auto rr = __builtin_amdgcn_permlane32_swap(__float_as_uint(v), __float_as_uint(v), false, false); return __uint_as_float(rr[0]) + __uint_as_float(rr[1]); }
__device__ __forceinline__ float half_swap_max(float v) { auto rr = __builtin_amdgcn_permlane32_swap(__float_as_uint(v), __float_as_uint(v), false, false); return fmaxf(__uint_as_float(rr[0]), __uint_as_float(rr[1])); }
__device__ __forceinline__ float half_sum32(float v) { v += __shfl_xor(v, 1); v += __shfl_xor(v, 2); v += __shfl_xor(v, 4); v += __shfl_xor(v, 8); v += __shfl_xor(v, 16); return v; }

__device__ __forceinline__ void attn_unit(Frame& F, char* lds, int b, int h, int u, bf16* BA) {
    const int tid = F.tid, wid = F.wave, lane = F.lane, r32 = lane & 31, hi = lane >> 5, map = wid >> 2, wq = wid & 3;
    char* V_lds = lds; char* K_lds = lds + 2 * SHM_V;
    float* wsf = (float*)(lds + FL_WS) + wid * 64; float* li_l = wsf; float* al_l = wsf + 32;
    const size_t rowbase = (size_t)b * SEQ;
    const bf16* QA = (const bf16*)(F.ws + WS_QA); const bf16* KA = (const bf16*)(F.ws + WS_KA); const bf16* VA = (const bf16*)(F.ws + WS_VA);
    const bf16* Qw = QA + (rowbase + 128 * u + wq * 32 + r32) * 1024 + h * 128 + map * 64 + hi * 8;
    bf16x8 qr[4];
#pragma unroll
    for (int d0 = 0; d0 < 4; ++d0) qr[d0] = *reinterpret_cast<const bf16x8*>(Qw + d0 * 16);
    const bf16* Kh = KA + rowbase * 1024 + h * 128; const bf16* Vh = VA + rowbase * 1024 + h * 128;
    const int vb0 = (int)(uintptr_t)V_lds + v_rd_base(lane);
    const int NT = 2 * u + 2, qchunk = 2 * u + (wq >> 1), qrel = wq * 32 + r32;
    unsigned kvo[2], vvo[2];
#pragma unroll
    for (int i = 0; i < 2; ++i) { const int off = (wid * 2 + i) * 1024 + lane * 16;
        { const int r = off >> 8, chs = (off >> 4) & 15, ch = chs ^ (r & 7); kvo[i] = (unsigned)(r * 2048 + ch * 16); }
        { const int s = off >> 9, kk = (s >> 2) * 8 + ((lane & 31) >> 2), c = (s & 3) * 32 + (lane & 3) * 8, k = (kk & ~0xC) | ((kk & 4) << 1) | ((kk & 8) >> 1); vvo[i] = (unsigned)(k * 2048 + c * 2); } }
    const unsigned ldsK = (unsigned)__builtin_amdgcn_readfirstlane((int)((unsigned)(uintptr_t)K_lds + (unsigned)wid * 2048u)), ldsV = (unsigned)__builtin_amdgcn_readfirstlane((int)((unsigned)(uintptr_t)V_lds + (unsigned)wid * 2048u));
#define DMA16(voff, sbase, ldsdst, imm) asm volatile("s_add_u32 m0, %2, %3\n\ts_nop 0\n\tglobal_load_lds_dwordx4 %0, %1" : : "v"(voff), "s"(sbase), "s"(ldsdst), "i"(imm) : "memory", "scc")
#define DMAK(jj, slot) do { const char* sb_ = (const char*)(Kh + (size_t)(64 * (NT - 1 - (jj))) * 1024); const unsigned ld_ = ldsK + (unsigned)(slot) * (unsigned)SHM_K; DMA16(kvo[0], sb_, ld_, 0); DMA16(kvo[1], sb_, ld_, 1024); } while (0)
#define DMAV(jj, slot) do { const char* sb_ = (const char*)(Vh + (size_t)(64 * (NT - 1 - (jj))) * 1024); const unsigned ld_ = ldsV + (unsigned)(slot) * (unsigned)SHM_V; DMA16(vvo[0], sb_, ld_, 0); DMA16(vvo[1], sb_, ld_, 1024); } while (0)
    const float slope2 = __builtin_amdgcn_exp2f(-(float)(h + 1)) * LOG2E;
    float m_reg, l_reg = 0.f; f32x16 o[4] = {};
    float sbound;
    { float qn = 0.f;
#pragma unroll
      for (int d0 = 0; d0 < 4; ++d0) { const v4u qq = __builtin_bit_cast(v4u, qr[d0]);
#pragma unroll
          for (int c = 0; c < 4; ++c) { const float a = bflo(qq[c]), b2 = bfhi(qq[c]); qn += a * a + b2 * b2; } }
      qn = half_swap_sum(qn);
      const unsigned* km = (const unsigned*)(F.ctl + CW_KMAX) + b * 32 + 4 * h + 2 * map;
      const float kmax2 = __uint_as_float(km[0]) + __uint_as_float(km[1]);
      sbound = sqrtf(qn * kmax2) * 1.01f + 1.0f; }
    m_reg = slope2 * (float)qrel - sbound;
    int* jst = (int*)(lds + FL_NTAB); int jstop = 0;
#define SCORE(P0, P1, jj, slot) do { const int jt_ = NT - 1 - (jj); const int kb_ = 64 * jt_ - 128 * u + 4 * hi; \
        if (jt_ > qchunk) { _Pragma("unroll") for (int r = 0; r < 16; ++r) { P0[r] = -1e30f; P1[r] = -1e30f; } } \
        else { if (jt_ == qchunk) { _Pragma("unroll") for (int r = 0; r < 16; ++r) { const int k0_ = kb_ + (r & 3) + 8 * (r >> 2), k1_ = k0_ + 32; P0[r] = slope2 * (float)min(k0_, 2 * qrel - k0_) - m_reg; P1[r] = slope2 * (float)min(k1_, 2 * qrel - k1_) - m_reg; } } \
               else { const float bb0_ = slope2 * (float)kb_ - m_reg; _Pragma("unroll") for (int r = 0; r < 16; ++r) { P0[r] = fmaf(slope2, (float)((r & 3) + 8 * (r >> 2)), bb0_); P1[r] = P0[r] + 32.f * slope2; } } \
               const char* Ks_ = K_lds + (slot) * SHM_K; \
               _Pragma("unroll") for (int d0 = 0; d0 < 4; ++d0) { const int cb_ = (map * 64 + d0 * 16 + hi * 8) * 2; \
                   const bf16x8 b0_ = *reinterpret_cast<const bf16x8*>(Ks_ + KSWZ(r32, cb_)), b1_ = *reinterpret_cast<const bf16x8*>(Ks_ + KSWZ(32 + r32, cb_)); \
                   P0 = __builtin_amdgcn_mfma_f32_32x32x16_bf16(b0_, qr[d0], P0, 0, 0, 0); P1 = __builtin_amdgcn_mfma_f32_32x32x16_bf16(b1_, qr[d0], P1, 0, 0, 0); } } } while (0)
#define STEP(PC0, PC1, PN0, PN1, jj) do { \
        if ((jj) + 2 < NT) DMAK((jj) + 2, ((jj) + 2) % 3); \
        if ((jj) + 1 < NT) DMAV((jj) + 1, ((jj) + 1) & 1); \
        if ((jj) + 1 < NT) SCORE(PN0, PN1, (jj) + 1, ((jj) + 1) % 3); \
        float pmax = PC0[0]; \
        _Pragma("unroll") for (int r = 1; r < 16; ++r) pmax = fmaxf(pmax, PC0[r]); \
        _Pragma("unroll") for (int r = 0; r < 16; ++r) pmax = fmaxf(pmax, PC1[r]); \
        pmax = half_swap_max(pmax); \
        float alpha = 1.f; \
        if (!__all(pmax <= 8.0f)) { const float dl = fmaxf(pmax, 0.f); alpha = __builtin_amdgcn_exp2f(-dl); m_reg += dl; \
            _Pragma("unroll") for (int r = 0; r < 16; ++r) { PC0[r] -= dl; PC1[r] -= dl; } \
            if ((jj) + 1 < NT) { _Pragma("unroll") for (int r = 0; r < 16; ++r) { PN0[r] -= dl; PN1[r] -= dl; } } } \
        float ps = 0.f; \
        _Pragma("unroll") for (int r = 0; r < 16; ++r) { PC0[r] = __builtin_amdgcn_exp2f(PC0[r]); PC1[r] = __builtin_amdgcn_exp2f(PC1[r]); ps += PC0[r] + PC1[r]; } \
        ps = half_swap_sum(ps); \
        l_reg = l_reg * alpha + ps; \
        bf16x8 pa0, pa1, pa2, pa3; pack_p(PC0, PC1, pa0, pa1, pa2, pa3); \
        if (__any(alpha < 1.f)) { if (hi == 0) al_l[r32] = alpha; asm volatile("s_waitcnt lgkmcnt(0)" ::: "memory"); \
            _Pragma("unroll") for (int d = 0; d < 4; ++d) _Pragma("unroll") for (int r = 0; r < 16; ++r) o[d][r] *= al_l[crow(r, hi)]; } \
        SBAR(); \
        pv_d0(o, vb0 + ((jj) & 1) * SHM_V, pa0, pa1, pa2, pa3); \
        SBAR(); \
        if ((jj) == 1) { const float nf = (m_reg - ATT_MARGIN - sbound) / (64.f * slope2) + (float)(128 * u - 63) * (1.0f / 64.0f); int js = (int)ceilf(fmaxf(nf, 0.f)); \
            _Pragma("unroll") for (int o_ = 1; o_ < 64; o_ <<= 1) js = min(js, __shfl_xor(js, o_)); \
            if (lane == 0) jst[wid] = js; } \
        asm volatile("s_waitcnt vmcnt(0)" ::: "memory"); \
        __syncthreads(); } while (0)
    DMAK(0, 0); DMAV(0, 0); DMAK(1, 1);
    asm volatile("s_waitcnt vmcnt(0)" ::: "memory"); __syncthreads();
    f32x16 pA0, pA1, pB0, pB1;
    SCORE(pA0, pA1, 0, 0);
    for (int j = 0; j < NT; j += 2) {
        if (j == 2) { jstop = jst[0];
#pragma unroll
            for (int w = 1; w < 8; ++w) jstop = min(jstop, jst[w]); }
        if (NT - 1 - j < jstop) break;
        STEP(pA0, pA1, pB0, pB1, j);
        if (NT - 2 - j < jstop) break;
        STEP(pB0, pB1, pA0, pA1, j + 1);
    }
#undef DMAK
#undef DMAV
#undef DMA16
#undef SCORE
#undef STEP
    __syncthreads();
    if (hi == 0) li_l[r32] = l_reg; asm volatile("s_waitcnt lgkmcnt(0)" ::: "memory");
    float rli[16];
#pragma unroll
    for (int r = 0; r < 16; ++r) rli[r] = __builtin_amdgcn_rcpf(li_l[crow(r, hi)]);
    float* X = (float*)lds + wq * 4096;
    if (map == 1) {
#pragma unroll
        for (int r = 0; r < 16; ++r)
#pragma unroll
            for (int d0 = 0; d0 < 4; ++d0) X[crow(r, hi) * 128 + d0 * 32 + r32] = o[d0][r] * rli[r];
    }
    __syncthreads();
    if (map == 0) {
        const float lam = ((const float*)(F.ws + WS_LAM))[0]; const float* subln = F.in[7];
        float g[4];
#pragma unroll
        for (int d0 = 0; d0 < 4; ++d0) g[d0] = subln[d0 * 32 + r32] * 0.8f;
        bf16* OT = (bf16*)(lds + FL_OT);
#pragma unroll
        for (int r = 0; r < 16; ++r) { float dv[4]; float s = 0.f;
#pragma unroll
            for (int d0 = 0; d0 < 4; ++d0) { dv[d0] = o[d0][r] * rli[r] - lam * X[crow(r, hi) * 128 + d0 * 32 + r32]; s += dv[d0] * dv[d0]; }
            s = half_sum32(s); const float rs = 1.0f / sqrtf(s * (1.0f / 128.0f) + EPS);
#pragma unroll
            for (int d0 = 0; d0 < 4; ++d0) OT[(wq * 32 + crow(r, hi)) * 128 + d0 * 32 + r32] = (bf16)f2bf(dv[d0] * rs * g[d0]); }
    }
    __syncthreads();
#pragma unroll
    for (int i = 0; i < 4; ++i) { const int p = tid + 512 * i, row = p >> 4, ch = p & 15;
        *(v4u*)(BA + (rowbase + 128 * u + row) * 1024 + h * 128 + ch * 8) = *(const v4u*)(lds + FL_OT + row * 256 + ch * 16); }
}

__device__ __forceinline__ void mlstm_seg_task(Frame& F, char* lds, int bh, int seg) {
    const int tid = F.tid, wid = F.wave, lane = F.lane, b = bh >> 3, h = bh & 7;
    char* V_lds = lds; char* K_lds = lds + 2 * SHM_V;
    float* wtab = (float*)(lds + FL_RED);
    float* red = (float*)(lds + FL_WS);
    const size_t rowbase = (size_t)b * SEQ + (size_t)seg * SEGTOK;
    const float* FC = (const float*)(F.ws + WS_FCUM) + (size_t)bh * SEQ + seg * SEGTOK; const float* LI = (const float*)(F.ws + WS_LIT) + (size_t)bh * SEQ + seg * SEGTOK;
    const bf16* Kh = (const bf16*)((const unsigned char*)F.out + OUT_MKC) + rowbase * 1024 + h * 128; const bf16* Vh = (const bf16*)(F.ws + WS_MV) + rowbase * 1024 + h * 128;
    const float li0 = LI[tid], li1 = LI[512 + tid];
    float mx = wave_max(fmaxf(li0, li1)); if (lane == 0) red[wid] = mx; __syncthreads();
    float Lseg = red[0];
#pragma unroll
    for (int i = 1; i < 8; ++i) Lseg = fmaxf(Lseg, red[i]);
    const float FE = FC[SEGTOK - 1];
    wtab[tid] = __expf(FE - FC[tid] + li0 - Lseg); wtab[512 + tid] = __expf(FE - FC[512 + tid] + li1 - Lseg);
    __syncthreads();
    const int sr = tid >> 4, sc = (tid & 15) * 8, vst0 = v_st(sr, sc), vst1 = v_st(32 + sr, sc);
    const int vbV = (int)(uintptr_t)V_lds + v_rd_base(lane), vbK = (int)(uintptr_t)K_lds + v_rd_base(lane);
    v4u vs0, vs1, ks0, ks1; float npart[8];
#pragma unroll
    for (int e = 0; e < 8; ++e) npart[e] = 0.f;
#define SLOAD(k0) do { vs0 = *(const v4u*)(&Vh[(size_t)((k0) + sr) * 1024 + sc]); vs1 = *(const v4u*)(&Vh[(size_t)((k0) + 32 + sr) * 1024 + sc]); \
    ks0 = *(const v4u*)(&Kh[(size_t)((k0) + sr) * 1024 + sc]); ks1 = *(const v4u*)(&Kh[(size_t)((k0) + 32 + sr) * 1024 + sc]); } while (0)
#define KW(kv, wv, outv) do { float f0 = bflo(kv.x) * wv, f1 = bfhi(kv.x) * wv, f2 = bflo(kv.y) * wv, f3 = bfhi(kv.y) * wv, f4 = bflo(kv.z) * wv, f5 = bfhi(kv.z) * wv, f6 = bflo(kv.w) * wv, f7 = bfhi(kv.w) * wv; \
    npart[0] += f0; npart[1] += f1; npart[2] += f2; npart[3] += f3; npart[4] += f4; npart[5] += f5; npart[6] += f6; npart[7] += f7; \
    outv.x = cvtpk(f0, f1); outv.y = cvtpk(f2, f3); outv.z = cvtpk(f4, f5); outv.w = cvtpk(f6, f7); } while (0)
#define SWRITE(bb, k0) do { *(v4u*)(V_lds + (bb) * SHM_V + vst0) = vs0; *(v4u*)(V_lds + (bb) * SHM_V + vst1) = vs1; \
    const float w0_ = wtab[(k0) + sr], w1_ = wtab[(k0) + 32 + sr]; v4u q0_, q1_; KW(ks0, w0_, q0_); KW(ks1, w1_, q1_); \
    *(v4u*)(K_lds + (bb) * SHM_K + vst0) = q0_; *(v4u*)(K_lds + (bb) * SHM_K + vst1) = q1_; } while (0)
    f32x16 acc0 = {}, acc1 = {};
    const int db = wid >> 1, eb0 = 2 * (wid & 1);
    SLOAD(0); asm volatile("s_waitcnt vmcnt(0)" ::: "memory"); SWRITE(0, 0); SLOAD(64); __syncthreads();
    constexpr int NT = SEGTOK / 64;
    for (int j = 0; j < NT; ++j) {
        const int buf = j & 1; const int ka = vbK + buf * SHM_K + db * 512, va = vbV + buf * SHM_V + eb0 * 512;
        s16x4 al[4], ah[4], bl0[4], bh0[4], bl1[4], bh1[4];
#define RD4(KS) do { al[KS] = tr_read<v_rd_off(0, KS, 0)>(ka); ah[KS] = tr_read<v_rd_off(0, KS, 1)>(ka); bl0[KS] = tr_read<v_rd_off(0, KS, 0)>(va); bh0[KS] = tr_read<v_rd_off(0, KS, 1)>(va); \
    bl1[KS] = tr_read<v_rd_off(1, KS, 0)>(va); bh1[KS] = tr_read<v_rd_off(1, KS, 1)>(va); } while (0)
        RD4(0); RD4(1); RD4(2); RD4(3);
#undef RD4
        asm volatile("s_waitcnt lgkmcnt(0)" ::: "memory"); SBAR();
#pragma unroll
        for (int ks = 0; ks < 4; ++ks) { const bf16x8 a = PKF(al[ks], ah[ks]);
            acc0 = __builtin_amdgcn_mfma_f32_32x32x16_bf16(a, PKF(bl0[ks], bh0[ks]), acc0, 0, 0, 0);
            acc1 = __builtin_amdgcn_mfma_f32_32x32x16_bf16(a, PKF(bl1[ks], bh1[ks]), acc1, 0, 0, 0); }
        if (j + 1 < NT) { asm volatile("s_waitcnt vmcnt(0)" ::: "memory"); SWRITE(buf ^ 1, 64 * (j + 1)); if (j + 2 < NT) SLOAD(64 * (j + 2)); }
        __syncthreads();
    }
#undef SLOAD
#undef SWRITE
#undef KW
    float* CS = (float*)(F.ws + WS_CSEG) + (size_t)(bh * NSEG + seg) * CSEG_STRIDE;
    const int r32 = lane & 31, hi = lane >> 5;
#pragma unroll
    for (int r = 0; r < 16; ++r) { const int d = 32 * db + crow(r, hi); CS[d * 128 + 32 * eb0 + r32] = acc0[r]; CS[d * 128 + 32 * (eb0 + 1) + r32] = acc1[r]; }
    float* nred = (float*)lds;
#pragma unroll
    for (int e = 0; e < 8; ++e) nred[sr * 128 + sc + e] = npart[e];
    __syncthreads();
    if (tid < 128) { float s = 0.f; for (int i = 0; i < 32; ++i) s += nred[i * 128 + tid]; CS[128 * 128 + tid] = s; }
    if (tid == 0) CS[128 * 128 + 128] = Lseg;
    asm volatile("s_waitcnt vmcnt(0)" ::: "memory"); __syncthreads();
    if (tid == 0) { __builtin_amdgcn_fence(__ATOMIC_RELEASE, "agent"); asm volatile("s_waitcnt vmcnt(0)" ::: "memory");
        __hip_atomic_fetch_add((unsigned*)(F.ctl + CW_SEGCNT + 64 * bh), 1u, __ATOMIC_RELAXED, __HIP_MEMORY_SCOPE_AGENT); }
    __syncthreads();
}

__device__ __forceinline__ void mlstm_unit(Frame& F, char* lds, int bh, int sj, int qi, bf16* BB) {
    const int tid = F.tid, wid = F.wave, lane = F.lane, r32 = lane & 31, hi = lane >> 5, b = bh >> 3, h = bh & 7;
    char* V_lds = lds; char* K_lds = lds + 2 * SHM_V;
    float* wsf = (float*)(lds + FL_WS) + wid * 64; float* li_l = wsf; float* al_l = wsf + 32;
    float* btab = (float*)(lds + FL_BTAB); float* ntab = (float*)(lds + FL_NTAB);
    const size_t segrow = (size_t)b * SEQ + (size_t)sj * SEGTOK;
    const int tl0 = qi * 256;
    const float* FCb = (const float*)(F.ws + WS_FCUM) + (size_t)bh * SEQ; const float* LIb = (const float*)(F.ws + WS_LIT) + (size_t)bh * SEQ;
    const float L = ((const float*)(F.ws + WS_LAM))[16 + bh];
    const float Fref = sj > 0 ? FCb[sj * SEGTOK - 1] : 0.f;
    const bf16* MQC = (const bf16*)((const unsigned char*)F.out + OUT_MQC);
    const bf16* Kh = (const bf16*)((const unsigned char*)F.out + OUT_MKC) + segrow * 1024 + h * 128; const bf16* Vh = (const bf16*)(F.ws + WS_MV) + segrow * 1024 + h * 128;
    const int trow = tl0 + wid * 32 + r32;
    const bf16* Qw = MQC + (segrow + trow) * 1024 + h * 128 + hi * 8;
    bf16x8 qr[8];
#pragma unroll
    for (int d0 = 0; d0 < 8; ++d0) qr[d0] = *reinterpret_cast<const bf16x8*>(Qw + d0 * 16);
    const float At = (FCb[sj * SEGTOK + trow] - Fref) * LOG2E;
    const int sr = tid >> 4, sc = (tid & 15) * 8, vst0 = v_st(sr, sc), vst1 = v_st(32 + sr, sc);
    const int vb0 = (int)(uintptr_t)V_lds + v_rd_base(lane);
    float l_reg = 0.f; f32x16 o[4] = {};
    if (sj > 0) {
        if (tid == 0) { unsigned sp = 0; while (__hip_atomic_load((unsigned*)(F.ctl + CW_SEGCNT + 64 * bh), __ATOMIC_RELAXED, __HIP_MEMORY_SCOPE_AGENT) < (unsigned)NSEG) { __builtin_amdgcn_s_sleep(2); if (++sp > (1u << 22)) break; }
            __builtin_amdgcn_fence(__ATOMIC_ACQUIRE, "agent"); asm volatile("s_waitcnt vmcnt(0)" ::: "memory"); }
        __syncthreads();
        const float* CS = (const float*)(F.ws + WS_CSEG) + (size_t)(bh * NSEG) * CSEG_STRIDE;
        f32x4 ca[4][2]; float ns = 0.f;
#pragma unroll
        for (int q = 0; q < 4; ++q) { ca[q][0] = (f32x4){0.f, 0.f, 0.f, 0.f}; ca[q][1] = (f32x4){0.f, 0.f, 0.f, 0.f}; }
#pragma unroll 1
        for (int i = 0; i < sj; ++i) { const float* Ci = CS + (size_t)i * CSEG_STRIDE; const float cf = __expf(Fref - FCb[(i + 1) * SEGTOK - 1] + Ci[128 * 128 + 128] - L);
#pragma unroll
            for (int q = 0; q < 4; ++q) { const float* p = Ci + (q * 32 + sr) * 128 + sc; ca[q][0] += cf * *(const f32x4*)p; ca[q][1] += cf * *(const f32x4*)(p + 4); }
            if (tid < 128) ns += cf * Ci[128 * 128 + tid]; }
#pragma unroll
        for (int q = 0; q < 4; ++q) { v4u w; w.x = cvtpk(ca[q][0][0], ca[q][0][1]); w.y = cvtpk(ca[q][0][2], ca[q][0][3]); w.z = cvtpk(ca[q][1][0], ca[q][1][1]); w.w = cvtpk(ca[q][1][2], ca[q][1][3]);
            *(v4u*)(V_lds + (q >> 1) * SHM_V + ((q & 1) ? vst1 : vst0)) = w; }
        if (tid < 128) ntab[tid] = ns;
        __syncthreads();
        pv_d0(o, vb0, qr[0], qr[1], qr[2], qr[3]);
        pv_d0(o, vb0 + SHM_V, qr[4], qr[5], qr[6], qr[7]);
        float dn = 0.f;
#pragma unroll
        for (int d0 = 0; d0 < 8; ++d0) { const v4u qq = __builtin_bit_cast(v4u, qr[d0]); const float* nt = ntab + d0 * 16 + hi * 8;
            dn += bflo(qq.x) * nt[0] + bfhi(qq.x) * nt[1] + bflo(qq.y) * nt[2] + bfhi(qq.y) * nt[3] + bflo(qq.z) * nt[4] + bfhi(qq.z) * nt[5] + bflo(qq.w) * nt[6] + bfhi(qq.w) * nt[7]; }
        dn = half_swap_sum(dn);
        const float rsc = __builtin_amdgcn_exp2f(At);
        l_reg = rsc * dn;
        if (hi == 0) al_l[r32] = rsc; asm volatile("s_waitcnt lgkmcnt(0)" ::: "memory");
#pragma unroll
        for (int d = 0; d < 4; ++d)
#pragma unroll
            for (int r = 0; r < 16; ++r) o[d][r] *= al_l[crow(r, hi)];
        __syncthreads();
    }
    v4u vs0, vs1, ks0, ks1; float bt = 0.f;
#define SLOAD(k0) do { vs0 = *(const v4u*)(&Vh[(size_t)((k0) + sr) * 1024 + sc]); vs1 = *(const v4u*)(&Vh[(size_t)((k0) + 32 + sr) * 1024 + sc]); \
    ks0 = *(const v4u*)(&Kh[(size_t)((k0) + sr) * 1024 + sc]); ks1 = *(const v4u*)(&Kh[(size_t)((k0) + 32 + sr) * 1024 + sc]); \
    if (tid < 64) { const int s_ = sj * SEGTOK + (k0) + tid; bt = (LIb[s_] - L - (FCb[s_] - Fref)) * LOG2E; } } while (0)
#define SWRITE(bb) do { *(v4u*)(V_lds + (bb) * SHM_V + vst0) = vs0; *(v4u*)(V_lds + (bb) * SHM_V + vst1) = vs1; const int kc = sc * 2; \
    *(v4u*)(K_lds + (bb) * SHM_K + KSWZ(sr, kc)) = ks0; *(v4u*)(K_lds + (bb) * SHM_K + KSWZ(32 + sr, kc)) = ks1; if (tid < 64) btab[(bb) * 64 + tid] = bt; } while (0)
    const int NT = 4 * qi + 4, qc = 4 * qi + (wid >> 1), trel = (wid * 32 + r32) & 63;
    SLOAD(0); asm volatile("s_waitcnt vmcnt(0)" ::: "memory"); SWRITE(0); SLOAD(64); __syncthreads();
    for (int j = 0; j < NT; ++j) {
        const int buf = j & 1;
        if (j <= qc) {
            f32x16 p0 = {}, p1 = {};
            const char* Ks = K_lds + buf * SHM_K;
#pragma unroll
            for (int d0 = 0; d0 < 8; ++d0) { const int cb = (d0 * 16 + hi * 8) * 2;
                const bf16x8 b0 = *reinterpret_cast<const bf16x8*>(Ks + KSWZ(r32, cb)), b1 = *reinterpret_cast<const bf16x8*>(Ks + KSWZ(32 + r32, cb));
                p0 = __builtin_amdgcn_mfma_f32_32x32x16_bf16(b0, qr[d0], p0, 0, 0, 0); p1 = __builtin_amdgcn_mfma_f32_32x32x16_bf16(b1, qr[d0], p1, 0, 0, 0); if (d0 == 3) SBAR(); }
            const float* bp = btab + buf * 64 + 4 * hi; float ps = 0.f; const bool diag = (j == qc);
#pragma unroll
            for (int r = 0; r < 16; ++r) { const int kk = (r & 3) + 8 * (r >> 2);
                float w0 = __builtin_amdgcn_exp2f(At + bp[kk]), w1 = __builtin_amdgcn_exp2f(At + bp[kk + 32]);
                if (diag) { if (kk + 4 * hi > trel) w0 = 0.f; if (kk + 32 + 4 * hi > trel) w1 = 0.f; }
                p0[r] *= w0; p1[r] *= w1; ps += p0[r] + p1[r]; }
            l_reg += half_swap_sum(ps);
            bf16x8 pa0, pa1, pa2, pa3; pack_p(p0, p1, pa0, pa1, pa2, pa3);
            SBAR();
            pv_d0(o, vb0 + buf * SHM_V, pa0, pa1, pa2, pa3);
        }
        if (j + 1 < NT) { asm volatile("s_waitcnt vmcnt(0)" ::: "memory"); SWRITE(buf ^ 1); if (j + 2 < NT) SLOAD(64 * (j + 2)); }
        __syncthreads();
    }
#undef SLOAD
#undef SWRITE
    const float den = fmaxf(fabsf(l_reg), __expf(-L));
    if (hi == 0) li_l[r32] = den; asm volatile("s_waitcnt lgkmcnt(0)" ::: "memory");
    const float* hn = F.in[8] + h * 128;
    float g[4];
#pragma unroll
    for (int d0 = 0; d0 < 4; ++d0) g[d0] = hn[d0 * 32 + r32];
    bf16* OT = (bf16*)lds;
#pragma unroll
    for (int r = 0; r < 16; ++r) { const float rd = __builtin_amdgcn_rcpf(li_l[crow(r, hi)]); float hv[4]; float s = 0.f;
#pragma unroll
        for (int d0 = 0; d0 < 4; ++d0) { hv[d0] = o[d0][r] * rd; s += hv[d0] * hv[d0]; }
        s = half_sum32(s); const float rs = 1.0f / sqrtf(s * (1.0f / 128.0f) + EPS);
#pragma unroll
        for (int d0 = 0; d0 < 4; ++d0) OT[(wid * 32 + crow(r, hi)) * 128 + d0 * 32 + r32] = (bf16)f2bf(hv[d0] * rs * g[d0]); }
    __syncthreads();
    const bf16* MO = (const bf16*)(F.ws + WS_MO);
    v4u mq[8];
#pragma unroll
    for (int i = 0; i < 8; ++i) { const int p = tid + 512 * i, row = p >> 4, ch = p & 15; mq[i] = *(const v4u*)(MO + (segrow + tl0 + row) * 1024 + h * 128 + ch * 8); }
#pragma unroll
    for (int i = 0; i < 8; ++i) { const int p = tid + 512 * i, row = p >> 4, ch = p & 15; const size_t goff = (segrow + tl0 + row) * 1024 + h * 128 + ch * 8;
        const v4u a = *(const v4u*)(lds + row * 256 + ch * 16), m = mq[i]; v4u w;
        w.x = cvtpk(bflo(a.x) * bflo(m.x), bfhi(a.x) * bfhi(m.x)); w.y = cvtpk(bflo(a.y) * bflo(m.y), bfhi(a.y) * bfhi(m.y));
        w.z = cvtpk(bflo(a.z) * bflo(m.z), bfhi(a.z) * bfhi(m.z)); w.w = cvtpk(bflo(a.w) * bflo(m.w), bfhi(a.w) * bfhi(m.w));
        *(v4u*)(BB + goff) = w; }
    __syncthreads();
}

__device__ __forceinline__ unsigned fkey(float f) { const unsigned u = __float_as_uint(f); return (u & 0x80000000u) ? ~u : (u | 0x80000000u); }
__device__ __forceinline__ float funkey(unsigned k) { const unsigned u = (k & 0x80000000u) ? (k & 0x7fffffffu) : ~k; return __uint_as_float(u); }
#define CE(a, b) do { const unsigned h_ = max(a, b), l_ = min(a, b); a = h_; b = l_; } while (0)
#define SORT16(X) do { CE(X[0], X[1]); CE(X[2], X[3]); CE(X[0], X[2]); CE(X[1], X[3]); CE(X[1], X[2]); CE(X[4], X[5]); CE(X[6], X[7]); CE(X[4], X[6]); CE(X[5], X[7]); CE(X[5], X[6]); CE(X[0], X[4]); CE(X[2], X[6]); CE(X[2], X[4]); CE(X[1], X[5]); CE(X[3], X[7]); CE(X[3], X[5]); CE(X[1], X[2]); CE(X[3], X[4]); CE(X[5], X[6]); CE(X[8], X[9]); CE(X[10], X[11]); CE(X[8], X[10]); CE(X[9], X[11]); CE(X[9], X[10]); CE(X[12], X[13]); CE(X[14], X[15]); CE(X[12], X[14]); CE(X[13], X[15]); CE(X[13], X[14]); CE(X[8], X[12]); CE(X[10], X[14]); CE(X[10], X[12]); CE(X[9], X[13]); CE(X[11], X[15]); CE(X[11], X[13]); CE(X[9], X[10]); CE(X[11], X[12]); CE(X[13], X[14]); CE(X[0], X[8]); CE(X[4], X[12]); CE(X[4], X[8]); CE(X[2], X[10]); CE(X[6], X[14]); CE(X[6], X[10]); CE(X[2], X[4]); CE(X[6], X[8]); CE(X[10], X[12]); CE(X[1], X[9]); CE(X[5], X[13]); CE(X[5], X[9]); CE(X[3], X[11]); CE(X[7], X[15]); CE(X[7], X[11]); CE(X[3], X[5]); CE(X[7], X[9]); CE(X[11], X[13]); CE(X[1], X[2]); CE(X[3], X[4]); CE(X[5], X[6]); CE(X[7], X[8]); CE(X[9], X[10]); CE(X[11], X[12]); CE(X[13], X[14]); } while (0)
#define MERGE16(L, N) do { L[0] = max(L[0], N[15]); L[1] = max(L[1], N[14]); L[2] = max(L[2], N[13]); L[3] = max(L[3], N[12]); L[4] = max(L[4], N[11]); L[5] = max(L[5], N[10]); L[6] = max(L[6], N[9]); L[7] = max(L[7], N[8]); L[8] = max(L[8], N[7]); L[9] = max(L[9], N[6]); L[10] = max(L[10], N[5]); L[11] = max(L[11], N[4]); L[12] = max(L[12], N[3]); L[13] = max(L[13], N[2]); L[14] = max(L[14], N[1]); L[15] = max(L[15], N[0]); CE(L[0], L[8]); CE(L[1], L[9]); CE(L[2], L[10]); CE(L[3], L[11]); CE(L[4], L[12]); CE(L[5], L[13]); CE(L[6], L[14]); CE(L[7], L[15]); CE(L[0], L[4]); CE(L[1], L[5]); CE(L[2], L[6]); CE(L[3], L[7]); CE(L[8], L[12]); CE(L[9], L[13]); CE(L[10], L[14]); CE(L[11], L[15]); CE(L[0], L[2]); CE(L[1], L[3]); CE(L[4], L[6]); CE(L[5], L[7]); CE(L[8], L[10]); CE(L[9], L[11]); CE(L[12], L[14]); CE(L[13], L[15]); CE(L[0], L[1]); CE(L[2], L[3]); CE(L[4], L[5]); CE(L[6], L[7]); CE(L[8], L[9]); CE(L[10], L[11]); CE(L[12], L[13]); CE(L[14], L[15]); } while (0)
#define TK_MERGE(L) do { unsigned N[16]; _Pragma("unroll") for (int j_ = 0; j_ < 16; ++j_) { auto rr_ = __builtin_amdgcn_permlane32_swap(L[j_], L[j_], false, false); L[j_] = rr_[0]; N[j_] = rr_[1]; } MERGE16(L, N); } while (0)
typedef __bf16 bf16x2_t __attribute__((ext_vector_type(2)));
__device__ __forceinline__ float dot2bf(unsigned a, unsigned b, float c) { return __builtin_amdgcn_fdot2_f32_bf16(__builtin_bit_cast(bf16x2_t, a), __builtin_bit_cast(bf16x2_t, b), c, false); }

__device__ __forceinline__ void route_unit(Frame& F, char* lds, int t0, int hh) {
    const int lane = F.lane, r32 = lane & 31, hi = lane >> 5, wid = F.wave;
    const bf16* QP = (const bf16*)(F.ws + WS_QP); const bf16* SK = (const bf16*)(F.ws + WS_SK);
    int* IDX = (int*)(F.ws + WS_IDX); float* GATE = (float*)(F.ws + WS_GATE);
    float fa[16], fb[16];
    int* tab = (int*)(lds) + (wid * 64 + lane) * 33;
#pragma unroll
    for (int c = 0; c < 2; ++c) {
        unsigned L[16];
#pragma unroll
        for (int j = 0; j < 16; ++j) L[j] = 0u;
        const bf16* qrow = QP + (size_t)(t0 + r32) * 2048 + hh * 256 + c * 128 + hi * 8;
        bf16x8 qf[8];
#pragma unroll
        for (int ks = 0; ks < 8; ++ks) qf[ks] = *reinterpret_cast<const bf16x8*>(qrow + ks * 16);
        const bf16* skb = SK + (size_t)((hh * 2 + c) * 128 + r32) * 128 + hi * 8;
        const unsigned nbase = 127u - 4u * (unsigned)hi;
        bf16x8 an[8];
        { const bf16* sp = skb; asm volatile("" : "+v"(sp));
#pragma unroll
          for (int ks = 0; ks < 8; ++ks) an[ks] = *reinterpret_cast<const bf16x8*>(sp + ks * 16); }
#pragma unroll
        for (int nb = 0; nb < 4; ++nb) { f32x16 acc = {};
#pragma unroll
            for (int ks = 0; ks < 8; ++ks) acc = __builtin_amdgcn_mfma_f32_32x32x16_bf16(an[ks], qf[ks], acc, 0, 0, 0);
            if (nb < 3) { const bf16* sp = skb + (size_t)(nb + 1) * 32 * 128; asm volatile("" : "+v"(sp));
#pragma unroll
                for (int ks = 0; ks < 8; ++ks) an[ks] = *reinterpret_cast<const bf16x8*>(sp + ks * 16); }
            { unsigned X[16];
#pragma unroll
              for (int r = 0; r < 16; ++r) X[r] = (fkey(acc[r]) & ~127u) | (nbase - (unsigned)(32 * nb + (r & 3) + 8 * (r >> 2)));
              SORT16(X); if (nb == 0) {
#pragma unroll
                  for (int r = 0; r < 16; ++r) L[r] = X[r]; } else { unsigned* N = X; MERGE16(L, N); } }
            SBAR(); }
        TK_MERGE(L);
#pragma unroll
        for (int j = 0; j < 16; ++j) { const float f = funkey(L[j] & ~127u); if (c == 0) fa[j] = f; else fb[j] = f; tab[16 * c + j] = 127 - (int)(L[j] & 127u); }
        SBAR();
    }
    unsigned C[16];
    {
        unsigned K2[16]; float pa_ = 0.f, pb_ = 0.f; int pf_ = 0; int cnt = 0;
#pragma unroll
        for (int j = 0; j < 16; ++j) K2[j] = 0u;
#pragma unroll
        for (int i = 0; i < 16; ++i)
#pragma unroll
            for (int j = 0; j < 16; ++j) if ((i + 1) * (j + 1) <= 16) {
                if ((cnt & 1) == 0) { pa_ = fa[i]; pb_ = fb[j]; pf_ = i * 16 + j; }
                else { const float s = hi ? fa[i] + fb[j] : pa_ + pb_; const int fl = hi ? i * 16 + j : pf_; const unsigned key = (fkey(s) & ~255u) | (unsigned)(255 - fl); const int q = cnt >> 1; if (q < 16) C[q] = key; else K2[q - 16] = key; }
                ++cnt; }
        { unsigned* X = C; SORT16(X); } { unsigned* X = K2; SORT16(X); }
        { unsigned* L = C; unsigned* N = K2; MERGE16(L, N); }
    }
    { unsigned* L = C; TK_MERGE(L); }
    asm volatile("s_waitcnt lgkmcnt(0)" ::: "memory");
    const float vmax = funkey(C[0] & ~255u); float ev[16]; float es = 0.f;
#pragma unroll
    for (int k = 0; k < 16; ++k) { ev[k] = __expf(funkey(C[k] & ~255u) - vmax); es += ev[k]; }
    const float ri = 1.0f / es;
    const size_t ob = (size_t)(t0 + r32) * 128 + hh * 16;
    int* dstp = hi ? (int*)GATE + ob : IDX + ob; int w[16];
#pragma unroll
    for (int k = 0; k < 16; ++k) { const int fl = 255 - (int)(C[k] & 255u); const int e = tab[fl >> 4] * 128 + tab[16 + (fl & 15)]; w[k] = hi ? (int)__float_as_uint(ev[k] * ri) : e; }
#pragma unroll
    for (int q = 0; q < 4; ++q) { typedef int i32x4 __attribute__((ext_vector_type(4))); *(i32x4*)(dstp + 4 * q) = (i32x4){w[4 * q], w[4 * q + 1], w[4 * q + 2], w[4 * q + 3]}; }
    asm volatile("s_waitcnt lgkmcnt(0)" ::: "memory");
}

__device__ __forceinline__ float gelu_tanh(float x) { const float z = 0.7978845608028654f * (x + 0.044715f * x * x * x); return x * __builtin_amdgcn_rcpf(1.0f + __builtin_amdgcn_exp2f(-2.0f * LOG2E * z)); }
constexpr float USCALE = 64.0f, VSCALE = 2.7f;
constexpr int ROW6 = DM * 6 / 8;
typedef __bf16 bf16x32_t __attribute__((ext_vector_type(32)));
typedef unsigned u32x6 __attribute__((ext_vector_type(6)));
typedef unsigned u32x3 __attribute__((ext_vector_type(3)));
typedef unsigned u32x16 __attribute__((ext_vector_type(16)));
__device__ __forceinline__ u32x16 fp6row6(unsigned a, unsigned b, unsigned c, unsigned d, unsigned e, unsigned f) { const u32x6 p = {a, b, c, d, e, f}; return __builtin_bit_cast(u32x16, __builtin_amdgcn_cvt_scalef32_pk32_bf16_fp6(p, 1.0f)); }
__device__ __forceinline__ u32x16 fp6row_to_bf16(u32x3 a, u32x3 b) { const u32x6 p = {a[0], a[1], a[2], b[0], b[1], b[2]}; return __builtin_bit_cast(u32x16, __builtin_amdgcn_cvt_scalef32_pk32_bf16_fp6(p, 1.0f)); }
typedef int i32x8 __attribute__((ext_vector_type(8)));
constexpr int P4_ROW = 128;
constexpr size_t SLICE_TAB4 = (size_t)NEXP * P4_ROW;
constexpr int PW_BYTES = 16384, PM_OFF = 12288, PRING = 12;
constexpr int ACT_STRIDE = 144;
constexpr float XS8 = 16.0f;
#ifndef FP4_SPLIT
#define FP4_SPLIT 0
#endif
#define PDMA(voff, sbase, ldsdst, imm) asm volatile("s_add_u32 m0, %2, %3\n\ts_nop 0\n\tglobal_load_lds_dwordx4 %0, %1" : : "v"(voff), "s"(sbase), "s"(ldsdst), "i"(imm) : "memory", "scc")
#define PWAIT(n) asm volatile("s_waitcnt vmcnt(" #n ")" ::: "memory")
#define PEER_SETUP() \
    const int lane = F.lane, m = lane & 15, g = lane >> 4; \
    const int members_ = F.G / 8, sl = F.vcu / members_, mem_ = F.vcu % members_, tstep = members_ * NWAVES, t0 = mem_ * NWAVES + F.wave, NTOK = (T - t0 + tstep - 1) / tstep, tl = t0 + (NTOK - 1) * tstep; \
    LAS unsigned char* W = F.lds + F.wave * PW_BYTES; \
    const unsigned ldsW = (unsigned)__builtin_amdgcn_readfirstlane((int)(unsigned)(uintptr_t)W); \
    const unsigned char* wsb = F.ws;
#define TOKC(nn) min(t0 + (nn) * tstep, tl)
#define META(tt, mb) do { const unsigned vo_ = mbase + (unsigned)(tt) * mstride; const unsigned ld_ = (unsigned)__builtin_amdgcn_readfirstlane((int)(ldsW + (unsigned)(PM_OFF + 1024 * (mb)))); PDMA(vo_, wsb, ld_, 0); } while (0)

__device__ __forceinline__ void peer_udots(Frame& F) {
    PEER_SETUP()
    bf16* PART = (bf16*)(F.ws + WS_PART);
    const unsigned char* tabs = F.ws + WS_UB + (size_t)sl * SLICE_TAB4;
    const unsigned r8 = lane >> 3, p8 = lane & 7;
    const unsigned co0 = 16u * (p8 ^ ((r8 >> 1) & 7)), co1 = 16u * (p8 ^ (((r8 + 8) >> 1) & 7));
    unsigned mbase, mstride;
    if (lane < 16) { mbase = (unsigned)WS_X8 + 256u * sl + 16u * lane; mstride = (unsigned)DM; } else { mbase = (unsigned)WS_IDX + 16u * (lane < 48 ? lane - 16 : 0); mstride = 512u; }
#define UDMA(mb, ui, su) do { const LAS unsigned char* ip_ = W + PM_OFF + 1024 * (mb) + 256 + 64 * (ui) + 4 * r8; const unsigned e0_ = *(const LAS unsigned*)ip_, e1_ = *(const LAS unsigned*)(ip_ + 32); \
        const unsigned ld_ = (unsigned)__builtin_amdgcn_readfirstlane((int)(ldsW + 2048u * (unsigned)(su))); \
        const unsigned v0_ = e0_ * (unsigned)P4_ROW + co0, v1_ = e1_ * (unsigned)P4_ROW + co1; PDMA(v0_, tabs, ld_, 0); PDMA(v1_, tabs, ld_, 1024); } while (0)
    META(TOKC(0), 0); META(TOKC(1), 1); PWAIT(0);
    int si = 0;
#pragma unroll
    for (int r = 0; r < 5; ++r) { UDMA(0, r, si); ++si; }
    int mb0 = 0, mb1 = 1, mb2 = 2, sc = 0;
#pragma unroll 1
    for (int n = 0; n < NTOK; ++n) {
        const int t = t0 + n * tstep;
        i32x8 xb[2]; f32x4 acc[8];
#pragma unroll
        for (int r = 0; r < 8; ++r) {
            if (r == 4) META(TOKC(n + 2), mb2);
            if (r < 3) UDMA(mb0, r + 5, si); else UDMA(mb1, r - 3, si);
            si = si == 5 ? 0 : si + 1;
            if (r >= 4) PWAIT(11); else PWAIT(10);
            if (r == 0) {
#pragma unroll
                for (int h = 0; h < 2; ++h) { const LAS unsigned char* xp_ = W + PM_OFF + 1024 * mb0 + 128 * h + (FP4_SPLIT ? 32 * g : 16 * g); const v4u a0 = *(const LAS v4u*)xp_, a1 = *(const LAS v4u*)(xp_ + (FP4_SPLIT ? 16 : 64));
                    xb[h] = (i32x8){(int)a0[0], (int)a0[1], (int)a0[2], (int)a0[3], (int)a1[0], (int)a1[1], (int)a1[2], (int)a1[3]}; } }
            f32x4 c = {0.f, 0.f, 0.f, 0.f};
#pragma unroll
            for (int h = 0; h < 2; ++h) { const v4u a0 = *(const LAS v4u*)(W + 2048 * sc + m * P4_ROW + 16 * ((4 * h + g) ^ ((m >> 1) & 7)));
                const i32x8 a = {(int)a0[0], (int)a0[1], (int)a0[2], (int)a0[3], 0, 0, 0, 0};
                c = __builtin_amdgcn_mfma_scale_f32_16x16x128_f8f6f4(a, xb[h], c, 4, 0, 0, 127, 0, 127); }
            acc[r] = c;
            sc = sc == 5 ? 0 : sc + 1;
        }
        f32x4 v = acc[0];
#pragma unroll
        for (int b = 1; b < 8; ++b) { const bool s_ = (m & 7) == b; v[0] = s_ ? acc[b][0] : v[0]; v[1] = s_ ? acc[b][1] : v[1]; v[2] = s_ ? acc[b][2] : v[2]; v[3] = s_ ? acc[b][3] : v[3]; }
        asm volatile("" : "+v"(v[0]), "+v"(v[1]), "+v"(v[2]), "+v"(v[3]));
        if (m < 8) *(u32x2*)(PART + ((size_t)sl * T + t) * 128 + 16 * m + 4 * g) = (u32x2){cvtpk(v[0], v[1]), cvtpk(v[2], v[3])};
        { const int o_ = mb0; mb0 = mb1; mb1 = mb2; mb2 = o_; }
    }
    PWAIT(0);
#undef UDMA
}
__device__ __forceinline__ void peer_act(Frame& F) {
    const int gw = F.vcu * NWAVES + F.wave, NGW = F.G * NWAVES, lane = F.lane;
    const unsigned* PART2 = (const unsigned*)(F.ws + WS_PART); const float* GATEA = (const float*)(F.ws + WS_GATE); unsigned char* ACT8 = (unsigned char*)(F.ws + WS_ACT);
    const int* IDXA = (const int*)(F.ws + WS_IDX); const float* SCU = (const float*)(F.ws + WS_SCU); const float* SCV = (const float*)(F.ws + WS_SCV); const float* SSQ = (const float*)(F.ws + WS_SSQ);
    for (int t = gw; t < T; t += NGW) {
        unsigned pw[8];
#pragma unroll
        for (int j = 0; j < 8; ++j) pw[j] = PART2[((size_t)j * T + t) * 64 + lane];
        const u32x2 ev = *(const u32x2*)(IDXA + (size_t)t * 128 + 2 * lane); const u32x2 gv = *(const u32x2*)(GATEA + (size_t)t * 128 + 2 * lane);
        float a0 = 0.f, a1 = 0.f;
#pragma unroll
        for (int j = 0; j < 8; ++j) { a0 += bflo(pw[j]); a1 += bfhi(pw[j]); }
        const float su0 = SCU[ev[0]], su1 = SCU[ev[1]], sv0 = SCV[ev[0]], sv1 = SCV[ev[1]];
        float v[2]; v[0] = gelu_tanh(a0 * su0 * (1.0f / XS8)) * __uint_as_float(gv[0]) * sv0; v[1] = gelu_tanh(a1 * su1 * (1.0f / XS8)) * __uint_as_float(gv[1]) * sv1;
        float am = fmaxf(fabsf(v[0]), fabsf(v[1]));
#pragma unroll
        for (int o = 1; o < 64; o <<= 1) am = fmaxf(am, __shfl_xor(am, o));
        const float ts = am > 0.f ? 224.0f / am : 1.0f;
#pragma unroll
        for (int hk = 0; hk < 2; ++hk) { const int k = 2 * lane + hk, r = k & 7, j = k >> 3, gg = r & 3, ga = 2 * (gg & 1) + (r >> 2), half = gg >> 1;
            const int p = __builtin_amdgcn_cvt_pk_fp8_f32(v[hk] * ts, 0.f, 0, false);
            ACT8[(size_t)t * ACT_STRIDE + 32 * ga + 2 * j + half] = (unsigned char)(p & 255); }
        if (lane == 0) *(float*)(ACT8 + (size_t)t * ACT_STRIDE + 128) = 1.0f / ts;
    }
}
__device__ __forceinline__ void peer_vacc(Frame& F) {
    PEER_SETUP()
    bf16* Y = (bf16*)(F.ws + WS_Y);
    const unsigned char* tabs = F.ws + WS_VB6 + (size_t)sl * SLICE_TAB4;
    const unsigned r8 = lane >> 3, co = 16u * (lane & 7);
    unsigned mbase, mstride;
    if (lane < 9) { mbase = (unsigned)WS_ACT + 16u * lane; mstride = (unsigned)ACT_STRIDE; } else { mbase = (unsigned)WS_IDX + 16u * ((lane >= 16 && lane < 48) ? lane - 16 : 0); mstride = 512u; }
    const int sh = 8 * (m & 3), mq = m >> 2;
#define VDMA(mb, ui, su) do { const unsigned e_ = *(const LAS unsigned*)(W + PM_OFF + 1024 * (mb) + 256 + 32 * (ui) + 4 * r8); \
        const unsigned ld_ = (unsigned)__builtin_amdgcn_readfirstlane((int)(ldsW + 1024u * (unsigned)(su))); const unsigned v_ = e_ * (unsigned)P4_ROW + co; PDMA(v_, tabs, ld_, 0); } while (0)
    META(TOKC(0), 0); META(TOKC(1), 1); PWAIT(0);
    int si = 0;
#pragma unroll
    for (int r = 0; r < 11; ++r) { VDMA(0, r, si); ++si; }
    int mb0 = 0, mb1 = 1, mb2 = 2, sc = 0;
#pragma unroll 1
    for (int n = 0; n < NTOK; ++n) {
        const int t = t0 + n * tstep;
        f32x4 d = {0.f, 0.f, 0.f, 0.f};
#pragma unroll
        for (int r = 0; r < 16; ++r) {
            if (r == 4) META(TOKC(n + 2), mb2);
            if (r < 5) VDMA(mb0, r + 11, si); else VDMA(mb1, r - 5, si);
            si = si == PRING - 1 ? 0 : si + 1;
            if (r >= 4 && r <= 14) PWAIT(12); else PWAIT(11);
            const LAS unsigned char* r0 = W + 1024 * sc + (FP4_SPLIT ? 2 * g : g) * P4_ROW + 8 * m;
            const u32x2 b0 = *(const LAS u32x2*)r0, b1 = *(const LAS u32x2*)(r0 + (FP4_SPLIT ? 1 : 4) * P4_ROW);
            const i32x8 b = {(int)b0[0], (int)b0[1], (int)b1[0], (int)b1[1], 0, 0, 0, 0};
            const unsigned pair = *(const LAS unsigned short*)(W + PM_OFF + 1024 * mb0 + 32 * g + 2 * r);
            const int lo = (int)((pair & 255u) << sh), hi = (int)((pair >> 8) << sh);
            const i32x8 a = {mq == 0 ? lo : 0, mq == 1 ? lo : 0, mq == 2 ? lo : 0, mq == 3 ? lo : 0, mq == 0 ? hi : 0, mq == 1 ? hi : 0, mq == 2 ? hi : 0, mq == 3 ? hi : 0};
            d = __builtin_amdgcn_mfma_scale_f32_16x16x128_f8f6f4(a, b, d, 0, 4, 0, 127, 0, 127);
            sc = sc == PRING - 1 ? 0 : sc + 1;
        }
        const float inv = *(const LAS float*)(W + PM_OFF + 1024 * mb0 + 128);
        *(u32x2*)(Y + (size_t)t * DM + 256 * sl + 16 * m + 4 * g) = (u32x2){cvtpk(d[0] * inv, d[1] * inv), cvtpk(d[2] * inv, d[3] * inv)};
        { const int o_ = mb0; mb0 = mb1; mb1 = mb2; mb2 = o_; }
    }
    PWAIT(0);
#undef VDMA
}
#undef META
#undef TOKC
#undef PEER_SETUP

__device__ __forceinline__ void peer_final(Frame& F) {
    const int gw = F.vcu * NWAVES + F.wave, NGW = F.G * NWAVES, lane = F.lane;
    const bf16* Y = (const bf16*)(F.ws + WS_Y); const bf16* X1B = (const bf16*)(F.ws + WS_X1B); const float* norm_final = F.in[17];
    f32x4 gv[8];
#pragma unroll
    for (int q = 0; q < 4; ++q) { gv[2 * q] = *(const f32x4*)(norm_final + 8 * lane + 512 * q); gv[2 * q + 1] = *(const f32x4*)(norm_final + 8 * lane + 512 * q + 4); }
    for (int t = gw; t < T; t += NGW) {
        v4u xa[4], ya[4]; f32x4 v[8]; float ss = 0.f;
#pragma unroll
        for (int q = 0; q < 4; ++q) { xa[q] = *(const v4u*)(X1B + (size_t)t * DM + 8 * lane + 512 * q); ya[q] = *(const v4u*)(Y + (size_t)t * DM + 8 * lane + 512 * q); }
#pragma unroll
        for (int q = 0; q < 4; ++q) {
            v[2 * q] = (f32x4){bflo(xa[q][0]) + bflo(ya[q][0]), bfhi(xa[q][0]) + bfhi(ya[q][0]), bflo(xa[q][1]) + bflo(ya[q][1]), bfhi(xa[q][1]) + bfhi(ya[q][1])};
            v[2 * q + 1] = (f32x4){bflo(xa[q][2]) + bflo(ya[q][2]), bfhi(xa[q][2]) + bfhi(ya[q][2]), bflo(xa[q][3]) + bflo(ya[q][3]), bfhi(xa[q][3]) + bfhi(ya[q][3])}; }
#pragma unroll
        for (int q = 0; q < 8; ++q) ss += (v[q][0] * v[q][0] + v[q][1] * v[q][1]) + (v[q][2] * v[q][2] + v[q][3] * v[q][3]);
        ss = wave_sum(ss);
        const float rf = 1.0f / sqrtf(ss * (1.0f / DM) + EPS);
        float* orow = F.out + (size_t)t * DM + 8 * lane;
#pragma unroll
        for (int q = 0; q < 4; ++q) { *(f32x4*)(orow + 512 * q) = v[2 * q] * rf * gv[2 * q]; *(f32x4*)(orow + 512 * q + 4) = v[2 * q + 1] * rf * gv[2 * q + 1]; }
    }
}

__device__ __forceinline__ unsigned e2m1_code(float x) {
    const float a = fabsf(x); const unsigned c = (unsigned)(a >= 0.25f) + (unsigned)(a >= 0.75f) + (unsigned)(a >= 1.25f) + (unsigned)(a >= 1.75f) + (unsigned)(a >= 2.5f) + (unsigned)(a >= 3.5f) + (unsigned)(a >= 5.0f);
    return c | (x < 0.f ? 8u : 0u); }
__device__ __forceinline__ void p5_expert_cvt(Frame& F) {
    const int gw = F.vcu * NWAVES + F.wave, NGW = F.G * NWAVES, lane = F.lane;
    const float* eu = F.in[15]; const float* ev = F.in[16]; const float* g = F.in[12];
    unsigned char* UB = (unsigned char*)(F.ws + WS_UB); unsigned char* VB = (unsigned char*)(F.ws + WS_VB6); float* SCU = (float*)(F.ws + WS_SCU); float* SCV = (float*)(F.ws + WS_SCV);
    LAS float* row = (LAS float*)(F.lds + RING_OFF + F.wave * 8192);
    f32x4 gv[8];
#pragma unroll
    for (int j = 0; j < 8; ++j) gv[j] = *(const f32x4*)(g + 4 * lane + 256 * j);
    for (int r = gw; r < 2 * NEXP; r += NGW) {
        const bool isv = r >= NEXP; const int e = isv ? r - NEXP : r;
        const GAS f32x4* src = (const GAS f32x4*)((isv ? ev : eu) + (size_t)e * DM) + lane;
        f32x4 v[8]; float ss = 0.f;
#pragma unroll
        for (int j = 0; j < 8; ++j) v[j] = src[64 * j];
#pragma unroll
        for (int j = 0; j < 8; ++j) { if (!isv) v[j] = v[j] * gv[j]; ss += (v[j][0] * v[j][0] + v[j][1] * v[j][1]) + (v[j][2] * v[j][2] + v[j][3] * v[j][3]); }
        ss = wave_sum(ss);
        const float sc = 0.5f * sqrtf(ss * (1.0f / DM)) + 1e-30f, isc = 1.0f / sc;
        if (lane == 0) (isv ? SCV : SCU)[e] = sc;
#pragma unroll
        for (int j = 0; j < 8; ++j) *(LAS f32x4*)(row + 4 * (lane + 64 * j)) = v[j] * isc;
        LDS_WAIT(); asm volatile("" ::: "memory");
        v4u w;
#pragma unroll
        for (int q = 0; q < 4; ++q) { const f32x4 a = *(const LAS f32x4*)(row + 32 * lane + 8 * q), b = *(const LAS f32x4*)(row + 32 * lane + 8 * q + 4);
            w[q] = e2m1_code(a[0]) | (e2m1_code(a[1]) << 4) | (e2m1_code(a[2]) << 8) | (e2m1_code(a[3]) << 12) | (e2m1_code(b[0]) << 16) | (e2m1_code(b[1]) << 20) | (e2m1_code(b[2]) << 24) | (e2m1_code(b[3]) << 28); }
        LDS_WAIT(); asm volatile("" ::: "memory");
        *(v4u*)((isv ? VB : UB) + (size_t)(lane >> 3) * SLICE_TAB4 + (size_t)e * P4_ROW + 16 * (lane & 7)) = w;
    }
}

__device__ __forceinline__ void p7_xquant(Frame& F) {
    const int gw = F.vcu * NWAVES + F.wave, NGW = F.G * NWAVES, lane = F.lane;
    const float* SSQ = (const float*)(F.ws + WS_SSQ); const bf16* X1B = (const bf16*)(F.ws + WS_X1B); unsigned char* X8 = (unsigned char*)(F.ws + WS_X8);
    for (int t = gw; t < T; t += NGW) {
        float ss = lane < 32 ? SSQ[(size_t)t * 32 + lane] : 0.f; ss = wave_sum(ss);
        const float sc = (1.0f / sqrtf(ss * (1.0f / DM) + EPS)) * XS8;
        const bf16* xs = X1B + (size_t)t * DM + 32 * lane; v4u o[2];
#pragma unroll
        for (int q = 0; q < 4; ++q) { const v4u a = *(const v4u*)(xs + 8 * q);
#pragma unroll
            for (int d = 0; d < 2; ++d) { const float f0 = fminf(fmaxf(bflo(a[2 * d]) * sc, -440.f), 440.f), f1 = fminf(fmaxf(bfhi(a[2 * d]) * sc, -440.f), 440.f), f2 = fminf(fmaxf(bflo(a[2 * d + 1]) * sc, -440.f), 440.f), f3 = fminf(fmaxf(bfhi(a[2 * d + 1]) * sc, -440.f), 440.f);
                int p = __builtin_amdgcn_cvt_pk_fp8_f32(f0, f1, 0, false); p = __builtin_amdgcn_cvt_pk_fp8_f32(f2, f3, p, true); o[q >> 1][2 * (q & 1) + d] = (unsigned)p; } }
        *(v4u*)(X8 + (size_t)t * DM + 32 * lane) = o[0]; *(v4u*)(X8 + (size_t)t * DM + 32 * lane + 16) = o[1];
    }
}

#ifndef MK_PER_PHASE
#define MK_PER_PHASE 0
#endif
constexpr int N_PHASES = 12;
struct Args { const float* in[18]; float* out; unsigned char* ws; int ph_lo, ph_hi; };
__global__ void __launch_bounds__(NWAVES * 64, 2) fwd_kernel(Args args) {
    extern __shared__ __attribute__((aligned(16))) unsigned char lds[];
    Frame F;
    F.lds = (LAS unsigned char*)lds;
    F.MISC = (volatile LAS unsigned*)(F.lds + MISC_OFF);
    F.wave = __builtin_amdgcn_readfirstlane((int)(threadIdx.x >> 6)); F.lane = (int)__builtin_amdgcn_mbcnt_hi(~0u, __builtin_amdgcn_mbcnt_lo(~0u, 0u)); F.tid = F.wave * 64 + F.lane;
    F.G = gridDim.x; { const int bx = blockIdx.x; F.vcu = (F.G % 8 == 0) ? (bx % 8) * (F.G / 8) + bx / 8 : bx; }
    F.ws = args.ws; F.ctl = (gu32*)(args.ws + WS_CTL); F.out = args.out;
    F.in = (const float* const*)__builtin_amdgcn_kernarg_segment_ptr();
    for (int u = F.tid; u < (LDS_BYTES - LDSCTL_OFF) / 4; u += NWAVES * 64) ((LAS unsigned*)(F.lds + LDSCTL_OFF))[u] = 0u;
    __syncthreads();
    XcdBarrier bar; bar.bar = (unsigned*)(F.ctl + CW_BAR); bar.x = 0; bar.st = nullptr; bar.w0 = F.wave == 0;
    if (!MK_PER_PHASE) bar = xcd_barrier_post((unsigned*)(F.ctl + CW_BAR), F.MISC + 8, F.wave);
    const int lo = args.ph_lo, hi = args.ph_hi;
#define IN(k) (lo <= (k) && (k) < hi)
    char* gl = (char*)lds + RING_OFF;
#define REFRESH() do { int l_ = (int)__builtin_amdgcn_mbcnt_hi(~0u, __builtin_amdgcn_mbcnt_lo(~0u, 0u)); asm volatile("" : "+v"(l_)); F.lane = l_; F.tid = F.wave * 64 + l_; } while (0)
#define LATE_GRP (F.G == 256 ? ((F.vcu >> 5) & 1) : (F.vcu & 1))
#define PH0 if (IN(0)) { p0_prep(F); }
#define PH1 if (IN(1)) { \
        if (LATE_GRP) p1_ifgates(F); \
        { pg8::Gemm g{(const bf16*)F.out, (const bf16*)(F.ws + WS_WIN), T, NPROJ - NSENS, DM / 2}; pg8::StaticOrder S; S.init(T, NPROJ - NSENS, F.G, (int)blockIdx.x); \
          pg8::EpiProj E{(bf16*)(F.ws + WS_QA), SEG_STRIDE / 2, (bf16*)(F.ws + WS_GATES), nullptr, 1.0f / WIN_SCALE, 0.125f * LOG2E, NSENS / 256, nullptr}; \
          pg8::gemm_phase<pg8::EpiProj, pg8::StaticOrder, true, true, true>(F.lds + RING_OFF, g, S, E, F.wave); } \
        }
  \
#define PH2 if (IN(2)) { \
          \
        if (LATE_GRP) { p2_conv_scan(F); __syncthreads(); } \
        { pg8::Gemm g{(const bf16*)(F.ws + WS_XB), (const bf16*)(F.ws + WS_WINB), T, NSENS, DM}; pg8::StaticOrder S; S.init(T, NSENS, F.G, (int)blockIdx.x); \
          pg8::EpiProj E{(bf16*)(F.ws + WS_QA), SEG_STRIDE / 2, (bf16*)(F.ws + WS_GATES), (const float*)(F.ws + WS_RSTD1), 1.0f, 0.125f * LOG2E, 0, (unsigned*)(F.ctl + CW_KMAX)}; \
          pg8::gemm_phase<pg8::EpiProj, pg8::StaticOrder, true, true, false>(F.lds + RING_OFF, g, S, E, F.wave); } \
        REFRESH(); if (!LATE_GRP) p2_conv_scan(F); }
#define PH3(BA_, BB_, QI_) if (IN(3)) { const int v = F.vcu; \
        if (v < 16 * NSEG) mlstm_seg_task(F, gl, v >> 3, v & 7); \
          \
        _Pragma("unroll 1") for (; (QI_) != 2;) { \
            if (F.tid == 0) F.MISC[16] = __hip_atomic_fetch_add((unsigned*)(F.ctl + CW_QUEUE + 64 * (QI_)), 1u, __ATOMIC_RELAXED, __HIP_MEMORY_SCOPE_AGENT); \
            __syncthreads(); const int q = (int)F.MISC[16]; __syncthreads(); \
            if (q >= 1024) break; \
            REFRESH(); \
            { const int u = 63 - (q >> 4), rem = q & 15; attn_unit(F, gl, rem & 1, 7 - (rem >> 1), u, BA_); } } \
        REFRESH(); \
        if (v < 256) { const int bh = v >> 4, sj = (v >> 1) & 7, pr = v & 1; mlstm_unit(F, gl, bh, sj, pr, BB_); mlstm_unit(F, gl, bh, sj, 3 - pr, BB_); } }
#define PH4 if (IN(4)) { \
        { pg8::Gemm g{(const bf16*)(F.ws + WS_QA), (const bf16*)(F.ws + WS_WA), T, DM, 1024}; pg8::StaticOrder S; S.init(T, DM, F.G, (int)blockIdx.x); \
          pg8::EpiGate<0> E{(bf16*)(F.ws + WS_MERGED), (const bf16*)(F.ws + WS_GATES)}; \
          pg8::gemm_phase<pg8::EpiGate<0>, pg8::StaticOrder, true, true>(F.lds + RING_OFF, g, S, E, F.wave); } \
        { pg8::Gemm g{(const bf16*)(F.ws + WS_BB), (const bf16*)(F.ws + WS_WB), T, DM, 1024}; pg8::StaticOrder S; S.init(T, DM, F.G, (int)blockIdx.x); \
          pg8::EpiGate<1> E{(bf16*)(F.ws + WS_MERGED), (const bf16*)(F.ws + WS_GATES)}; \
          pg8::gemm_phase<pg8::EpiGate<1>, pg8::StaticOrder, true, true>(F.lds + RING_OFF, g, S, E, F.wave); } }
#define PH5 if (IN(5)) { \
          \
        if (LATE_GRP) { p5_expert_cvt(F); __syncthreads(); } \
        { pg8::Gemm g{(const bf16*)(F.ws + WS_MERGED), (const bf16*)(F.ws + WS_WOUT), T, DM, DM}; pg8::StaticOrder S; S.init(T, DM, F.G, (int)blockIdx.x); \
          pg8::EpiRes E{F.in[0], (bf16*)(F.ws + WS_X1B), (float*)(F.ws + WS_SSQ)}; \
          pg8::gemm_phase<pg8::EpiRes, pg8::StaticOrder, true, true>(F.lds + RING_OFF, g, S, E, F.wave); } \
        REFRESH(); if (!LATE_GRP) p5_expert_cvt(F); }
#define PH6 if (IN(6)) { \
        pg8::Gemm g{(const bf16*)(F.ws + WS_X1B), (const bf16*)(F.ws + WS_WQ), T, DM, DM}; pg8::StaticOrder S; S.init(T, DM, F.G, (int)blockIdx.x); \
          \
        { float* R2 = (float*)(F.ws + WS_RSTD2); const float* SSQ = (const float*)(F.ws + WS_SSQ); pg8::Unit uu; \
          for (int i = 0; S.next(i, uu); ++i) if (F.tid < 256) { const int row = uu.pm * 256 + F.tid; const f32x4* sp = (const f32x4*)(SSQ + (size_t)row * 32); float s = 0.f; \
              _Pragma("unroll") for (int q = 0; q < 8; ++q) { const f32x4 t = sp[q]; s += (t[0] + t[1]) + (t[2] + t[3]); } \
              R2[row] = 1.0f / sqrtf(s * (1.0f / 2048.0f) + EPS); } \
          asm volatile("s_waitcnt vmcnt(0)" ::: "memory"); __syncthreads(); } \
        pg8::EpiQ E{(bf16*)(F.ws + WS_QP), (const float*)(F.ws + WS_RSTD2)}; \
        pg8::gemm_phase<pg8::EpiQ, pg8::StaticOrder, true, true>(F.lds + RING_OFF, g, S, E, F.wave); }
#define PH7 if (IN(7)) { const int gw = F.vcu * NWAVES + F.wave, NGW = F.G * NWAVES; \
        for (int it = gw; it < (T / 32) * NH; it += NGW) route_unit(F, gl, (it >> 3) * 32, it & 7); \
        p7_xquant(F); }
#define PH8 if (IN(8)) { REFRESH(); peer_udots(F); }
#define PH9 if (IN(9)) { peer_act(F); }
#define PH10 if (IN(10)) { REFRESH(); peer_vacc(F); }
#define PH11 if (IN(11)) { peer_final(F); }
#define SEAM(k) do { if (IN(k) && IN((k) + 1)) xcd_barrier(bar); } while (0)
#define BAR_ALWAYS() xcd_barrier(bar)
#ifndef DUP
#define DUP -1
#endif
#ifdef ONLY_PH1
    PH1
#else
    PH0 SEAM(0);
#if DUP == 0
    PH0 BAR_ALWAYS();
#endif
    PH1 SEAM(1);
#if DUP == 1
    PH1 BAR_ALWAYS();
#endif
    PH2 SEAM(2);
#if DUP == 2
    PH2 BAR_ALWAYS();
#endif
#if DUP == 3
    PH3((bf16*)(F.ws + WS_MQ), (bf16*)(F.ws + WS_MK), 1) BAR_ALWAYS();
#endif
#if DUP == 31
    PH3((bf16*)(F.ws + WS_MQ), (bf16*)(F.ws + WS_MK), 2) BAR_ALWAYS();
#endif
    PH3((bf16*)(F.ws + WS_QA), (bf16*)(F.ws + WS_BB), 0) SEAM(3);
    PH4 SEAM(4);
#if DUP == 4
    PH4 BAR_ALWAYS();
#endif
    PH5 SEAM(5);
#if DUP == 5
    PH5 BAR_ALWAYS();
#endif
    PH6 SEAM(6);
#if DUP == 6
    PH6 BAR_ALWAYS();
#endif
    PH7 SEAM(7);
#if DUP == 7
    PH7 BAR_ALWAYS();
#endif
    PH8 SEAM(8);
#if DUP == 8
    PH8 BAR_ALWAYS();
#endif
    PH9 SEAM(9);
#if DUP == 9
    PH9 BAR_ALWAYS();
#endif
#if DUP == 10
    PH10 BAR_ALWAYS();
#endif
    PH10 SEAM(10);
    PH11
#if DUP == 11
    BAR_ALWAYS(); PH11
#endif
#endif
#undef IN
#undef SEAM
}

extern "C" void kernel_launch(void* const* d_in, const int* in_sizes, int n_in, void* d_out, int out_size, void* d_ws, size_t ws_size, hipStream_t stream) {
    static int grid = 0;
    if (grid == 0) {
        if (n_in != 18 || in_sizes[0] != T * DM || out_size != T * DM || ws_size < WS_END) { fprintf(stderr, "kernel_launch: unexpected shapes: n_in %d in0 %d out %d ws %zu (need %zu)\n", n_in, n_in > 0 ? in_sizes[0] : -1, out_size, ws_size, (size_t)WS_END); grid = -1; return; }
        int dev = 0, cus = 0, per_cu = 0;
        if (hipGetDevice(&dev) != hipSuccess || hipDeviceGetAttribute(&cus, hipDeviceAttributeMultiprocessorCount, dev) != hipSuccess) { grid = -1; return; }
        if (hipFuncSetAttribute((const void*)fwd_kernel, hipFuncAttributeMaxDynamicSharedMemorySize, LDS_BYTES) != hipSuccess) { fprintf(stderr, "kernel_launch: hipFuncSetAttribute failed\n"); grid = -1; return; }
        if (hipOccupancyMaxActiveBlocksPerMultiprocessor(&per_cu, (const void*)fwd_kernel, NWAVES * 64, LDS_BYTES) != hipSuccess || per_cu < 1) { fprintf(stderr, "kernel_launch: occupancy query says %d\n", per_cu); per_cu = 1; }
        (void)hipGetLastError();
        grid = cus;
    }
    if (grid < 0) return;
    (void)hipMemsetAsync((char*)d_ws + WS_CTL, 0, CTL_ZERO_BYTES, stream);
    Args a{};
    for (int i = 0; i < 18; ++i) a.in[i] = (const float*)d_in[i];
    a.out = (float*)d_out; a.ws = (unsigned char*)d_ws;
#if MK_PER_PHASE
    for (int p = 0; p < N_PHASES; ++p) { a.ph_lo = p; a.ph_hi = p + 1; hipLaunchKernelGGL(fwd_kernel, dim3(grid), dim3(NWAVES * 64), LDS_BYTES, stream, a); }
#else
    a.ph_lo = 0; a.ph_hi = N_PHASES;
    hipLaunchKernelGGL(fwd_kernel, dim3(grid), dim3(NWAVES * 64), LDS_BYTES, stream, a);
#endif
    const hipError_t le = hipPeekAtLastError();
    if (le != hipSuccess) fprintf(stderr, "kernel_launch: launch failed: %s\n", hipGetErrorName(le));
}
```

```cpp
#include <hip/hip_runtime.h>
#include <cstdio>
#include <cstdint>
namespace pg8 {
#define PG8_LAS __attribute__((address_space(3)))
typedef unsigned short bf16_t;
typedef short bf16x8 __attribute__((ext_vector_type(8)));
typedef float f32x4 __attribute__((ext_vector_type(4)));
typedef unsigned u32x4 __attribute__((ext_vector_type(4)));
constexpr int BM = 256, BK = 64, HALF = 128, HTB = HALF * BK * 2  , STAGE_BYTES = 8 * HTB, NXCD = 8, WGM = 8;

__host__ __device__ __forceinline__ int lds_byte(int r, int c) { const int st = (r >> 4) * 2 + (c >> 5), rr = r & 15, cc = c & 31, ob = rr * 64 + cc * 2; return st * 1024 + (ob ^ (((ob >> 9) & 1) << 5)); }
__host__ __device__ __forceinline__ void stage_rc(int b, int& R, int& C) { const int st = b / 1024, sb = b % 1024, swz = sb ^ (((sb >> 9) & 1) << 5); R = (st >> 1) * 16 + swz / 64; C = (st & 1) * 32 + (swz % 64) / 2; }
__host__ __device__ __forceinline__ int perm32(int rho) { const int n = rho >> 4, i = rho & 15; return 8 * (i >> 2) + 4 * n + (i & 3); }

struct Unit { int pm, pn; };
struct Gemm { const bf16_t* A; const bf16_t* Bt; int M, N, K; };

struct StaticOrder {
    int nM, nN, nwg, G, c;
    __host__ __device__ void init(int M, int N, int G_, int c_) { nM = M / BM; nN = N / BM; nwg = nM * nN; G = G_; c = c_; }
    __host__ __device__ bool next(int i, Unit& u) const {
        const long L = (long)i * G + c; if (L >= nwg) return false;
        int wgid = (int)L; { const int q = nwg / NXCD, r = nwg % NXCD, xcd = wgid % NXCD, off = wgid / NXCD; wgid = (xcd < r ? xcd * (q + 1) : r * (q + 1) + (xcd - r) * q) + off; }
        const int nig = WGM * nN, gid = wgid / nig, fm = gid * WGM, gsz = (nM - fm) < WGM ? (nM - fm) : WGM;
        u.pm = fm + ((wgid % nig) % gsz); u.pn = (wgid % nig) / gsz; return true;
    }
    __device__ __forceinline__ void a_ready(const Unit&) const {}
    __device__ __forceinline__ void done(const Unit&) const {}
};

__device__ __forceinline__ unsigned cvt_pk_bf16(float lo, float hi) { unsigned r; asm volatile("v_cvt_pk_bf16_f32 %0, %1, %2" : "=v"(r) : "v"(lo), "v"(hi)); return r; }
typedef float f32x2 __attribute__((ext_vector_type(2)));
__device__ __forceinline__ float sigmoidf_fast(float x) { return __builtin_amdgcn_rcpf(1.0f + __builtin_amdgcn_exp2f(-1.4426950408889634f * x)); }
__device__ __forceinline__ float bf_lo(unsigned w) { return __uint_as_float(w << 16); }
__device__ __forceinline__ float bf_hi(unsigned w) { return __uint_as_float(w & 0xffff0000u); }

__device__ __forceinline__ size_t gate8_off(int pm, int gt, int wv, int fragi, int ln) { return ((((size_t)(pm * 16 + gt) * 8 + wv) * 16 + fragi) * 64 + ln) * 8; }
struct EpiProj {
    static constexpr bool PERM = true, AFTER_DRAIN = false;
    bf16_t* segbase;
    size_t segstride;
    bf16_t* gates;
    const float* rstd;
    float cscale;
    float qscale;
    int pn_off;
    unsigned* kmax;
    __device__ __forceinline__ void operator()(const f32x4 (&acc)[2][2][4][2], const Unit& u, int wr, int wc, int fr, int fq) const {
        const int pn = u.pn + pn_off; bf16_t* base; int ldc, colt, mode;
        if (pn < 28) { const int seg = pn >> 2; base = segbase + (size_t)seg * segstride; ldc = 1024; colt = (pn & 3) * 256; mode = seg == 0 ? 1 : (seg == 6 ? 2 : 0); }
        else { base = gates; ldc = 4096; colt = (pn - 28) * 256; mode = 2; }
        const int row0 = u.pm * BM + wr * 64 + fr, col0 = colt + wc * 32 + 8 * fq; float kmx[2] = {0.f, 0.f};
        float rr[2][4];
#pragma unroll
        for (int ai = 0; ai < 2; ++ai)
#pragma unroll
            for (int m = 0; m < 4; ++m) rr[ai][m] = rstd ? rstd[row0 + ai * HALF + m * 16] : cscale;
#pragma unroll
        for (int ai = 0; ai < 2; ++ai)
#pragma unroll
            for (int m = 0; m < 4; ++m) { const int row = row0 + ai * HALF + m * 16; float r = rr[ai][m]; if (mode == 1) r *= qscale;
                bf16_t* rowp = base + (size_t)row * ldc + col0;
#pragma unroll
                for (int bj = 0; bj < 2; ++bj) { f32x4 v0 = acc[ai][bj][m][0] * r, v1 = acc[ai][bj][m][1] * r;
                    if (mode == 2) {
#pragma unroll
                        for (int e = 0; e < 4; ++e) { v0[e] = sigmoidf_fast(v0[e]); v1[e] = sigmoidf_fast(v1[e]); } }
                    if (pn >= 28) { unsigned g0 = 0u, g1 = 0u; const float glo = pn >= 36 ? 1.0f : 0.0f;
#pragma unroll
                        for (int e = 0; e < 4; ++e) { g0 = __builtin_amdgcn_cvt_pk_u8_f32(fmaxf(fmaf(v0[e], 255.0f, 0.5f), glo), e, g0); g1 = __builtin_amdgcn_cvt_pk_u8_f32(fmaxf(fmaf(v1[e], 255.0f, 0.5f), glo), e, g1); }
                        typedef unsigned u32x2g __attribute__((ext_vector_type(2)));
                        *(u32x2g*)((unsigned char*)gates + gate8_off(u.pm, pn - 28, wr * 4 + wc, ai * 8 + m * 2 + bj, fq * 16 + fr)) = (u32x2g){g0, g1}; }
                    else { u32x4 w; w.x = cvt_pk_bf16(v0[0], v0[1]); w.y = cvt_pk_bf16(v0[2], v0[3]); w.z = cvt_pk_bf16(v1[0], v1[1]); w.w = cvt_pk_bf16(v1[2], v1[3]);
                        *(u32x4*)(rowp + bj * HALF) = w; }
                    if (kmax && pn >= 4 && pn < 8) {
                        float s = ((v0[0] * v0[0] + v0[1] * v0[1]) + (v0[2] * v0[2] + v0[3] * v0[3])) + ((v1[0] * v1[0] + v1[1] * v1[1]) + (v1[2] * v1[2] + v1[3] * v1[3]));
                        s += __shfl_xor(s, 16); s += __shfl_xor(s, 32); kmx[bj] = fmaxf(kmx[bj], s); } } }
        if (kmax && pn >= 4 && pn < 8 && fq == 0) {
#pragma unroll
            for (int bj = 0; bj < 2; ++bj) { float m = kmx[bj];
#pragma unroll
                for (int o = 1; o < 16; o <<= 1) m = fmaxf(m, __shfl_xor(m, o));
                if (fr == 0) atomicMax(kmax + (row0 >> 13) * 32 + ((colt + bj * HALF + wc * 32) >> 5), __float_as_uint(m)); } }
    }
};
template <int PASS> struct EpiGate {
    static constexpr bool PERM = true, AFTER_DRAIN = false;
    bf16_t* merged; const bf16_t* gates;
    __device__ __forceinline__ void operator()(const f32x4 (&acc)[2][2][4][2], const Unit& u, int wr, int wc, int fr, int fq) const {
        const int row0 = u.pm * BM + wr * 64 + fr, col0 = u.pn * BM + wc * 32 + 8 * fq;
        typedef unsigned u32x2g __attribute__((ext_vector_type(2))); u32x2g gq[2][4][2];
#pragma unroll
        for (int ai = 0; ai < 2; ++ai)
#pragma unroll
            for (int m = 0; m < 4; ++m)
#pragma unroll
                for (int bj = 0; bj < 2; ++bj) gq[ai][m][bj] = *(const u32x2g*)((const unsigned char*)gates + gate8_off(u.pm, PASS * 8 + u.pn, wr * 4 + wc, ai * 8 + m * 2 + bj, fq * 16 + fr));
#pragma unroll
        for (int ai = 0; ai < 2; ++ai) {
            u32x4 pq[4][2];
            if (PASS == 1) {
#pragma unroll
                for (int m = 0; m < 4; ++m)
#pragma unroll
                    for (int bj = 0; bj < 2; ++bj) pq[m][bj] = *(const u32x4*)(merged + (size_t)(row0 + ai * HALF + m * 16) * 2048 + col0 + bj * HALF); }
#pragma unroll
            for (int m = 0; m < 4; ++m)
#pragma unroll
                for (int bj = 0; bj < 2; ++bj) { const int row = row0 + ai * HALF + m * 16, col = col0 + bj * HALF; const u32x2g g = gq[ai][m][bj];
                    f32x4 v0 = acc[ai][bj][m][0] * (1.0f / 255.0f), v1 = acc[ai][bj][m][1] * (1.0f / 255.0f);
                    v0[0] *= (float)(g[0] & 255u); v0[1] *= (float)((g[0] >> 8) & 255u); v0[2] *= (float)((g[0] >> 16) & 255u); v0[3] *= (float)(g[0] >> 24);
                    v1[0] *= (float)(g[1] & 255u); v1[1] *= (float)((g[1] >> 8) & 255u); v1[2] *= (float)((g[1] >> 16) & 255u); v1[3] *= (float)(g[1] >> 24);
                    if (PASS == 1) { const u32x4 p = pq[m][bj];
                        v0[0] += bf_lo(p.x); v0[1] += bf_hi(p.x); v0[2] += bf_lo(p.y); v0[3] += bf_hi(p.y); v1[0] += bf_lo(p.z); v1[1] += bf_hi(p.z); v1[2] += bf_lo(p.w); v1[3] += bf_hi(p.w); }
                    u32x4 w; w.x = cvt_pk_bf16(v0[0], v0[1]); w.y = cvt_pk_bf16(v0[2], v0[3]); w.z = cvt_pk_bf16(v1[0], v1[1]); w.w = cvt_pk_bf16(v1[2], v1[3]);
                    *(u32x4*)(merged + (size_t)row * 2048 + col) = w; }
        }
    }
};
struct EpiGate2 {
    static constexpr bool PERM = true, AFTER_DRAIN = false;
    bf16_t* merged; const bf16_t* gates;
    typedef unsigned u32x2g __attribute__((ext_vector_type(2)));
    __device__ __forceinline__ void mid(f32x4 (&acc)[2][2][4][2], const Unit& u, int wr, int wc, int fr, int fq) const {
        const unsigned char* const ga = (const unsigned char*)gates + gate8_off(u.pm, u.pn, wr * 4 + wc, 0, fq * 16 + fr); const unsigned char* const gb = ga + 8 * (size_t)(8 * 16 * 64 * 8);
#pragma unroll
        for (int ai = 0; ai < 2; ++ai) {
            u32x2g qa[4][2], qb[4][2];
#pragma unroll
            for (int m = 0; m < 4; ++m)
#pragma unroll
                for (int bj = 0; bj < 2; ++bj) { qa[m][bj] = *(const u32x2g*)(ga + (size_t)(ai * 8 + m * 2 + bj) * 512); qb[m][bj] = *(const u32x2g*)(gb + (size_t)(ai * 8 + m * 2 + bj) * 512); }
#pragma unroll
            for (int m = 0; m < 4; ++m)
#pragma unroll
                for (int bj = 0; bj < 2; ++bj)
#pragma unroll
                    for (int n = 0; n < 2; ++n) { const unsigned a = qa[m][bj][n], d = qb[m][bj][n];
                        acc[ai][bj][m][n][0] *= (float)(a & 255u) * __builtin_amdgcn_rcpf((float)(d & 255u)); acc[ai][bj][m][n][1] *= (float)((a >> 8) & 255u) * __builtin_amdgcn_rcpf((float)((d >> 8) & 255u));
                        acc[ai][bj][m][n][2] *= (float)((a >> 16) & 255u) * __builtin_amdgcn_rcpf((float)((d >> 16) & 255u)); acc[ai][bj][m][n][3] *= (float)(a >> 24) * __builtin_amdgcn_rcpf((float)(d >> 24)); }
        }
    }
    __device__ __forceinline__ void operator()(const f32x4 (&acc)[2][2][4][2], const Unit& u, int wr, int wc, int fr, int fq) const {
        const int row0 = u.pm * BM + wr * 64 + fr, col0 = u.pn * BM + wc * 32 + 8 * fq;
        const unsigned char* const gb = (const unsigned char*)gates + gate8_off(u.pm, 8 + u.pn, wr * 4 + wc, 0, fq * 16 + fr);
        u32x2g gq[2][4][2];
#pragma unroll
        for (int ai = 0; ai < 2; ++ai)
#pragma unroll
            for (int m = 0; m < 4; ++m)
#pragma unroll
                for (int bj = 0; bj < 2; ++bj) gq[ai][m][bj] = *(const u32x2g*)(gb + (size_t)(ai * 8 + m * 2 + bj) * 512);
#pragma unroll
        for (int ai = 0; ai < 2; ++ai)
#pragma unroll
            for (int m = 0; m < 4; ++m)
#pragma unroll
                for (int bj = 0; bj < 2; ++bj) { const int row = row0 + ai * HALF + m * 16, col = col0 + bj * HALF; const u32x2g g = gq[ai][m][bj];
                    f32x4 v0 = acc[ai][bj][m][0] * (1.0f / 255.0f), v1 = acc[ai][bj][m][1] * (1.0f / 255.0f);
                    v0[0] *= (float)(g[0] & 255u); v0[1] *= (float)((g[0] >> 8) & 255u); v0[2] *= (float)((g[0] >> 16) & 255u); v0[3] *= (float)(g[0] >> 24);
                    v1[0] *= (float)(g[1] & 255u); v1[1] *= (float)((g[1] >> 8) & 255u); v1[2] *= (float)((g[1] >> 16) & 255u); v1[3] *= (float)(g[1] >> 24);
                    u32x4 w; w.x = cvt_pk_bf16(v0[0], v0[1]); w.y = cvt_pk_bf16(v0[2], v0[3]); w.z = cvt_pk_bf16(v1[0], v1[1]); w.w = cvt_pk_bf16(v1[2], v1[3]);
                    *(u32x4*)(merged + (size_t)row * 2048 + col) = w; }
    }
};
struct EpiRes {
    static constexpr bool PERM = false, AFTER_DRAIN = false;
    const bf16_t* x; bf16_t* x1b; float* ssq;
    __device__ __forceinline__ void operator()(const f32x4 (&acc)[2][2][4][2], const Unit& u, int wr, int wc, int fr, int fq) const {
        const int row0 = u.pm * BM + wr * 64 + fr, col0 = u.pn * BM + wc * 32 + 4 * fq;
#pragma unroll
        for (int ai = 0; ai < 2; ++ai) {
            typedef unsigned u32x2v __attribute__((ext_vector_type(2))); u32x2v xq[4][2][2];
#pragma unroll
            for (int m = 0; m < 4; ++m)
#pragma unroll
                for (int bj = 0; bj < 2; ++bj)
#pragma unroll
                    for (int n = 0; n < 2; ++n) xq[m][bj][n] = *(const u32x2v*)(x + (size_t)(row0 + ai * HALF + m * 16) * 2048 + col0 + bj * HALF + n * 16);
#pragma unroll
            for (int m = 0; m < 4; ++m) { const int row = row0 + ai * HALF + m * 16; const size_t off = (size_t)row * 2048 + col0; float s = 0.f;
#pragma unroll
                for (int bj = 0; bj < 2; ++bj)
#pragma unroll
                    for (int n = 0; n < 2; ++n) { const size_t o = off + bj * HALF + n * 16; const u32x2v xv = xq[m][bj][n]; const f32x4 v = (f32x4){bf_lo(xv.x), bf_hi(xv.x), bf_lo(xv.y), bf_hi(xv.y)} + acc[ai][bj][m][n];
                        u32x2v w; w.x = cvt_pk_bf16(v[0], v[1]); w.y = cvt_pk_bf16(v[2], v[3]);
                        *(u32x2v*)(x1b + o) = w; s += (v[0] * v[0] + v[1] * v[1]) + (v[2] * v[2] + v[3] * v[3]); }
                s += __shfl_xor(s, 16); s += __shfl_xor(s, 32);
                if (fq == 0) ssq[(size_t)row * 32 + u.pn * 4 + wc] = s; }
        }
    }
};
struct EpiQ {
    static constexpr bool PERM = true, AFTER_DRAIN = false;
    bf16_t* out; const float* rstd2;
    __device__ __forceinline__ void operator()(const f32x4 (&acc)[2][2][4][2], const Unit& u, int wr, int wc, int fr, int fq) const {
        const int row0 = u.pm * BM + wr * 64 + fr, col0 = u.pn * BM + wc * 32 + 8 * fq;
        float rr[2][4];
#pragma unroll
        for (int ai = 0; ai < 2; ++ai)
#pragma unroll
            for (int m = 0; m < 4; ++m) rr[ai][m] = rstd2[row0 + ai * HALF + m * 16];
#pragma unroll
        for (int ai = 0; ai < 2; ++ai)
#pragma unroll
            for (int m = 0; m < 4; ++m) { const int row = row0 + ai * HALF + m * 16; const float r = rr[ai][m];
#pragma unroll
                for (int bj = 0; bj < 2; ++bj) { const f32x4 v0 = acc[ai][bj][m][0] * r, v1 = acc[ai][bj][m][1] * r;
                    u32x4 w; w.x = cvt_pk_bf16(v0[0], v0[1]); w.y = cvt_pk_bf16(v0[2], v0[3]); w.z = cvt_pk_bf16(v1[0], v1[1]); w.w = cvt_pk_bf16(v1[2], v1[3]);
                    *(u32x4*)(out + (size_t)row * 2048 + col0 + bj * HALF) = w; } }
    }
};

template <class Epi, class Sched, bool ALIGN_EPI = false, bool SP2 = false, bool FP8 = false, int MIDT = 0>
__device__ __forceinline__ void gemm_phase(PG8_LAS unsigned char* lds, const Gemm g, const Sched& S, const Epi& E, const int wid_in) {
    const int wid = wid_in, lane = (int)__builtin_amdgcn_mbcnt_hi(~0u, __builtin_amdgcn_mbcnt_lo(~0u, 0u)), tid = wid * 64 + lane, wr = wid >> 2, wc = wid & 3, fr = lane & 15, fq = lane >> 4;
    const int K = g.K, nt = K / BK;
    unsigned voffA[2], voffB[2];
#pragma unroll
    for (int i = 0; i < 2; ++i) { int R, C; stage_rc(tid * 16 + i * 8192, R, C); const int Rb = Epi::PERM ? ((R & ~31) + perm32(R & 31)) : R;
        voffA[i] = (unsigned)(R * K + C) * 2u; voffB[i] = (unsigned)(Rb * K + C) * 2u; }
    const size_t half64 = (size_t)64 * K * 2;
    const size_t kstep = (size_t)(BK * 2);
    const size_t hstep = (size_t)HALF * K * 2;
    const size_t tstep = 2 * hstep;
    const unsigned ldsw = (unsigned)wid * 1024u; const unsigned ldsw_base = (unsigned)__builtin_amdgcn_readfirstlane((int)((unsigned)(uintptr_t)lds + ldsw));
    const int aoff = lds_byte(wr * 64 + fr, fq * 8), boff = lds_byte(wc * 32 + fr, fq * 8);
    const PG8_LAS unsigned char* const ldsA = lds + aoff; const PG8_LAS unsigned char* const ldsB = lds + 4 * HTB + boff;
#define PG8_SA(b, h) (((b) * 2 + (h)) * HTB)
#define PG8_SB(b, h) ((4 + (b) * 2 + (h)) * HTB)
#define PG8_STAGE(bufoff, gbase, voff) do { _Pragma("unroll") for (int _i = 0; _i < 2; ++_i) \
        asm volatile("s_add_u32 m0, %2, %3\n\ts_nop 0\n\tglobal_load_lds_dwordx4 %0, %1" : : "v"((voff)[0]), "s"((const char*)(gbase) + (size_t)_i * half64), "s"(ldsw_base), "i"((bufoff) + _i * 8192) : "memory", "scc"); } while (0)
#define PG8_LDA(dst, b, h) do { _Pragma("unroll") for (int m = 0; m < 4; ++m) { if constexpr (FP8) { const i32x4_ r0_ = *(const PG8_LAS i32x4_*)(ldsA + PG8_SA(b, h) + m * 2048), r1_ = *(const PG8_LAS i32x4_*)(ldsA + PG8_SA(b, h) + m * 2048 + 1024); dst##8[m] = __builtin_shufflevector(r0_, r1_, 0, 1, 2, 3, 4, 5, 6, 7); } \
        else { _Pragma("unroll") for (int k = 0; k < 2; ++k) dst[m][k] = *(const PG8_LAS bf16x8*)(ldsA + PG8_SA(b, h) + m * 2048 + k * 1024); } } } while (0)
#define PG8_LDB(dst, b, h) do { _Pragma("unroll") for (int n = 0; n < 2; ++n) { if constexpr (FP8) { const i32x4_ r0_ = *(const PG8_LAS i32x4_*)(ldsB + (PG8_SB(b, h) - 4 * HTB) + n * 2048), r1_ = *(const PG8_LAS i32x4_*)(ldsB + (PG8_SB(b, h) - 4 * HTB) + n * 2048 + 1024); dst##8[n] = __builtin_shufflevector(r0_, r1_, 0, 1, 2, 3, 4, 5, 6, 7); } \
        else { _Pragma("unroll") for (int k = 0; k < 2; ++k) dst[n][k] = *(const PG8_LAS bf16x8*)(ldsB + (PG8_SB(b, h) - 4 * HTB) + n * 2048 + k * 1024); } } } while (0)
#define PG8_MMA(ai, bj, At, Bt) do { __builtin_amdgcn_s_setprio(1); _Pragma("unroll") for (int m = 0; m < 4; ++m) _Pragma("unroll") for (int n = 0; n < 2; ++n) { \
        if constexpr (FP8) acc[ai][bj][m][n] = __builtin_amdgcn_mfma_scale_f32_16x16x128_f8f6f4(Bt##8[n], At##8[m], acc[ai][bj][m][n], 0, 0, 0, 127, 0, 127); \
        else { _Pragma("unroll") for (int k = 0; k < 2; ++k) acc[ai][bj][m][n] = __builtin_amdgcn_mfma_f32_16x16x32_bf16(Bt[n][k], At[m][k], acc[ai][bj][m][n], 0, 0, 0); } } \
        __builtin_amdgcn_s_setprio(0); } while (0)
#define PG8_WAIT_V(n) asm volatile("s_waitcnt vmcnt(" #n ")" ::: "memory")
#define PG8_WAIT_L(n) asm volatile("s_waitcnt lgkmcnt(" #n ")" ::: "memory")
#define PG8_BAR __builtin_amdgcn_s_barrier()
#define PG8_SCHED __builtin_amdgcn_sched_barrier(0)
    Unit cur, nxt; int ui = 0;
    if (!S.next(0, cur)) return;
    f32x4 acc[2][2][4][2];
#pragma unroll
    for (int a = 0; a < 2; ++a)
#pragma unroll
        for (int b = 0; b < 2; ++b)
#pragma unroll
            for (int m = 0; m < 4; ++m)
#pragma unroll
                for (int n = 0; n < 2; ++n) acc[a][b][m][n] = (f32x4){0.f, 0.f, 0.f, 0.f};
    typedef int i32x8_ __attribute__((ext_vector_type(8))); typedef int i32x4_ __attribute__((ext_vector_type(4)));
    bf16x8 At[4][2], B0[2][2], B1[2][2]; i32x8_ At8[4], B08[2], B18[2];
    const char* cA = (const char*)g.A + (size_t)cur.pm * tstep; const char* cB = (const char*)g.Bt + (size_t)cur.pn * tstep;
    S.a_ready(cur);
    if constexpr (SP2) {
        PG8_STAGE(PG8_SB(0, 0), cB, voffB); PG8_STAGE(PG8_SB(0, 1), cB + hstep, voffB); PG8_STAGE(PG8_SA(0, 0), cA, voffA); PG8_STAGE(PG8_SA(0, 1), cA + hstep, voffA);
        if (wr == 1) PG8_BAR;
        PG8_WAIT_V(2); PG8_BAR;
        PG8_STAGE(PG8_SB(1, 0), cB + kstep, voffB); PG8_STAGE(PG8_SA(1, 0), cA + kstep, voffA); PG8_STAGE(PG8_SB(1, 1), cB + hstep + kstep, voffB);
        PG8_WAIT_V(6); PG8_BAR;
    } else {
        PG8_STAGE(PG8_SB(0, 0), cB, voffB); PG8_STAGE(PG8_SA(0, 0), cA, voffA); PG8_STAGE(PG8_SB(0, 1), cB + hstep, voffB); PG8_STAGE(PG8_SA(0, 1), cA + hstep, voffA);
        if (wr == 1) PG8_BAR;
        PG8_WAIT_V(4); PG8_BAR;
        PG8_STAGE(PG8_SB(1, 0), cB + kstep, voffB); PG8_STAGE(PG8_SA(1, 0), cA + kstep, voffA); PG8_STAGE(PG8_SB(1, 1), cB + hstep + kstep, voffB);
        PG8_WAIT_V(6); PG8_BAR;
    }
    for (;;) {
        const bool has_next = S.next(ui + 1, nxt);
        const char* nA = has_next ? (const char*)g.A + (size_t)nxt.pm * tstep : cA; const char* nB = has_next ? (const char*)g.Bt + (size_t)nxt.pn * tstep : cB;
        for (int t = 0; t < nt; t += 2) {
            const bool last = (t == nt - 2);
            const char* a1 = cA + (size_t)(t + 1) * kstep;
            const char* a2 = last ? nA : cA + (size_t)(t + 2) * kstep; const char* b2 = last ? nB : cB + (size_t)(t + 2) * kstep;
            const char* a3 = a2 + kstep; const char* b3 = b2 + kstep;
            if (last && has_next) S.a_ready(nxt);
            if constexpr (MIDT > 0) { if (t == MIDT) { int laneM = (int)__builtin_amdgcn_mbcnt_hi(~0u, __builtin_amdgcn_mbcnt_lo(~0u, 0u)); asm volatile("" : "+v"(laneM)); const int widM = wid_in;
                E.mid(acc, cur, widM >> 2, widM & 3, laneM & 15, laneM >> 4); } }
            if constexpr (SP2) {
            PG8_LDB(B0, 0, 0); PG8_LDB(B1, 0, 1); PG8_SCHED; PG8_LDA(At, 0, 0); PG8_STAGE(PG8_SA(1, 1), a1 + hstep, voffA);
            PG8_WAIT_V(8); PG8_WAIT_L(0); PG8_BAR; PG8_MMA(0, 0, At, B0); PG8_MMA(0, 1, At, B1); PG8_BAR; PG8_SCHED;
            PG8_LDA(At, 0, 1); PG8_STAGE(PG8_SB(0, 0), b2, voffB); PG8_STAGE(PG8_SB(0, 1), b2 + hstep, voffB); PG8_STAGE(PG8_SA(0, 0), a2, voffA);
            PG8_WAIT_V(8); PG8_WAIT_L(0); PG8_BAR; PG8_MMA(1, 0, At, B0); PG8_MMA(1, 1, At, B1); PG8_BAR; PG8_SCHED;
            PG8_LDB(B0, 1, 0); PG8_LDB(B1, 1, 1); PG8_SCHED; PG8_LDA(At, 1, 0); PG8_STAGE(PG8_SA(0, 1), a2 + hstep, voffA);
            PG8_WAIT_V(8); PG8_WAIT_L(0); PG8_BAR; PG8_MMA(0, 0, At, B0); PG8_MMA(0, 1, At, B1); PG8_BAR; PG8_SCHED;
            PG8_LDA(At, 1, 1); PG8_STAGE(PG8_SB(1, 0), b3, voffB); PG8_STAGE(PG8_SB(1, 1), b3 + hstep, voffB); PG8_STAGE(PG8_SA(1, 0), a3, voffA);
            PG8_WAIT_V(8); PG8_WAIT_L(0); PG8_BAR; PG8_MMA(1, 0, At, B0); PG8_MMA(1, 1, At, B1); PG8_BAR; PG8_SCHED;
            } else {
            PG8_LDB(B0, 0, 0); PG8_SCHED; PG8_LDA(At, 0, 0); PG8_STAGE(PG8_SA(1, 1), a1 + hstep, voffA);
            PG8_WAIT_L(8); PG8_BAR; PG8_WAIT_L(0); PG8_MMA(0, 0, At, B0); PG8_BAR; PG8_SCHED;
            PG8_LDB(B1, 0, 1); PG8_STAGE(PG8_SB(0, 0), b2, voffB);
            PG8_BAR; PG8_WAIT_L(0); PG8_MMA(0, 1, At, B1); PG8_BAR;
            PG8_LDA(At, 0, 1); PG8_STAGE(PG8_SA(0, 0), a2, voffA);
            PG8_BAR; PG8_WAIT_L(0); PG8_MMA(1, 0, At, B0); PG8_BAR; PG8_SCHED;
            PG8_STAGE(PG8_SB(0, 1), b2 + hstep, voffB);
            PG8_WAIT_V(6); PG8_BAR; PG8_MMA(1, 1, At, B1); PG8_BAR;
            PG8_LDB(B0, 1, 0); PG8_SCHED; PG8_LDA(At, 1, 0); PG8_STAGE(PG8_SA(0, 1), a2 + hstep, voffA);
            PG8_WAIT_L(8); PG8_BAR; PG8_WAIT_L(0); PG8_MMA(0, 0, At, B0); PG8_BAR; PG8_SCHED;
            PG8_LDB(B1, 1, 1); PG8_STAGE(PG8_SB(1, 0), b3, voffB);
            PG8_BAR; PG8_WAIT_L(0); PG8_MMA(0, 1, At, B1); PG8_BAR;
            PG8_LDA(At, 1, 1); PG8_STAGE(PG8_SA(1, 0), a3, voffA);
            PG8_BAR; PG8_WAIT_L(0); PG8_MMA(1, 0, At, B0); PG8_BAR; PG8_SCHED;
            PG8_STAGE(PG8_SB(1, 1), b3 + hstep, voffB);
            PG8_WAIT_V(6); PG8_BAR; PG8_MMA(1, 1, At, B1); PG8_BAR;
            }
        }
        if constexpr (ALIGN_EPI) { if (wr == 0) PG8_BAR; }
        if constexpr (!Epi::AFTER_DRAIN) { int laneE = (int)__builtin_amdgcn_mbcnt_hi(~0u, __builtin_amdgcn_mbcnt_lo(~0u, 0u)); asm volatile("" : "+v"(laneE));
            const int widE = wid_in; E(acc, cur, widE >> 2, widE & 3, laneE & 15, laneE >> 4); S.done(cur); }
        if (!has_next) break;
#pragma unroll
        for (int a = 0; a < 2; ++a)
#pragma unroll
            for (int b = 0; b < 2; ++b)
#pragma unroll
                for (int m = 0; m < 4; ++m)
#pragma unroll
                    for (int n = 0; n < 2; ++n) acc[a][b][m][n] = (f32x4){0.f, 0.f, 0.f, 0.f};
        cur = nxt; cA = nA; cB = nB; ++ui;
        if constexpr (ALIGN_EPI) { if (wr == 1) PG8_BAR; }
    }
    PG8_WAIT_V(0);
    if constexpr (!ALIGN_EPI) { if (wr == 0) PG8_BAR; }
    PG8_BAR;
    if constexpr (Epi::AFTER_DRAIN) { E.fused(acc, cur, wr, wc, fr, fq, lds, wid, lane); S.done(cur); }
#undef PG8_SA
#undef PG8_SB
#undef PG8_STAGE
#undef PG8_LDA
#undef PG8_LDB
#undef PG8_MMA
#undef PG8_WAIT_V
#undef PG8_WAIT_L
#undef PG8_BAR
#undef PG8_SCHED
}
}

constexpr int NWAVES = 8;
constexpr int BATCH = 2, SEQ = 8192, DM = 2048, T = BATCH * SEQ;
constexpr int IN_WIDTH = 11280, NPROJ = 11264;
constexpr int NH = 8, HD = 128;
constexpr int NEXP = 16384, NKEYS = 128, TOPK = 16;
constexpr float EPS = 1e-6f;
constexpr float LOG2E = 1.4426950408889634f;
constexpr int SEGTOK = 1024, NSEG = SEQ / SEGTOK;

constexpr size_t MiB = 1u << 20;
constexpr size_t WS_CTL = 0, CTL_ZERO_BYTES = 1 * MiB;
constexpr size_t WS_IF = 1 * MiB;
constexpr size_t WS_RSTD1 = 2 * MiB;
constexpr size_t WS_LAM = 2 * MiB + 64 * 1024;
constexpr size_t WS_FCUM = 2 * MiB + 128 * 1024;
constexpr size_t WS_LIT = 2 * MiB + 640 * 1024;
constexpr size_t WS_WA = 4 * MiB, WS_WB = 8 * MiB, WS_WOUT = 12 * MiB, WS_WQ = 20 * MiB;
constexpr size_t WS_SK = 28 * MiB;
constexpr size_t WS_WIF = 28 * MiB + 512 * 1024;
constexpr size_t WS_SSQ = 29 * MiB;
constexpr size_t WS_WIN = 32 * MiB;
constexpr size_t WS_CSEG = 32 * MiB;
constexpr int NSENS = 2048;
constexpr size_t WS_WINB = 60 * MiB;
constexpr size_t WS_XB = 76 * MiB;
constexpr size_t OUT_MQC = 0, OUT_MKC = 32 * MiB;
constexpr size_t WS_BB = 44 * MiB;
constexpr size_t WS_QA = 140 * MiB;
constexpr size_t SEG_STRIDE = 32 * MiB;
constexpr size_t WS_KA = WS_QA + SEG_STRIDE, WS_VA = WS_QA + 2 * SEG_STRIDE, WS_MQ = WS_QA + 3 * SEG_STRIDE, WS_MK = WS_QA + 4 * SEG_STRIDE, WS_MV = WS_QA + 5 * SEG_STRIDE, WS_MO = WS_QA + 6 * SEG_STRIDE;
constexpr size_t WS_AB = 428 * MiB;
constexpr size_t WS_MERGED = WS_KA;
constexpr size_t WS_X1B = WS_MQ;
constexpr size_t WS_QP = WS_MV;
constexpr size_t WS_GATES = 364 * MiB;
constexpr size_t WS_UB = 364 * MiB, WS_VB = 428 * MiB, WS_VB6 = 396 * MiB;
constexpr size_t WS_PART = 140 * MiB;
constexpr size_t WS_ACT = 204 * MiB;
constexpr size_t WS_SSQ2 = 212 * MiB;
constexpr size_t WS_RSTD2 = 215 * MiB;
constexpr size_t WS_X8 = 420 * MiB;
constexpr size_t WS_X6 = 420 * MiB;
constexpr size_t WS_Y = 300 * MiB;
constexpr size_t WS_SCU = 31 * MiB, WS_SCV = 31 * MiB + 256 * 1024;
constexpr size_t WS_IDX = 492 * MiB, WS_GATE = 500 * MiB;
constexpr size_t WS_END = 508 * MiB;
constexpr int CSEG_STRIDE = 128 * 128 + 128 + 8;
static_assert((size_t)16 * NSEG * CSEG_STRIDE * 4 <= 44 * MiB, "CSEG fits W_in region");
constexpr int CW_BAR = 4096;
constexpr int CW_KMAX = 20480;
constexpr int CW_QUEUE = 24576;
constexpr int CW_CONVCNT = 18432;
constexpr int CONV_WGS = 64;
constexpr int CW_SEGCNT = 16384;

constexpr int RING_OFF = 0, RING_BYTES = 131072;
constexpr int LDSCTL_OFF = RING_BYTES, MISC_OFF = LDSCTL_OFF + 320;
constexpr int LDS_BYTES = 147456;

#define GAS __attribute__((address_space(1)))
#define LAS __attribute__((address_space(3)))
typedef unsigned short bf16;
typedef unsigned v4u __attribute__((ext_vector_type(4)));
typedef float f32x4 __attribute__((ext_vector_type(4)));
typedef short bf16x8 __attribute__((ext_vector_type(8)));
typedef GAS unsigned gu32;
typedef GAS unsigned long long gu64;
#define RLX_AGENT __ATOMIC_RELAXED, __HIP_MEMORY_SCOPE_AGENT
#define LDS_WAIT() asm volatile("s_waitcnt lgkmcnt(0)" ::: "memory")
#define VM_WAIT() asm volatile("s_waitcnt vmcnt(0)" ::: "memory")
__device__ __forceinline__ unsigned long long rt() { return __builtin_amdgcn_s_memrealtime(); }
__device__ __forceinline__ unsigned f2bf(float f) { unsigned u = __builtin_bit_cast(unsigned, f); return (u + 0x7fffu + ((u >> 16) & 1u)) >> 16; }
__device__ __forceinline__ unsigned pk2(float lo, float hi) { return f2bf(lo) | (f2bf(hi) << 16); }

#define XB_TMO      128
#define XB_XCNT(j)  (256  + 64 * (j))
#define XB_XSUB(j)  (1280 + 64 * (j))
#define XB_XGEN(j)  (2304 + 64 * (j))
#define XB_TOP      3328
#define XB_TOPGEN   3392
#define XCD_BAR_WORDS 3456
#define XB_SPIN_CAP (1u << 18)

__device__ __forceinline__ unsigned xb_ld(unsigned* p)              { return __hip_atomic_load(p, __ATOMIC_RELAXED, __HIP_MEMORY_SCOPE_AGENT); }
__device__ __forceinline__ unsigned xb_add(unsigned* p, unsigned v) { return __hip_atomic_fetch_add(p, v, __ATOMIC_RELAXED, __HIP_MEMORY_SCOPE_AGENT); }
__device__ __forceinline__ unsigned xb_xcc_id() { return (unsigned)__builtin_amdgcn_s_getreg((3 << 11) | 20) & 0xFu; }
#define XB_SPIN(cond, bar) do { unsigned _sp = 0; while (cond) { __builtin_amdgcn_s_sleep(1); \
    if ((++_sp & 255u) == 0u) { if (xb_ld(&(bar)[XB_TMO])) break; if (_sp > XB_SPIN_CAP) { atomicAdd(&(bar)[XB_TMO], 1u); break; } } } } while (0)

struct XcdBarrier {
    unsigned* bar; unsigned x;
    volatile LAS unsigned* st;
    bool w0;
};
__device__ __forceinline__ int xb_lane_id() { return (int)__builtin_amdgcn_mbcnt_hi(~0u, __builtin_amdgcn_mbcnt_lo(~0u, 0u)); }

__device__ __forceinline__ XcdBarrier xcd_barrier_post(unsigned* bar, volatile LAS unsigned* st, int wave) {
    XcdBarrier b; b.bar = bar; b.x = xb_xcc_id(); b.st = st; b.w0 = wave == 0;
    if (b.w0 && xb_lane_id() == 0) (void)xb_add(&bar[XB_XCNT(b.x)], 1u);
    return b;
}
__device__ __forceinline__ void xcd_barrier_complete(unsigned* bar, unsigned x, unsigned& nloc, unsigned& nx) {
    const unsigned G = gridDim.x * gridDim.y * gridDim.z;
    unsigned sum, cnt, mine, sp = 0u;
    for (;;) {
        sum = 0u; cnt = 0u; mine = 0u;
#pragma unroll
        for (unsigned j = 0; j < 16; ++j) { const unsigned c = xb_ld(&bar[XB_XCNT(j)]); sum += c; cnt += (c > 0u) ? 1u : 0u; mine = (j == x) ? c : mine; }
        if (sum == G) break;
        __builtin_amdgcn_s_sleep(1);
        if ((++sp & 255u) == 0u) { if (xb_ld(&bar[XB_TMO])) break; if (sp > XB_SPIN_CAP) { atomicAdd(&bar[XB_TMO], 1u); break; } }
    }
    nloc = mine > 0u ? mine : 1u; nx = cnt > 0u ? cnt : 1u;
}

__device__ __forceinline__ void xcd_barrier(const XcdBarrier& b) {
    asm volatile("s_waitcnt vmcnt(0)" ::: "memory");
    __syncthreads();
    if (b.w0 && xb_lane_id() == 0) {
        unsigned* bar = b.bar;
        __builtin_amdgcn_s_waitcnt(0);
        unsigned nloc = b.st[0], nx = b.st[1];
        if (nloc == 0u) { xcd_barrier_complete(bar, b.x, nloc, nx); b.st[0] = nloc; b.st[1] = nx; }
        const unsigned old = xb_add(&bar[XB_XSUB(b.x)], 1u);
        const unsigned gen = old / nloc;
        if (old + 1u == (gen + 1u) * nloc) {
            __builtin_amdgcn_fence(__ATOMIC_RELEASE, "agent");
            asm volatile("s_waitcnt vmcnt(0)" ::: "memory");
            const unsigned og = xb_add(&bar[XB_TOP], 1u);
            const unsigned tg = og / nx;
            if (og + 1u == (tg + 1u) * nx) xb_add(&bar[XB_TOPGEN], 1u);
            else XB_SPIN(xb_ld(&bar[XB_TOPGEN]) == tg, bar);
            __builtin_amdgcn_fence(__ATOMIC_ACQUIRE, "agent");
            xb_add(&bar[XB_XGEN(b.x)], 1u);
            asm volatile("s_waitcnt vmcnt(0)" ::: "memory");
        } else {
            XB_SPIN(xb_ld(&bar[XB_XGEN(b.x)]) == gen, bar);
            __builtin_amdgcn_fence(__ATOMIC_ACQUIRE, "agent");
            asm volatile("s_waitcnt vmcnt(0)" ::: "memory");
        }
    }
    __syncthreads();
}

struct Frame {
    LAS unsigned char* lds;
    volatile LAS unsigned* MISC;
    gu32* ctl;
    unsigned char* ws;
    int tid, lane, wave;
    int vcu, G;
    const float* const* in;
    float* out;
};
typedef unsigned u32x2 __attribute__((ext_vector_type(2)));
typedef float f32x16 __attribute__((ext_vector_type(16)));
typedef short s16x4 __attribute__((ext_vector_type(4)));

__device__ __forceinline__ float wave_sum(float v) {
#pragma unroll
    for (int o = 1; o < 64; o <<= 1) v += __shfl_xor(v, o);
    return v;
}
__device__ __forceinline__ float wave_max(float v) {
#pragma unroll
    for (int o = 1; o < 64; o <<= 1) v = fmaxf(v, __shfl_xor(v, o));
    return v;
}
__device__ __forceinline__ float bflo(unsigned w) { return __uint_as_float(w << 16); }
__device__ __forceinline__ float bfhi(unsigned w) { return __uint_as_float(w & 0xffff0000u); }
__device__ __forceinline__ unsigned cvtpk(float lo, float hi) { unsigned r; asm volatile("v_cvt_pk_bf16_f32 %0, %1, %2" : "=v"(r) : "v"(lo), "v"(hi)); return r; }

template <bool HASG> __device__ __forceinline__ void transpose_item(const float* W, int ldw, int src_col0, int k0, bf16* WT, int ldt, int dst_row0, const float* gk, LAS float* scr, int lane) {
    { const float* wp_ = W + (size_t)(k0 + (lane >> 3)) * ldw + src_col0 + 4 * (lane & 7); const float* gp_ = gk + k0 + (lane >> 3); LAS float* sp_ = scr + (lane >> 3) * 33 + 4 * (lane & 7);
      f32x4 v[8]; float gq[8];
#pragma unroll
      for (int i = 0; i < 8; ++i) { v[i] = *(const f32x4*)(wp_ + (size_t)(8 * i) * ldw); if constexpr (HASG) gq[i] = gp_[8 * i]; else gq[i] = 1.0f; }
#pragma unroll
      for (int i = 0; i < 8; ++i) { sp_[8 * i * 33] = v[i][0] * gq[i]; sp_[8 * i * 33 + 1] = v[i][1] * gq[i]; sp_[8 * i * 33 + 2] = v[i][2] * gq[i]; sp_[8 * i * 33 + 3] = v[i][3] * gq[i]; } }
    LDS_WAIT(); asm volatile("" ::: "memory");
    const int c = lane & 7;
#pragma unroll
    for (int j = 0; j < 4; ++j) { const int n = (lane >> 3) + 8 * j; const LAS float* s = scr + (8 * c) * 33 + n;
        v4u o; o.x = pk2(s[0 * 33], s[1 * 33]); o.y = pk2(s[2 * 33], s[3 * 33]); o.z = pk2(s[4 * 33], s[5 * 33]); o.w = pk2(s[6 * 33], s[7 * 33]);
        *(GAS v4u*)(WT + (size_t)(dst_row0 + n) * ldt + k0 + 8 * c) = o; }
    LDS_WAIT(); asm volatile("" ::: "memory");
}
template <bool HASG> __device__ __forceinline__ void transpose_item8(const float* W, int ldw, int src_col0, int k0, unsigned char* WT8, int ldt, int dst_row0, const float* gk, float scale, LAS float* scr, int lane) {
    { const float* wp_ = W + (size_t)(k0 + (lane >> 3)) * ldw + src_col0 + 4 * (lane & 7); const float* gp_ = gk + k0 + (lane >> 3); LAS float* sp_ = scr + (lane >> 3) * 33 + 4 * (lane & 7);
      f32x4 v[8]; float gq[8];
#pragma unroll
      for (int i = 0; i < 8; ++i) { v[i] = *(const f32x4*)(wp_ + (size_t)(8 * i) * ldw); if constexpr (HASG) gq[i] = gp_[8 * i]; else gq[i] = 1.0f; }
#pragma unroll
      for (int i = 0; i < 8; ++i) gq[i] *= scale;
#pragma unroll
      for (int i = 0; i < 8; ++i) { sp_[8 * i * 33] = v[i][0] * gq[i]; sp_[8 * i * 33 + 1] = v[i][1] * gq[i]; sp_[8 * i * 33 + 2] = v[i][2] * gq[i]; sp_[8 * i * 33 + 3] = v[i][3] * gq[i]; } }
    LDS_WAIT(); asm volatile("" ::: "memory");
    const int c = lane & 7;
#pragma unroll
    for (int j = 0; j < 4; ++j) { const int n = (lane >> 3) + 8 * j; const LAS float* s = scr + (8 * c) * 33 + n;
        int p0 = __builtin_amdgcn_cvt_pk_fp8_f32(s[0 * 33], s[1 * 33], 0, false); p0 = __builtin_amdgcn_cvt_pk_fp8_f32(s[2 * 33], s[3 * 33], p0, true);
        int p1 = __builtin_amdgcn_cvt_pk_fp8_f32(s[4 * 33], s[5 * 33], 0, false); p1 = __builtin_amdgcn_cvt_pk_fp8_f32(s[6 * 33], s[7 * 33], p1, true);
        u32x2 o; o.x = (unsigned)p0; o.y = (unsigned)p1;
        *(GAS u32x2*)(WT8 + (size_t)(dst_row0 + n) * ldt + k0 + 8 * c) = o; }
    LDS_WAIT(); asm volatile("" ::: "memory");
}
constexpr float WIN_SCALE = 64.0f;
__device__ __forceinline__ void p1_wprep(Frame& F) {
    LAS float* scr = (LAS float*)(F.lds + RING_OFF + F.wave * 16384);
    const int gw = (F.vcu >> 1) * NWAVES + F.wave, NGW = (F.G >> 1) * NWAVES, lane = F.lane;
    const float* w_a = F.in[9]; const float* w_b = F.in[10]; const float* w_out = F.in[11]; const float* norm_ffn = F.in[12]; const float* peer_query = F.in[13];
    bf16* WA = (bf16*)(F.ws + WS_WA); bf16* WOUT = (bf16*)(F.ws + WS_WOUT); bf16* WQ = (bf16*)(F.ws + WS_WQ);
    constexpr int I_A = 16 * 64, I_B = 16 * 64, I_OUT = 32 * 64, I_Q = 32 * 64;
    for (int it = gw; it < I_A + I_B + I_OUT + I_Q; it += NGW) {
        int r = it;
        if (r < I_A) { const int kb = r / 64, nb = r % 64; transpose_item<false>(w_a, 2048, nb * 32, kb * 64, WA, 2048, nb * 32, w_a, scr, lane); continue; } r -= I_A;
        if (r < I_B) { const int kb = r / 64, nb = r % 64; transpose_item<false>(w_b, 2048, nb * 32, kb * 64, WA + 1024, 2048, nb * 32, w_b, scr, lane);     continue; } r -= I_B;
        if (r < I_OUT) { const int kb = r / 64, nb = r % 64; transpose_item<false>(w_out, 2048, nb * 32, kb * 64, WOUT, 2048, nb * 32, w_out, scr, lane); continue; } r -= I_OUT;
        if (r < I_Q) { const int kb = r / 64, nb = r % 64; transpose_item<true>(peer_query, 2048, nb * 32, kb * 64, WQ, 2048, nb * 32, norm_ffn, scr, lane); }
    }
}
__device__ __forceinline__ void p0_prep(Frame& F) {
    LAS float* scr = (LAS float*)(F.lds + RING_OFF + F.wave * 16384);
    const int gw = F.vcu * NWAVES + F.wave, NGW = F.G * NWAVES, lane = F.lane;
    const float* x = F.in[0]; const float* norm_mix = F.in[1]; const float* w_in = F.in[2];
    const float* da_lambda = F.in[6];
    const float* w_a = F.in[9]; const float* w_b = F.in[10]; const float* w_out = F.in[11]; const float* norm_ffn = F.in[12]; const float* peer_query = F.in[13]; const float* subkeys = F.in[14];
    bf16* WIN = (bf16*)(F.ws + WS_WIN); bf16* WA = (bf16*)(F.ws + WS_WA); bf16* WB = (bf16*)(F.ws + WS_WB); bf16* WOUT = (bf16*)(F.ws + WS_WOUT); bf16* WQ = (bf16*)(F.ws + WS_WQ);
    bf16* SK = (bf16*)(F.ws + WS_SK); bf16* WIF = (bf16*)(F.ws + WS_WIF); bf16* XB = (bf16*)(F.ws + WS_XB); float* RSTD1 = (float*)(F.ws + WS_RSTD1);
    constexpr int I_IN = 32 * 352, I_A = 16 * 64, I_B = 16 * 64, I_OUT = 32 * 64, I_Q = 32 * 64, I_IF = 512, I_SK = 512, I_LAM = 1;
    constexpr int NITEMS = I_IN + I_IF + I_SK + I_LAM;
    for (int it = gw; it < NITEMS; it += NGW) {
        int r = it;
        if (r < I_IN) { const int kb = r / 352, nb = r % 352, n0 = nb * 32;
            if (n0 < NSENS) transpose_item<true>(w_in, IN_WIDTH, n0, kb * 64, (bf16*)(F.ws + WS_WINB), DM, n0, norm_mix, scr, lane);
            else transpose_item8<true>(w_in, IN_WIDTH, n0 + (n0 >= 7168 ? 16 : 0), kb * 64, (unsigned char*)WIN, DM, n0 - NSENS, norm_mix, WIN_SCALE, scr, lane);
            continue; } r -= I_IN;
        if (r < I_IF) { const int e = r * 64 + lane, j = e >> 11, k = e & 2047; WIF[e] = (bf16)f2bf(w_in[(size_t)k * IN_WIDTH + 7168 + j] * norm_mix[k]); continue; } r -= I_IF;
        if (r < I_SK) {
#pragma unroll
            for (int q = 0; q < 2; ++q) { const int e = r * 512 + q * 256 + lane * 4; const f32x4 v = *(const f32x4*)(subkeys + e); u32x2 w; w.x = pk2(v[0], v[1]); w.y = pk2(v[2], v[3]); *(u32x2*)(SK + e) = w; }
            continue; } r -= I_SK;
        { float a = da_lambda[lane] * da_lambda[64 + lane], b = da_lambda[128 + lane] * da_lambda[192 + lane]; a = wave_sum(a); b = wave_sum(b);
          if (lane == 0) ((float*)(F.ws + WS_LAM))[0] = __expf(a) - __expf(b) + 0.2f; }
    }
    unsigned char* XB8 = (unsigned char*)F.out;
    for (int m = gw; m < T; m += NGW) {
        const GAS f32x4* xr = (const GAS f32x4*)(x + (size_t)m * DM) + lane; f32x4 v[8]; float s = 0.f;
#pragma unroll
        for (int j = 0; j < 8; ++j) { v[j] = xr[64 * j]; s += (v[j][0] * v[j][0] + v[j][1] * v[j][1]) + (v[j][2] * v[j][2] + v[j][3] * v[j][3]); }
        s = wave_sum(s);
        const float rs = 1.0f / sqrtf(s * (1.0f / DM) + EPS);
        GAS unsigned* o = (GAS unsigned*)(XB8 + (size_t)m * DM) + lane; GAS u32x2* ob = (GAS u32x2*)(XB + (size_t)m * DM) + lane;
#pragma unroll
        for (int j = 0; j < 8; ++j) { int p = __builtin_amdgcn_cvt_pk_fp8_f32(v[j][0] * rs, v[j][1] * rs, 0, false); p = __builtin_amdgcn_cvt_pk_fp8_f32(v[j][2] * rs, v[j][3] * rs, p, true); o[64 * j] = (unsigned)p;
            u32x2 w; w.x = pk2(v[j][0], v[j][1]); w.y = pk2(v[j][2], v[j][3]); ob[64 * j] = w; }
        if (lane == 0) RSTD1[m] = rs;
    }
}

__device__ __forceinline__ void p1_ifgates(Frame& F) {
    const int gw = (F.vcu >> 1) * NWAVES + F.wave, NGW = (F.G >> 1) * NWAVES, lane = F.lane;
    const bf16* WIF = (const bf16*)(F.ws + WS_WIF); const float* RSTD1 = (const float*)(F.ws + WS_RSTD1);
    const float* gbias = F.in[5]; float* IFO = (float*)(F.ws + WS_IF);
    for (int it = gw; it < T / 16; it += NGW) {
        const int t0 = it * 16; f32x4 acc = {0.f, 0.f, 0.f, 0.f};
        const bf16* ap = (const bf16*)(F.ws + WS_XB) + (size_t)(t0 + (lane & 15)) * DM + 8 * (lane >> 4); const bf16* bp = WIF + (size_t)(lane & 15) * DM + 8 * (lane >> 4);
#pragma unroll 8
        for (int ks = 0; ks < 64; ++ks) { const bf16x8 a = *(const bf16x8*)(ap + ks * 32); const bf16x8 b = *(const bf16x8*)(bp + ks * 32);
            acc = __builtin_amdgcn_mfma_f32_16x16x32_bf16(a, b, acc, 0, 0, 0); }
        const int col = lane & 15; const float bs = gbias[col];
#pragma unroll
        for (int j = 0; j < 4; ++j) { const int row = t0 + (lane >> 4) * 4 + j; IFO[(size_t)row * 16 + col] = acc[j] * RSTD1[row] + bs; }
    }
}

__device__ __forceinline__ void p2_conv_scan(Frame& F, const int cv, const int NW) {
    const float* conv_w = F.in[3]; const float* conv_b = F.in[4];
    const bf16* MQ = (const bf16*)(F.ws + WS_MQ); const bf16* MK = (const bf16*)(F.ws + WS_MK);
    bf16* MQC = (bf16*)((unsigned char*)F.out + OUT_MQC); bf16* MKC = (bf16*)((unsigned char*)F.out + OUT_MKC);
    const int nthr = NW * 512, gt = cv * 512 + F.tid;
    for (int item = gt; item < 256 * 1024; item += nthr) {
        const int cg = item & 255, run = item >> 8; const int c0 = (cg & 127) * 8; const bool isk = cg >= 128;
        const bf16* src = (isk ? MK : MQ) + c0; bf16* dst = (isk ? MKC : MQC) + c0; const int wc0 = (isk ? 1024 : 0) + c0;
        float w[4][8], bb[8];
#pragma unroll
        for (int j = 0; j < 4; ++j) { const f32x4 a = *(const f32x4*)(conv_w + j * 2048 + wc0), b = *(const f32x4*)(conv_w + j * 2048 + wc0 + 4);
            w[j][0] = a[0]; w[j][1] = a[1]; w[j][2] = a[2]; w[j][3] = a[3]; w[j][4] = b[0]; w[j][5] = b[1]; w[j][6] = b[2]; w[j][7] = b[3]; }
        { const f32x4 a = *(const f32x4*)(conv_b + wc0), b = *(const f32x4*)(conv_b + wc0 + 4); bb[0] = a[0]; bb[1] = a[1]; bb[2] = a[2]; bb[3] = a[3]; bb[4] = b[0]; bb[5] = b[1]; bb[6] = b[2]; bb[7] = b[3]; }
        const int t0 = run * 16; const bool first = (t0 & (SEQ - 1)) == 0;
        float h0[8], h1[8], h2[8];
#pragma unroll
        for (int e = 0; e < 8; ++e) { h0[e] = 0.f; h1[e] = 0.f; h2[e] = 0.f; }
        if (!first) {
            const v4u a = *(const v4u*)(src + (size_t)(t0 - 3) * 1024), b = *(const v4u*)(src + (size_t)(t0 - 2) * 1024), c = *(const v4u*)(src + (size_t)(t0 - 1) * 1024);
            h0[0] = bflo(a.x); h0[1] = bfhi(a.x); h0[2] = bflo(a.y); h0[3] = bfhi(a.y); h0[4] = bflo(a.z); h0[5] = bfhi(a.z); h0[6] = bflo(a.w); h0[7] = bfhi(a.w);
            h1[0] = bflo(b.x); h1[1] = bfhi(b.x); h1[2] = bflo(b.y); h1[3] = bfhi(b.y); h1[4] = bflo(b.z); h1[5] = bfhi(b.z); h1[6] = bflo(b.w); h1[7] = bfhi(b.w);
            h2[0] = bflo(c.x); h2[1] = bfhi(c.x); h2[2] = bflo(c.y); h2[3] = bfhi(c.y); h2[4] = bflo(c.z); h2[5] = bfhi(c.z); h2[6] = bflo(c.w); h2[7] = bfhi(c.w);
        }
        const float osc = isk ? 0.08838834764831845f : 1.0f;
        v4u dv[16];
#pragma unroll
        for (int i = 0; i < 16; ++i) dv[i] = *(const v4u*)(src + (size_t)(t0 + i) * 1024);
#pragma unroll
        for (int i = 0; i < 16; ++i) {
            const v4u d = dv[i]; float cur[8];
            cur[0] = bflo(d.x); cur[1] = bfhi(d.x); cur[2] = bflo(d.y); cur[3] = bfhi(d.y); cur[4] = bflo(d.z); cur[5] = bfhi(d.z); cur[6] = bflo(d.w); cur[7] = bfhi(d.w);
            float y[8];
#pragma unroll
            for (int e = 0; e < 8; ++e) { float v = bb[e] + w[0][e] * h0[e] + w[1][e] * h1[e] + w[2][e] * h2[e] + w[3][e] * cur[e]; v = v * pg8::sigmoidf_fast(v) * osc; y[e] = v; h0[e] = h1[e]; h1[e] = h2[e]; h2[e] = cur[e]; }
            v4u o; o.x = cvtpk(y[0], y[1]); o.y = cvtpk(y[2], y[3]); o.z = cvtpk(y[4], y[5]); o.w = cvtpk(y[6], y[7]);
            *(v4u*)(dst + (size_t)(t0 + i) * 1024) = o;
        }
    }
    if (cv < 16) {
        const int bh = cv, b = bh >> 3, h = bh & 7, tid = F.tid;
        const float* IFI = (const float*)(F.ws + WS_IF) + (size_t)b * SEQ * 16;
        float* FC = (float*)(F.ws + WS_FCUM) + (size_t)bh * SEQ; float* LI = (float*)(F.ws + WS_LIT) + (size_t)bh * SEQ;
        LAS float* sh = (LAS float*)(F.lds + RING_OFF);
        float lf[16]; float run = 0.f, lmax = -3.0e38f;
#pragma unroll
        for (int i = 0; i < 16; ++i) { const int t = tid * 16 + i; const float li = IFI[(size_t)t * 16 + h], fr = IFI[(size_t)t * 16 + 8 + h];
            const float ls = fminf(fr, 0.f) - log1pf(expf(-fabsf(fr))); run += ls; lf[i] = run; LI[t] = li; lmax = fmaxf(lmax, li); }
        float incl = run;
#pragma unroll
        for (int o = 1; o < 64; o <<= 1) { const float n = __shfl_up(incl, o); if (F.lane >= o) incl += n; }
        lmax = wave_max(lmax);
        if (F.lane == 63) sh[F.wave] = incl; if (F.lane == 0) sh[8 + F.wave] = lmax; __syncthreads();
        float base = incl - run, mx = sh[8];
#pragma unroll
        for (int w = 0; w < 8; ++w) { if (w < F.wave) base += sh[w]; mx = fmaxf(mx, sh[8 + w]); }
        if (tid == 0) ((float*)(F.ws + WS_LAM))[16 + bh] = mx;
#pragma unroll
        for (int i = 0; i < 16; ++i) FC[tid * 16 + i] = base + lf[i];
        __syncthreads();
    }
}

constexpr int SHM_V = 64 * 128 * 2, SHM_K = 64 * 128 * 2;
constexpr int FL_WS = 81920;
constexpr int FL_BTAB = FL_WS + 2048;
constexpr int FL_NTAB = FL_WS + 2048 + 512;
constexpr int FL_RED = FL_WS + 4096;
constexpr int FL_OT = FL_WS + 8192;
constexpr float ATT_MARGIN = 66.0f;
#define KSWZ(row, colB) ((row) * 256 + ((colB) ^ (((row) & 7) << 4)))
#define SBAR() __builtin_amdgcn_sched_barrier(0)
__device__ __forceinline__ int crow(int r, int hi) { return (r & 3) + 8 * (r >> 2) + 4 * hi; }
__device__ __forceinline__ int v_st(int k, int c) { const int kk = (k & ~0xC) | ((k & 4) << 1) | ((k & 8) >> 1); return ((kk >> 3) * 4 + (c >> 5)) * 512 + ((kk & 7) * 32 + (c & 31)) * 2; }
__device__ __forceinline__ int v_rd_base(int lane) { return ((lane & 3) << 3) | (((lane >> 2) & 3) << 6) | (((lane >> 4) & 1) << 5) | (((lane >> 5) & 1) << 8); }
constexpr int v_rd_off(int d0, int ks, int half) { return d0 * 512 + ks * 4096 + half * 2048; }
template <int OFF> __device__ __forceinline__ s16x4 tr_read(int vb) { s16x4 r; asm volatile("ds_read_b64_tr_b16 %0, %1 offset:%2" : "=&v"(r) : "v"(vb), "i"(OFF) : "memory"); return r; }
#define PKF(L, H) (bf16x8){L[0], L[1], L[2], L[3], H[0], H[1], H[2], H[3]}
template <int D0> __device__ __forceinline__ void pv_one(f32x16& od, int vb, bf16x8 pa0, bf16x8 pa1, bf16x8 pa2, bf16x8 pa3) {
    const s16x4 l0 = tr_read<v_rd_off(D0, 0, 0)>(vb), h0 = tr_read<v_rd_off(D0, 0, 1)>(vb), l1 = tr_read<v_rd_off(D0, 1, 0)>(vb), h1 = tr_read<v_rd_off(D0, 1, 1)>(vb);
    const s16x4 l2 = tr_read<v_rd_off(D0, 2, 0)>(vb), h2 = tr_read<v_rd_off(D0, 2, 1)>(vb), l3 = tr_read<v_rd_off(D0, 3, 0)>(vb), h3 = tr_read<v_rd_off(D0, 3, 1)>(vb);
    asm volatile("s_waitcnt lgkmcnt(0)" ::: "memory"); SBAR();
    od = __builtin_amdgcn_mfma_f32_32x32x16_bf16(pa0, PKF(l0, h0), od, 0, 0, 0);
    od = __builtin_amdgcn_mfma_f32_32x32x16_bf16(pa1, PKF(l1, h1), od, 0, 0, 0);
    od = __builtin_amdgcn_mfma_f32_32x32x16_bf16(pa2, PKF(l2, h2), od, 0, 0, 0);
    od = __builtin_amdgcn_mfma_f32_32x32x16_bf16(pa3, PKF(l3, h3), od, 0, 0, 0);
}
__device__ __forceinline__ void pv_d0(f32x16* o, int vb, bf16x8 pa0, bf16x8 pa1, bf16x8 pa2, bf16x8 pa3) {
    pv_one<0>(o[0], vb, pa0, pa1, pa2, pa3); pv_one<1>(o[1], vb, pa0, pa1, pa2, pa3); pv_one<2>(o[2], vb, pa0, pa1, pa2, pa3); pv_one<3>(o[3], vb, pa0, pa1, pa2, pa3);
}
__device__ __forceinline__ void pack_p(const f32x16& p0, const f32x16& p1, bf16x8& pa0, bf16x8& pa1, bf16x8& pa2, bf16x8& pa3) {
#define PK4(P, BASE, OUT) do { unsigned a0 = cvtpk(P[BASE + 0], P[BASE + 1]), a1 = cvtpk(P[BASE + 2], P[BASE + 3]);   \
    unsigned b0 = cvtpk(P[BASE + 4], P[BASE + 5]), b1 = cvtpk(P[BASE + 6], P[BASE + 7]);                              \
    auto r0 = __builtin_amdgcn_permlane32_swap(a0, b0, false, false); auto r1 = __builtin_amdgcn_permlane32_swap(a1, b1, false, false); \
    v4u w = {r0[0], r1[0], r0[1], r1[1]}; OUT = *reinterpret_cast<bf16x8*>(&w); } while (0)
    PK4(p0, 0, pa0); PK4(p0, 8, pa1); PK4(p1, 0, pa2); PK4(p1, 8, pa3);
#undef PK4
}
__device__ __forceinline__ float half_swap_sum(float v) { auto rr = __builtin_amdgcn_permlane32_swap(__float_as_uint(v), __float_as_uint(v), false, false); return __uint_as_float(rr[0]) + __uint_as_float(rr[1]); }
__device__ __forceinline__ float half_swap_max(float v) { auto rr = __builtin_amdgcn_permlane32_swap(__float_as_uint(v), __float_as_uint(v), false, false); return fmaxf(__uint_as_float(rr[0]), __uint_as_float(rr[1])); }
__device__ __forceinline__ float half_sum32(float v) { v += __shfl_xor(v, 1); v += __shfl_xor(v, 2); v += __shfl_xor(v, 4); v += __shfl_xor(v, 8); v += __shfl_xor(v, 16); return v; }

__device__ __forceinline__ void attn_unit(Frame& F, char* lds, int b, int h, int u, bf16* BA) {
    const int tid = F.tid, wid = F.wave, lane = F.lane, r32 = lane & 31, hi = lane >> 5, map = wid >> 2, wq = wid & 3;
    char* V_lds = lds; char* K_lds = lds + 2 * SHM_V;
    float* wsf = (float*)(lds + FL_WS) + wid * 64; float* li_l = wsf; float* al_l = wsf + 32;
    const size_t rowbase = (size_t)b * SEQ;
    const bf16* QA = (const bf16*)(F.ws + WS_QA); const bf16* KA = (const bf16*)(F.ws + WS_KA); const bf16* VA = (const bf16*)(F.ws + WS_VA);
    const bf16* Qw = QA + (rowbase + 128 * u + wq * 32 + r32) * 1024 + h * 128 + map * 64 + hi * 8;
    bf16x8 qr[4];
#pragma unroll
    for (int d0 = 0; d0 < 4; ++d0) qr[d0] = *reinterpret_cast<const bf16x8*>(Qw + d0 * 16);
    const bf16* Kh = KA + rowbase * 1024 + h * 128; const bf16* Vh = VA + rowbase * 1024 + h * 128;
    const int vb0 = (int)(uintptr_t)V_lds + v_rd_base(lane);
    const int NT = 2 * u + 2, qchunk = 2 * u + (wq >> 1), qrel = wq * 32 + r32;
    unsigned kvo[2], vvo[2];
#pragma unroll
    for (int i = 0; i < 2; ++i) { const int off = (wid * 2 + i) * 1024 + lane * 16;
        { const int r = off >> 8, chs = (off >> 4) & 15, ch = chs ^ (r & 7); kvo[i] = (unsigned)(r * 2048 + ch * 16); }
        { const int s = off >> 9, kk = (s >> 2) * 8 + ((lane & 31) >> 2), c = (s & 3) * 32 + (lane & 3) * 8, k = (kk & ~0xC) | ((kk & 4) << 1) | ((kk & 8) >> 1); vvo[i] = (unsigned)(k * 2048 + c * 2); } }
    const unsigned ldsK = (unsigned)__builtin_amdgcn_readfirstlane((int)((unsigned)(uintptr_t)K_lds + (unsigned)wid * 2048u)), ldsV = (unsigned)__builtin_amdgcn_readfirstlane((int)((unsigned)(uintptr_t)V_lds + (unsigned)wid * 2048u));
#define DMA16(voff, sbase, ldsdst, imm) asm volatile("s_add_u32 m0, %2, %3\n\ts_nop 0\n\tglobal_load_lds_dwordx4 %0, %1" : : "v"(voff), "s"(sbase), "s"(ldsdst), "i"(imm) : "memory", "scc")
#define DMAK(jj, slot) do { const char* sb_ = (const char*)(Kh + (size_t)(64 * (NT - 1 - (jj))) * 1024); const unsigned ld_ = ldsK + (unsigned)(slot) * (unsigned)SHM_K; DMA16(kvo[0], sb_, ld_, 0); DMA16(kvo[1], sb_, ld_, 1024); } while (0)
#define DMAV(jj, slot) do { const char* sb_ = (const char*)(Vh + (size_t)(64 * (NT - 1 - (jj))) * 1024); const unsigned ld_ = ldsV + (unsigned)(slot) * (unsigned)SHM_V; DMA16(vvo[0], sb_, ld_, 0); DMA16(vvo[1], sb_, ld_, 1024); } while (0)
    const float slope2 = __builtin_amdgcn_exp2f(-(float)(h + 1)) * LOG2E;
    float m_reg, l_reg = 0.f; f32x16 o[4] = {};
    float sbound;
    { float qn = 0.f;
#pragma unroll
      for (int d0 = 0; d0 < 4; ++d0) { const v4u qq = __builtin_bit_cast(v4u, qr[d0]);
#pragma unroll
          for (int c = 0; c < 4; ++c) { const float a = bflo(qq[c]), b2 = bfhi(qq[c]); qn += a * a + b2 * b2; } }
      qn = half_swap_sum(qn);
      const unsigned* km = (const unsigned*)(F.ctl + CW_KMAX) + b * 32 + 4 * h + 2 * map;
      const float kmax2 = __uint_as_float(km[0]) + __uint_as_float(km[1]);
      sbound = sqrtf(qn * kmax2) * 1.01f + 1.0f; }
    m_reg = slope2 * (float)qrel - sbound;
    int* jst = (int*)(lds + FL_NTAB); int jstop = 0;
#define SCORE(P0, P1, jj, slot) do { const int jt_ = NT - 1 - (jj); const int kb_ = 64 * jt_ - 128 * u + 4 * hi; \
        if (jt_ > qchunk) { _Pragma("unroll") for (int r = 0; r < 16; ++r) { P0[r] = -1e30f; P1[r] = -1e30f; } } \
        else { if (jt_ == qchunk) { _Pragma("unroll") for (int r = 0; r < 16; ++r) { const int k0_ = kb_ + (r & 3) + 8 * (r >> 2), k1_ = k0_ + 32; P0[r] = slope2 * (float)min(k0_, 2 * qrel - k0_) - m_reg; P1[r] = slope2 * (float)min(k1_, 2 * qrel - k1_) - m_reg; } } \
               else { const float bb0_ = slope2 * (float)kb_ - m_reg; _Pragma("unroll") for (int r = 0; r < 16; ++r) { P0[r] = fmaf(slope2, (float)((r & 3) + 8 * (r >> 2)), bb0_); P1[r] = P0[r] + 32.f * slope2; } } \
               const char* Ks_ = K_lds + (slot) * SHM_K; \
               _Pragma("unroll") for (int d0 = 0; d0 < 4; ++d0) { const int cb_ = (map * 64 + d0 * 16 + hi * 8) * 2; \
                   const bf16x8 b0_ = *reinterpret_cast<const bf16x8*>(Ks_ + KSWZ(r32, cb_)), b1_ = *reinterpret_cast<const bf16x8*>(Ks_ + KSWZ(32 + r32, cb_)); \
                   P0 = __builtin_amdgcn_mfma_f32_32x32x16_bf16(b0_, qr[d0], P0, 0, 0, 0); P1 = __builtin_amdgcn_mfma_f32_32x32x16_bf16(b1_, qr[d0], P1, 0, 0, 0); } } } while (0)
#define STEP(PC0, PC1, PN0, PN1, jj) do { \
        if ((jj) + 2 < NT) DMAK((jj) + 2, ((jj) + 2) % 3); \
        if ((jj) + 1 < NT) DMAV((jj) + 1, ((jj) + 1) & 1); \
        if ((jj) + 1 < NT) SCORE(PN0, PN1, (jj) + 1, ((jj) + 1) % 3); \
        float pmax = PC0[0]; \
        _Pragma("unroll") for (int r = 1; r < 16; ++r) pmax = fmaxf(pmax, PC0[r]); \
        _Pragma("unroll") for (int r = 0; r < 16; ++r) pmax = fmaxf(pmax, PC1[r]); \
        pmax = half_swap_max(pmax); \
        float alpha = 1.f; \
        if (!__all(pmax <= 8.0f)) { const float dl = fmaxf(pmax, 0.f); alpha = __builtin_amdgcn_exp2f(-dl); m_reg += dl; \
            _Pragma("unroll") for (int r = 0; r < 16; ++r) { PC0[r] -= dl; PC1[r] -= dl; } \
            if ((jj) + 1 < NT) { _Pragma("unroll") for (int r = 0; r < 16; ++r) { PN0[r] -= dl; PN1[r] -= dl; } } } \
        float ps = 0.f; \
        _Pragma("unroll") for (int r = 0; r < 16; ++r) { PC0[r] = __builtin_amdgcn_exp2f(PC0[r]); PC1[r] = __builtin_amdgcn_exp2f(PC1[r]); ps += PC0[r] + PC1[r]; } \
        ps = half_swap_sum(ps); \
        l_reg = l_reg * alpha + ps; \
        bf16x8 pa0, pa1, pa2, pa3; pack_p(PC0, PC1, pa0, pa1, pa2, pa3); \
        if (__any(alpha < 1.f)) { if (hi == 0) al_l[r32] = alpha; asm volatile("s_waitcnt lgkmcnt(0)" ::: "memory"); \
            _Pragma("unroll") for (int d = 0; d < 4; ++d) _Pragma("unroll") for (int r = 0; r < 16; ++r) o[d][r] *= al_l[crow(r, hi)]; } \
        SBAR(); \
        pv_d0(o, vb0 + ((jj) & 1) * SHM_V, pa0, pa1, pa2, pa3); \
        SBAR(); \
        if ((jj) == 1) { const float nf = (m_reg - ATT_MARGIN - sbound) / (64.f * slope2) + (float)(128 * u - 63) * (1.0f / 64.0f); int js = (int)ceilf(fmaxf(nf, 0.f)); \
            _Pragma("unroll") for (int o_ = 1; o_ < 64; o_ <<= 1) js = min(js, __shfl_xor(js, o_)); \
            if (lane == 0) jst[wid] = js; } \
        asm volatile("s_waitcnt vmcnt(0)" ::: "memory"); \
        __syncthreads(); } while (0)
    DMAK(0, 0); DMAV(0, 0); DMAK(1, 1);
    asm volatile("s_waitcnt vmcnt(0)" ::: "memory"); __syncthreads();
    f32x16 pA0, pA1, pB0, pB1;
    SCORE(pA0, pA1, 0, 0);
    for (int j = 0; j < NT; j += 2) {
        if (j == 2) { jstop = jst[0];
#pragma unroll
            for (int w = 1; w < 8; ++w) jstop = min(jstop, jst[w]); }
        if (NT - 1 - j < jstop) break;
        STEP(pA0, pA1, pB0, pB1, j);
        if (NT - 2 - j < jstop) break;
        STEP(pB0, pB1, pA0, pA1, j + 1);
    }
#undef DMAK
#undef DMAV
#undef DMA16
#undef SCORE
#undef STEP
    __syncthreads();
    if (hi == 0) li_l[r32] = l_reg; asm volatile("s_waitcnt lgkmcnt(0)" ::: "memory");
    float rli[16];
#pragma unroll
    for (int r = 0; r < 16; ++r) rli[r] = __builtin_amdgcn_rcpf(li_l[crow(r, hi)]);
    float* X = (float*)lds + wq * 4096;
    if (map == 1) {
#pragma unroll
        for (int r = 0; r < 16; ++r)
#pragma unroll
            for (int d0 = 0; d0 < 4; ++d0) X[crow(r, hi) * 128 + d0 * 32 + r32] = o[d0][r] * rli[r];
    }
    __syncthreads();
    if (map == 0) {
        const float lam = ((const float*)(F.ws + WS_LAM))[0]; const float* subln = F.in[7];
        float g[4];
#pragma unroll
        for (int d0 = 0; d0 < 4; ++d0) g[d0] = subln[d0 * 32 + r32] * 0.8f;
        bf16* OT = (bf16*)(lds + FL_OT);
#pragma unroll
        for (int r = 0; r < 16; ++r) { float dv[4]; float s = 0.f;
#pragma unroll
            for (int d0 = 0; d0 < 4; ++d0) { dv[d0] = o[d0][r] * rli[r] - lam * X[crow(r, hi) * 128 + d0 * 32 + r32]; s += dv[d0] * dv[d0]; }
            s = half_sum32(s); const float rs = 1.0f / sqrtf(s * (1.0f / 128.0f) + EPS);
#pragma unroll
            for (int d0 = 0; d0 < 4; ++d0) OT[(wq * 32 + crow(r, hi)) * 128 + d0 * 32 + r32] = (bf16)f2bf(dv[d0] * rs * g[d0]); }
    }
    __syncthreads();
#pragma unroll
    for (int i = 0; i < 4; ++i) { const int p = tid + 512 * i, row = p >> 4, ch = p & 15;
        *(v4u*)(BA + (rowbase + 128 * u + row) * 2048 + h * 128 + ch * 8) = *(const v4u*)(lds + FL_OT + row * 256 + ch * 16); }
}

__device__ __forceinline__ void mlstm_seg_task(Frame& F, char* lds, int bh, int seg) {
    const int tid = F.tid, wid = F.wave, lane = F.lane, b = bh >> 3, h = bh & 7;
    char* V_lds = lds; char* K_lds = lds + 2 * SHM_V;
    float* wtab = (float*)(lds + FL_RED);
    float* red = (float*)(lds + FL_WS);
    const size_t rowbase = (size_t)b * SEQ + (size_t)seg * SEGTOK;
    const float* FC = (const float*)(F.ws + WS_FCUM) + (size_t)bh * SEQ + seg * SEGTOK; const float* LI = (const float*)(F.ws + WS_LIT) + (size_t)bh * SEQ + seg * SEGTOK;
    const bf16* Kh = (const bf16*)((const unsigned char*)F.out + OUT_MKC) + rowbase * 1024 + h * 128; const bf16* Vh = (const bf16*)(F.ws + WS_MV) + rowbase * 1024 + h * 128;
    const float li0 = LI[tid], li1 = LI[512 + tid];
    float mx = wave_max(fmaxf(li0, li1)); if (lane == 0) red[wid] = mx; __syncthreads();
    float Lseg = red[0];
#pragma unroll
    for (int i = 1; i < 8; ++i) Lseg = fmaxf(Lseg, red[i]);
    const float FE = FC[SEGTOK - 1];
    wtab[tid] = __expf(FE - FC[tid] + li0 - Lseg); wtab[512 + tid] = __expf(FE - FC[512 + tid] + li1 - Lseg);
    __syncthreads();
    const int sr = tid >> 4, sc = (tid & 15) * 8, vst0 = v_st(sr, sc), vst1 = v_st(32 + sr, sc);
    const int vbV = (int)(uintptr_t)V_lds + v_rd_base(lane), vbK = (int)(uintptr_t)K_lds + v_rd_base(lane);
    v4u vs0, vs1, ks0, ks1; float npart[8];
#pragma unroll
    for (int e = 0; e < 8; ++e) npart[e] = 0.f;
#define SLOAD(k0) do { vs0 = *(const v4u*)(&Vh[(size_t)((k0) + sr) * 1024 + sc]); vs1 = *(const v4u*)(&Vh[(size_t)((k0) + 32 + sr) * 1024 + sc]); \
    ks0 = *(const v4u*)(&Kh[(size_t)((k0) + sr) * 1024 + sc]); ks1 = *(const v4u*)(&Kh[(size_t)((k0) + 32 + sr) * 1024 + sc]); } while (0)
#define KW(kv, wv, outv) do { float f0 = bflo(kv.x) * wv, f1 = bfhi(kv.x) * wv, f2 = bflo(kv.y) * wv, f3 = bfhi(kv.y) * wv, f4 = bflo(kv.z) * wv, f5 = bfhi(kv.z) * wv, f6 = bflo(kv.w) * wv, f7 = bfhi(kv.w) * wv; \
    npart[0] += f0; npart[1] += f1; npart[2] += f2; npart[3] += f3; npart[4] += f4; npart[5] += f5; npart[6] += f6; npart[7] += f7; \
    outv.x = cvtpk(f0, f1); outv.y = cvtpk(f2, f3); outv.z = cvtpk(f4, f5); outv.w = cvtpk(f6, f7); } while (0)
#define SWRITE(bb, k0) do { *(v4u*)(V_lds + (bb) * SHM_V + vst0) = vs0; *(v4u*)(V_lds + (bb) * SHM_V + vst1) = vs1; \
    const float w0_ = wtab[(k0) + sr], w1_ = wtab[(k0) + 32 + sr]; v4u q0_, q1_; KW(ks0, w0_, q0_); KW(ks1, w1_, q1_); \
    *(v4u*)(K_lds + (bb) * SHM_K + vst0) = q0_; *(v4u*)(K_lds + (bb) * SHM_K + vst1) = q1_; } while (0)
    f32x16 acc0 = {}, acc1 = {};
    const int db = wid >> 1, eb0 = 2 * (wid & 1);
    SLOAD(0); asm volatile("s_waitcnt vmcnt(0)" ::: "memory"); SWRITE(0, 0); SLOAD(64); __syncthreads();
    constexpr int NT = SEGTOK / 64;
    for (int j = 0; j < NT; ++j) {
        const int buf = j & 1; const int ka = vbK + buf * SHM_K + db * 512, va = vbV + buf * SHM_V + eb0 * 512;
        s16x4 al[4], ah[4], bl0[4], bh0[4], bl1[4], bh1[4];
#define RD4(KS) do { al[KS] = tr_read<v_rd_off(0, KS, 0)>(ka); ah[KS] = tr_read<v_rd_off(0, KS, 1)>(ka); bl0[KS] = tr_read<v_rd_off(0, KS, 0)>(va); bh0[KS] = tr_read<v_rd_off(0, KS, 1)>(va); \
    bl1[KS] = tr_read<v_rd_off(1, KS, 0)>(va); bh1[KS] = tr_read<v_rd_off(1, KS, 1)>(va); } while (0)
        RD4(0); RD4(1); RD4(2); RD4(3);
#undef RD4
        asm volatile("s_waitcnt lgkmcnt(0)" ::: "memory"); SBAR();
#pragma unroll
        for (int ks = 0; ks < 4; ++ks) { const bf16x8 a = PKF(al[ks], ah[ks]);
            acc0 = __builtin_amdgcn_mfma_f32_32x32x16_bf16(a, PKF(bl0[ks], bh0[ks]), acc0, 0, 0, 0);
            acc1 = __builtin_amdgcn_mfma_f32_32x32x16_bf16(a, PKF(bl1[ks], bh1[ks]), acc1, 0, 0, 0); }
        if (j + 1 < NT) { asm volatile("s_waitcnt vmcnt(0)" ::: "memory"); SWRITE(buf ^ 1, 64 * (j + 1)); if (j + 2 < NT) SLOAD(64 * (j + 2)); }
        __syncthreads();
    }
#undef SLOAD
#undef SWRITE
#undef KW
    float* CS = (float*)(F.ws + WS_CSEG) + (size_t)(bh * NSEG + seg) * CSEG_STRIDE;
    const int r32 = lane & 31, hi = lane >> 5;
#pragma unroll
    for (int r = 0; r < 16; ++r) { const int d = 32 * db + crow(r, hi); CS[d * 128 + 32 * eb0 + r32] = acc0[r]; CS[d * 128 + 32 * (eb0 + 1) + r32] = acc1[r]; }
    float* nred = (float*)lds;
#pragma unroll
    for (int e = 0; e < 8; ++e) nred[sr * 128 + sc + e] = npart[e];
    __syncthreads();
    if (tid < 128) { float s = 0.f; for (int i = 0; i < 32; ++i) s += nred[i * 128 + tid]; CS[128 * 128 + tid] = s; }
    if (tid == 0) CS[128 * 128 + 128] = Lseg;
    asm volatile("s_waitcnt vmcnt(0)" ::: "memory"); __syncthreads();
    if (tid == 0) { __builtin_amdgcn_fence(__ATOMIC_RELEASE, "agent"); asm volatile("s_waitcnt vmcnt(0)" ::: "memory");
        __hip_atomic_fetch_add((unsigned*)(F.ctl + CW_SEGCNT + 64 * bh), 1u, __ATOMIC_RELAXED, __HIP_MEMORY_SCOPE_AGENT); }
    __syncthreads();
}

__device__ __forceinline__ void mlstm_unit(Frame& F, char* lds, int bh, int sj, int qi, bf16* BB) {
    const int tid = F.tid, wid = F.wave, lane = F.lane, r32 = lane & 31, hi = lane >> 5, b = bh >> 3, h = bh & 7;
    char* V_lds = lds; char* K_lds = lds + 2 * SHM_V;
    float* wsf = (float*)(lds + FL_WS) + wid * 64; float* li_l = wsf; float* al_l = wsf + 32;
    float* btab = (float*)(lds + FL_BTAB); float* ntab = (float*)(lds + FL_NTAB);
    const size_t segrow = (size_t)b * SEQ + (size_t)sj * SEGTOK;
    const int tl0 = qi * 256;
    const float* FCb = (const float*)(F.ws + WS_FCUM) + (size_t)bh * SEQ; const float* LIb = (const float*)(F.ws + WS_LIT) + (size_t)bh * SEQ;
    const float L = ((const float*)(F.ws + WS_LAM))[16 + bh];
    const float Fref = sj > 0 ? FCb[sj * SEGTOK - 1] : 0.f;
    const bf16* MQC = (const bf16*)((const unsigned char*)F.out + OUT_MQC);
    const bf16* Kh = (const bf16*)((const unsigned char*)F.out + OUT_MKC) + segrow * 1024 + h * 128; const bf16* Vh = (const bf16*)(F.ws + WS_MV) + segrow * 1024 + h * 128;
    const int trow = tl0 + wid * 32 + r32;
    const bf16* Qw = MQC + (segrow + trow) * 1024 + h * 128 + hi * 8;
    bf16x8 qr[8];
#pragma unroll
    for (int d0 = 0; d0 < 8; ++d0) qr[d0] = *reinterpret_cast<const bf16x8*>(Qw + d0 * 16);
    const float At = (FCb[sj * SEGTOK + trow] - Fref) * LOG2E;
    const int sr = tid >> 4, sc = (tid & 15) * 8, vst0 = v_st(sr, sc), vst1 = v_st(32 + sr, sc);
    const int vb0 = (int)(uintptr_t)V_lds + v_rd_base(lane);
    float l_reg = 0.f; f32x16 o[4] = {};
    if (sj > 0) {
        if (tid == 0) { unsigned sp = 0; while (__hip_atomic_load((unsigned*)(F.ctl + CW_SEGCNT + 64 * bh), __ATOMIC_RELAXED, __HIP_MEMORY_SCOPE_AGENT) < (unsigned)NSEG) { __builtin_amdgcn_s_sleep(2); if (++sp > (1u << 22)) break; }
            __builtin_amdgcn_fence(__ATOMIC_ACQUIRE, "agent"); asm volatile("s_waitcnt vmcnt(0)" ::: "memory"); }
        __syncthreads();
        const float* CS = (const float*)(F.ws + WS_CSEG) + (size_t)(bh * NSEG) * CSEG_STRIDE;
        f32x4 ca[4][2]; float ns = 0.f;
#pragma unroll
        for (int q = 0; q < 4; ++q) { ca[q][0] = (f32x4){0.f, 0.f, 0.f, 0.f}; ca[q][1] = (f32x4){0.f, 0.f, 0.f, 0.f}; }
#pragma unroll 1
        for (int i = 0; i < sj; ++i) { const float* Ci = CS + (size_t)i * CSEG_STRIDE; const float cf = __expf(Fref - FCb[(i + 1) * SEGTOK - 1] + Ci[128 * 128 + 128] - L);
#pragma unroll
            for (int q = 0; q < 4; ++q) { const float* p = Ci + (q * 32 + sr) * 128 + sc; ca[q][0] += cf * *(const f32x4*)p; ca[q][1] += cf * *(const f32x4*)(p + 4); }
            if (tid < 128) ns += cf * Ci[128 * 128 + tid]; }
#pragma unroll
        for (int q = 0; q < 4; ++q) { v4u w; w.x = cvtpk(ca[q][0][0], ca[q][0][1]); w.y = cvtpk(ca[q][0][2], ca[q][0][3]); w.z = cvtpk(ca[q][1][0], ca[q][1][1]); w.w = cvtpk(ca[q][1][2], ca[q][1][3]);
            *(v4u*)(V_lds + (q >> 1) * SHM_V + ((q & 1) ? vst1 : vst0)) = w; }
        if (tid < 128) ntab[tid] = ns;
        __syncthreads();
        pv_d0(o, vb0, qr[0], qr[1], qr[2], qr[3]);
        pv_d0(o, vb0 + SHM_V, qr[4], qr[5], qr[6], qr[7]);
        float dn = 0.f;
#pragma unroll
        for (int d0 = 0; d0 < 8; ++d0) { const v4u qq = __builtin_bit_cast(v4u, qr[d0]); const float* nt = ntab + d0 * 16 + hi * 8;
            dn += bflo(qq.x) * nt[0] + bfhi(qq.x) * nt[1] + bflo(qq.y) * nt[2] + bfhi(qq.y) * nt[3] + bflo(qq.z) * nt[4] + bfhi(qq.z) * nt[5] + bflo(qq.w) * nt[6] + bfhi(qq.w) * nt[7]; }
        dn = half_swap_sum(dn);
        const float rsc = __builtin_amdgcn_exp2f(At);
        l_reg = rsc * dn;
        if (hi == 0) al_l[r32] = rsc; asm volatile("s_waitcnt lgkmcnt(0)" ::: "memory");
#pragma unroll
        for (int d = 0; d < 4; ++d)
#pragma unroll
            for (int r = 0; r < 16; ++r) o[d][r] *= al_l[crow(r, hi)];
        __syncthreads();
    }
    v4u vs0, vs1, ks0, ks1; float bt = 0.f;
#define SLOAD(k0) do { vs0 = *(const v4u*)(&Vh[(size_t)((k0) + sr) * 1024 + sc]); vs1 = *(const v4u*)(&Vh[(size_t)((k0) + 32 + sr) * 1024 + sc]); \
    ks0 = *(const v4u*)(&Kh[(size_t)((k0) + sr) * 1024 + sc]); ks1 = *(const v4u*)(&Kh[(size_t)((k0) + 32 + sr) * 1024 + sc]); \
    if (tid < 64) { const int s_ = sj * SEGTOK + (k0) + tid; bt = (LIb[s_] - L - (FCb[s_] - Fref)) * LOG2E; } } while (0)
#define SWRITE(bb) do { *(v4u*)(V_lds + (bb) * SHM_V + vst0) = vs0; *(v4u*)(V_lds + (bb) * SHM_V + vst1) = vs1; const int kc = sc * 2; \
    *(v4u*)(K_lds + (bb) * SHM_K + KSWZ(sr, kc)) = ks0; *(v4u*)(K_lds + (bb) * SHM_K + KSWZ(32 + sr, kc)) = ks1; if (tid < 64) btab[(bb) * 64 + tid] = bt; } while (0)
    const int NT = 4 * qi + 4, qc = 4 * qi + (wid >> 1), trel = (wid * 32 + r32) & 63;
    SLOAD(0); asm volatile("s_waitcnt vmcnt(0)" ::: "memory"); SWRITE(0); SLOAD(64); __syncthreads();
    for (int j = 0; j < NT; ++j) {
        const int buf = j & 1;
        if (j <= qc) {
            f32x16 p0 = {}, p1 = {};
            const char* Ks = K_lds + buf * SHM_K;
#pragma unroll
            for (int d0 = 0; d0 < 8; ++d0) { const int cb = (d0 * 16 + hi * 8) * 2;
                const bf16x8 b0 = *reinterpret_cast<const bf16x8*>(Ks + KSWZ(r32, cb)), b1 = *reinterpret_cast<const bf16x8*>(Ks + KSWZ(32 + r32, cb));
                p0 = __builtin_amdgcn_mfma_f32_32x32x16_bf16(b0, qr[d0], p0, 0, 0, 0); p1 = __builtin_amdgcn_mfma_f32_32x32x16_bf16(b1, qr[d0], p1, 0, 0, 0); if (d0 == 3) SBAR(); }
            const float* bp = btab + buf * 64 + 4 * hi; float ps = 0.f; const bool diag = (j == qc);
#pragma unroll
            for (int r = 0; r < 16; ++r) { const int kk = (r & 3) + 8 * (r >> 2);
                float w0 = __builtin_amdgcn_exp2f(At + bp[kk]), w1 = __builtin_amdgcn_exp2f(At + bp[kk + 32]);
                if (diag) { if (kk + 4 * hi > trel) w0 = 0.f; if (kk + 32 + 4 * hi > trel) w1 = 0.f; }
                p0[r] *= w0; p1[r] *= w1; ps += p0[r] + p1[r]; }
            l_reg += half_swap_sum(ps);
            bf16x8 pa0, pa1, pa2, pa3; pack_p(p0, p1, pa0, pa1, pa2, pa3);
            SBAR();
            pv_d0(o, vb0 + buf * SHM_V, pa0, pa1, pa2, pa3);
        }
        if (j + 1 < NT) { asm volatile("s_waitcnt vmcnt(0)" ::: "memory"); SWRITE(buf ^ 1); if (j + 2 < NT) SLOAD(64 * (j + 2)); }
        __syncthreads();
    }
#undef SLOAD
#undef SWRITE
    const float den = fmaxf(fabsf(l_reg), __expf(-L));
    if (hi == 0) li_l[r32] = den; asm volatile("s_waitcnt lgkmcnt(0)" ::: "memory");
    const float* hn = F.in[8] + h * 128;
    float g[4];
#pragma unroll
    for (int d0 = 0; d0 < 4; ++d0) g[d0] = hn[d0 * 32 + r32];
    bf16* OT = (bf16*)lds;
#pragma unroll
    for (int r = 0; r < 16; ++r) { const float rd = __builtin_amdgcn_rcpf(li_l[crow(r, hi)]); float hv[4]; float s = 0.f;
#pragma unroll
        for (int d0 = 0; d0 < 4; ++d0) { hv[d0] = o[d0][r] * rd; s += hv[d0] * hv[d0]; }
        s = half_sum32(s); const float rs = 1.0f / sqrtf(s * (1.0f / 128.0f) + EPS);
#pragma unroll
        for (int d0 = 0; d0 < 4; ++d0) OT[(wid * 32 + crow(r, hi)) * 128 + d0 * 32 + r32] = (bf16)f2bf(hv[d0] * rs * g[d0]); }
    __syncthreads();
    const bf16* MO = (const bf16*)(F.ws + WS_MO);
    v4u mq[8];
#pragma unroll
    for (int i = 0; i < 8; ++i) { const int p = tid + 512 * i, row = p >> 4, ch = p & 15; mq[i] = *(const v4u*)(MO + (segrow + tl0 + row) * 1024 + h * 128 + ch * 8); }
#pragma unroll
    for (int i = 0; i < 8; ++i) { const int p = tid + 512 * i, row = p >> 4, ch = p & 15; const size_t goff = (segrow + tl0 + row) * 1024 + h * 128 + ch * 8;
        const v4u a = *(const v4u*)(lds + row * 256 + ch * 16), m = mq[i]; v4u w;
        w.x = cvtpk(bflo(a.x) * bflo(m.x), bfhi(a.x) * bfhi(m.x)); w.y = cvtpk(bflo(a.y) * bflo(m.y), bfhi(a.y) * bfhi(m.y));
        w.z = cvtpk(bflo(a.z) * bflo(m.z), bfhi(a.z) * bfhi(m.z)); w.w = cvtpk(bflo(a.w) * bflo(m.w), bfhi(a.w) * bfhi(m.w));
        *(v4u*)(BB + goff + (segrow + tl0 + row) * 1024) = w; }
    __syncthreads();
}

__device__ __forceinline__ unsigned fkey(float f) { const unsigned u = __float_as_uint(f); return (u & 0x80000000u) ? ~u : (u | 0x80000000u); }
__device__ __forceinline__ float funkey(unsigned k) { const unsigned u = (k & 0x80000000u) ? (k & 0x7fffffffu) : ~k; return __uint_as_float(u); }
#define CE(a, b) do { const unsigned h_ = max(a, b), l_ = min(a, b); a = h_; b = l_; } while (0)
#define SORT16(X) do { CE(X[0], X[1]); CE(X[2], X[3]); CE(X[0], X[2]); CE(X[1], X[3]); CE(X[1], X[2]); CE(X[4], X[5]); CE(X[6], X[7]); CE(X[4], X[6]); CE(X[5], X[7]); CE(X[5], X[6]); CE(X[0], X[4]); CE(X[2], X[6]); CE(X[2], X[4]); CE(X[1], X[5]); CE(X[3], X[7]); CE(X[3], X[5]); CE(X[1], X[2]); CE(X[3], X[4]); CE(X[5], X[6]); CE(X[8], X[9]); CE(X[10], X[11]); CE(X[8], X[10]); CE(X[9], X[11]); CE(X[9], X[10]); CE(X[12], X[13]); CE(X[14], X[15]); CE(X[12], X[14]); CE(X[13], X[15]); CE(X[13], X[14]); CE(X[8], X[12]); CE(X[10], X[14]); CE(X[10], X[12]); CE(X[9], X[13]); CE(X[11], X[15]); CE(X[11], X[13]); CE(X[9], X[10]); CE(X[11], X[12]); CE(X[13], X[14]); CE(X[0], X[8]); CE(X[4], X[12]); CE(X[4], X[8]); CE(X[2], X[10]); CE(X[6], X[14]); CE(X[6], X[10]); CE(X[2], X[4]); CE(X[6], X[8]); CE(X[10], X[12]); CE(X[1], X[9]); CE(X[5], X[13]); CE(X[5], X[9]); CE(X[3], X[11]); CE(X[7], X[15]); CE(X[7], X[11]); CE(X[3], X[5]); CE(X[7], X[9]); CE(X[11], X[13]); CE(X[1], X[2]); CE(X[3], X[4]); CE(X[5], X[6]); CE(X[7], X[8]); CE(X[9], X[10]); CE(X[11], X[12]); CE(X[13], X[14]); } while (0)
#define MERGE16(L, N) do { L[0] = max(L[0], N[15]); L[1] = max(L[1], N[14]); L[2] = max(L[2], N[13]); L[3] = max(L[3], N[12]); L[4] = max(L[4], N[11]); L[5] = max(L[5], N[10]); L[6] = max(L[6], N[9]); L[7] = max(L[7], N[8]); L[8] = max(L[8], N[7]); L[9] = max(L[9], N[6]); L[10] = max(L[10], N[5]); L[11] = max(L[11], N[4]); L[12] = max(L[12], N[3]); L[13] = max(L[13], N[2]); L[14] = max(L[14], N[1]); L[15] = max(L[15], N[0]); CE(L[0], L[8]); CE(L[1], L[9]); CE(L[2], L[10]); CE(L[3], L[11]); CE(L[4], L[12]); CE(L[5], L[13]); CE(L[6], L[14]); CE(L[7], L[15]); CE(L[0], L[4]); CE(L[1], L[5]); CE(L[2], L[6]); CE(L[3], L[7]); CE(L[8], L[12]); CE(L[9], L[13]); CE(L[10], L[14]); CE(L[11], L[15]); CE(L[0], L[2]); CE(L[1], L[3]); CE(L[4], L[6]); CE(L[5], L[7]); CE(L[8], L[10]); CE(L[9], L[11]); CE(L[12], L[14]); CE(L[13], L[15]); CE(L[0], L[1]); CE(L[2], L[3]); CE(L[4], L[5]); CE(L[6], L[7]); CE(L[8], L[9]); CE(L[10], L[11]); CE(L[12], L[13]); CE(L[14], L[15]); } while (0)
#define TK_MERGE(L) do { unsigned N[16]; _Pragma("unroll") for (int j_ = 0; j_ < 16; ++j_) { auto rr_ = __builtin_amdgcn_permlane32_swap(L[j_], L[j_], false, false); L[j_] = rr_[0]; N[j_] = rr_[1]; } MERGE16(L, N); } while (0)
typedef __bf16 bf16x2_t __attribute__((ext_vector_type(2)));
__device__ __forceinline__ float dot2bf(unsigned a, unsigned b, float c) { return __builtin_amdgcn_fdot2_f32_bf16(__builtin_bit_cast(bf16x2_t, a), __builtin_bit_cast(bf16x2_t, b), c, false); }

__device__ __forceinline__ void route_unit(Frame& F, char* lds, int t0, int hh) {
    const int lane = F.lane, r32 = lane & 31, hi = lane >> 5, wid = F.wave;
    const bf16* QP = (const bf16*)(F.ws + WS_QP); const bf16* SK = (const bf16*)(F.ws + WS_SK);
    int* IDX = (int*)(F.ws + WS_IDX); float* GATE = (float*)(F.ws + WS_GATE);
    float fa[16], fb[16];
    int* tab = (int*)(lds) + (wid * 64 + lane) * 33;
#pragma unroll
    for (int c = 0; c < 2; ++c) {
        unsigned L[16];
#pragma unroll
        for (int j = 0; j < 16; ++j) L[j] = 0u;
        const bf16* qrow = QP + (size_t)(t0 + r32) * 2048 + hh * 256 + c * 128 + hi * 8;
        bf16x8 qf[8];
#pragma unroll
        for (int ks = 0; ks < 8; ++ks) qf[ks] = *reinterpret_cast<const bf16x8*>(qrow + ks * 16);
        const bf16* skb = SK + (size_t)((hh * 2 + c) * 128 + r32) * 128 + hi * 8;
        const unsigned nbase = 127u - 4u * (unsigned)hi;
        bf16x8 an[8];
        { const bf16* sp = skb; asm volatile("" : "+v"(sp));
#pragma unroll
          for (int ks = 0; ks < 8; ++ks) an[ks] = *reinterpret_cast<const bf16x8*>(sp + ks * 16); }
#pragma unroll
        for (int nb = 0; nb < 4; ++nb) { f32x16 acc = {};
#pragma unroll
            for (int ks = 0; ks < 8; ++ks) acc = __builtin_amdgcn_mfma_f32_32x32x16_bf16(an[ks], qf[ks], acc, 0, 0, 0);
            if (nb < 3) { const bf16* sp = skb + (size_t)(nb + 1) * 32 * 128; asm volatile("" : "+v"(sp));
#pragma unroll
                for (int ks = 0; ks < 8; ++ks) an[ks] = *reinterpret_cast<const bf16x8*>(sp + ks * 16); }
            { unsigned X[16];
#pragma unroll
              for (int r = 0; r < 16; ++r) X[r] = (fkey(acc[r]) & ~127u) | (nbase - (unsigned)(32 * nb + (r & 3) + 8 * (r >> 2)));
              SORT16(X); if (nb == 0) {
#pragma unroll
                  for (int r = 0; r < 16; ++r) L[r] = X[r]; } else { unsigned* N = X; MERGE16(L, N); } }
            SBAR(); }
        TK_MERGE(L);
#pragma unroll
        for (int j = 0; j < 16; ++j) { const float f = funkey(L[j] & ~127u); if (c == 0) fa[j] = f; else fb[j] = f; tab[16 * c + j] = 127 - (int)(L[j] & 127u); }
        SBAR();
    }
    unsigned C[16];
    {
        unsigned K2[16]; float pa_ = 0.f, pb_ = 0.f; int pf_ = 0; int cnt = 0;
#pragma unroll
        for (int j = 0; j < 16; ++j) K2[j] = 0u;
#pragma unroll
        for (int i = 0; i < 16; ++i)
#pragma unroll
            for (int j = 0; j < 16; ++j) if ((i + 1) * (j + 1) <= 16) {
                if ((cnt & 1) == 0) { pa_ = fa[i]; pb_ = fb[j]; pf_ = i * 16 + j; }
                else { const float s = hi ? fa[i] + fb[j] : pa_ + pb_; const int fl = hi ? i * 16 + j : pf_; const unsigned key = (fkey(s) & ~255u) | (unsigned)(255 - fl); const int q = cnt >> 1; if (q < 16) C[q] = key; else K2[q - 16] = key; }
                ++cnt; }
        { unsigned* X = C; SORT16(X); } { unsigned* X = K2; SORT16(X); }
        { unsigned* L = C; unsigned* N = K2; MERGE16(L, N); }
    }
    { unsigned* L = C; TK_MERGE(L); }
    asm volatile("s_waitcnt lgkmcnt(0)" ::: "memory");
    const float vmax = funkey(C[0] & ~255u); float ev[16]; float es = 0.f;
#pragma unroll
    for (int k = 0; k < 16; ++k) { ev[k] = __expf(funkey(C[k] & ~255u) - vmax); es += ev[k]; }
    const float ri = 1.0f / es;
    const size_t ob = (size_t)(t0 + r32) * 128 + hh * 16;
    int* dstp = hi ? (int*)GATE + ob : IDX + ob; int w[16];
#pragma unroll
    for (int k = 0; k < 16; ++k) { const int fl = 255 - (int)(C[k] & 255u); const int e = tab[fl >> 4] * 128 + tab[16 + (fl & 15)]; w[k] = hi ? (int)__float_as_uint(ev[k] * ri) : e; }
#pragma unroll
    for (int q = 0; q < 4; ++q) { typedef int i32x4 __attribute__((ext_vector_type(4))); *(i32x4*)(dstp + 4 * q) = (i32x4){w[4 * q], w[4 * q + 1], w[4 * q + 2], w[4 * q + 3]}; }
    asm volatile("s_waitcnt lgkmcnt(0)" ::: "memory");
}

__device__ __forceinline__ float gelu_tanh(float x) { const float z = 0.7978845608028654f * (x + 0.044715f * x * x * x); return x * __builtin_amdgcn_rcpf(1.0f + __builtin_amdgcn_exp2f(-2.0f * LOG2E * z)); }
constexpr float USCALE = 64.0f, VSCALE = 2.7f;
constexpr int ROW6 = DM * 6 / 8;
typedef __bf16 bf16x32_t __attribute__((ext_vector_type(32)));
typedef unsigned u32x6 __attribute__((ext_vector_type(6)));
typedef unsigned u32x3 __attribute__((ext_vector_type(3)));
typedef unsigned u32x16 __attribute__((ext_vector_type(16)));
__device__ __forceinline__ u32x16 fp6row6(unsigned a, unsigned b, unsigned c, unsigned d, unsigned e, unsigned f) { const u32x6 p = {a, b, c, d, e, f}; return __builtin_bit_cast(u32x16, __builtin_amdgcn_cvt_scalef32_pk32_bf16_fp6(p, 1.0f)); }
__device__ __forceinline__ u32x16 fp6row_to_bf16(u32x3 a, u32x3 b) { const u32x6 p = {a[0], a[1], a[2], b[0], b[1], b[2]}; return __builtin_bit_cast(u32x16, __builtin_amdgcn_cvt_scalef32_pk32_bf16_fp6(p, 1.0f)); }
typedef int i32x8 __attribute__((ext_vector_type(8)));
constexpr int P4_ROW = 128;
constexpr size_t SLICE_TAB4 = (size_t)NEXP * P4_ROW;
constexpr int PW_BYTES = 16384, PM_OFF = 12288, PRING = 12;
constexpr int ACT_STRIDE = 144;
constexpr float XS8 = 16.0f;
#ifndef FP4_SPLIT
#define FP4_SPLIT 0
#endif
#define PDMA(voff, sbase, ldsdst, imm) asm volatile("s_add_u32 m0, %2, %3\n\ts_nop 0\n\tglobal_load_lds_dwordx4 %0, %1" : : "v"(voff), "s"(sbase), "s"(ldsdst), "i"(imm) : "memory", "scc")
#define PWAIT(n) asm volatile("s_waitcnt vmcnt(" #n ")" ::: "memory")
#define PEER_SETUP() \
    const int lane = F.lane, m = lane & 15, g = lane >> 4; \
    const int members_ = F.G / 8, sl = F.vcu / members_, mem_ = F.vcu % members_, tstep = members_ * NWAVES, t0 = mem_ * NWAVES + F.wave, NTOK = (T - t0 + tstep - 1) / tstep, tl = t0 + (NTOK - 1) * tstep; \
    LAS unsigned char* W = F.lds + F.wave * PW_BYTES; \
    const unsigned ldsW = (unsigned)__builtin_amdgcn_readfirstlane((int)(unsigned)(uintptr_t)W); \
    const unsigned char* wsb = F.ws;
#define TOKC(nn) min(t0 + (nn) * tstep, tl)
#define META(tt, mb) do { const unsigned vo_ = mbase + (unsigned)(tt) * mstride; const unsigned ld_ = (unsigned)__builtin_amdgcn_readfirstlane((int)(ldsW + (unsigned)(PM_OFF + 1024 * (mb)))); PDMA(vo_, wsb, ld_, 0); } while (0)

__device__ __forceinline__ void peer_udots(Frame& F) {
    PEER_SETUP()
    bf16* PART = (bf16*)(F.ws + WS_PART);
    const unsigned char* tabs = F.ws + WS_UB + (size_t)sl * SLICE_TAB4;
    const unsigned r8 = lane >> 3, p8 = lane & 7;
    const unsigned co0 = 16u * (p8 ^ ((r8 >> 1) & 7)), co1 = 16u * (p8 ^ (((r8 + 8) >> 1) & 7));
    unsigned mbase, mstride;
    if (lane < 16) { mbase = (unsigned)WS_X8 + 256u * sl + 16u * lane; mstride = (unsigned)DM; } else { mbase = (unsigned)WS_IDX + 16u * (lane < 48 ? lane - 16 : 0); mstride = 512u; }
#define UDMA(mb, ui, su) do { const LAS unsigned char* ip_ = W + PM_OFF + 1024 * (mb) + 256 + 64 * (ui) + 4 * r8; const unsigned e0_ = *(const LAS unsigned*)ip_, e1_ = *(const LAS unsigned*)(ip_ + 32); \
        const unsigned ld_ = (unsigned)__builtin_amdgcn_readfirstlane((int)(ldsW + 2048u * (unsigned)(su))); \
        const unsigned v0_ = e0_ * (unsigned)P4_ROW + co0, v1_ = e1_ * (unsigned)P4_ROW + co1; PDMA(v0_, tabs, ld_, 0); PDMA(v1_, tabs, ld_, 1024); } while (0)
    META(TOKC(0), 0); META(TOKC(1), 1); PWAIT(0);
    int si = 0;
#pragma unroll
    for (int r = 0; r < 5; ++r) { UDMA(0, r, si); ++si; }
    int mb0 = 0, mb1 = 1, mb2 = 2, sc = 0;
#pragma unroll 1
    for (int n = 0; n < NTOK; ++n) {
        const int t = t0 + n * tstep;
        i32x8 xb[2]; f32x4 acc[8];
#pragma unroll
        for (int r = 0; r < 8; ++r) {
            if (r == 4) META(TOKC(n + 2), mb2);
            if (r < 3) UDMA(mb0, r + 5, si); else UDMA(mb1, r - 3, si);
            si = si == 5 ? 0 : si + 1;
            if (r >= 4) PWAIT(11); else PWAIT(10);
            if (r == 0) {
#pragma unroll
                for (int h = 0; h < 2; ++h) { const LAS unsigned char* xp_ = W + PM_OFF + 1024 * mb0 + 128 * h + (FP4_SPLIT ? 32 * g : 16 * g); const v4u a0 = *(const LAS v4u*)xp_, a1 = *(const LAS v4u*)(xp_ + (FP4_SPLIT ? 16 : 64));
                    xb[h] = (i32x8){(int)a0[0], (int)a0[1], (int)a0[2], (int)a0[3], (int)a1[0], (int)a1[1], (int)a1[2], (int)a1[3]}; } }
            f32x4 c = {0.f, 0.f, 0.f, 0.f};
#pragma unroll
            for (int h = 0; h < 2; ++h) { const v4u a0 = *(const LAS v4u*)(W + 2048 * sc + m * P4_ROW + 16 * ((4 * h + g) ^ ((m >> 1) & 7)));
                const i32x8 a = {(int)a0[0], (int)a0[1], (int)a0[2], (int)a0[3], 0, 0, 0, 0};
                c = __builtin_amdgcn_mfma_scale_f32_16x16x128_f8f6f4(a, xb[h], c, 4, 0, 0, 127, 0, 127); }
            acc[r] = c;
            sc = sc == 5 ? 0 : sc + 1;
        }
        f32x4 v = acc[0];
#pragma unroll
        for (int b = 1; b < 8; ++b) { const bool s_ = (m & 7) == b; v[0] = s_ ? acc[b][0] : v[0]; v[1] = s_ ? acc[b][1] : v[1]; v[2] = s_ ? acc[b][2] : v[2]; v[3] = s_ ? acc[b][3] : v[3]; }
        asm volatile("" : "+v"(v[0]), "+v"(v[1]), "+v"(v[2]), "+v"(v[3]));
        if (m < 8) *(u32x2*)(PART + ((size_t)sl * T + t) * 128 + 16 * m + 4 * g) = (u32x2){cvtpk(v[0], v[1]), cvtpk(v[2], v[3])};
        { const int o_ = mb0; mb0 = mb1; mb1 = mb2; mb2 = o_; }
    }
    PWAIT(0);
#undef UDMA
}
__device__ __forceinline__ void peer_act(Frame& F) {
    const int gw = F.vcu * NWAVES + F.wave, NGW = F.G * NWAVES, lane = F.lane;
    const unsigned* PART2 = (const unsigned*)(F.ws + WS_PART); const float* GATEA = (const float*)(F.ws + WS_GATE); unsigned char* ACT8 = (unsigned char*)(F.ws + WS_ACT);
    const int* IDXA = (const int*)(F.ws + WS_IDX); const float* SCU = (const float*)(F.ws + WS_SCU); const float* SCV = (const float*)(F.ws + WS_SCV); const float* SSQ = (const float*)(F.ws + WS_SSQ);
    for (int t = gw; t < T; t += NGW) {
        unsigned pw[8];
#pragma unroll
        for (int j = 0; j < 8; ++j) pw[j] = PART2[((size_t)j * T + t) * 64 + lane];
        const u32x2 ev = *(const u32x2*)(IDXA + (size_t)t * 128 + 2 * lane); const u32x2 gv = *(const u32x2*)(GATEA + (size_t)t * 128 + 2 * lane);
        float a0 = 0.f, a1 = 0.f;
#pragma unroll
        for (int j = 0; j < 8; ++j) { a0 += bflo(pw[j]); a1 += bfhi(pw[j]); }
        const float su0 = SCU[ev[0]], su1 = SCU[ev[1]], sv0 = SCV[ev[0]], sv1 = SCV[ev[1]];
        float v[2]; v[0] = gelu_tanh(a0 * su0 * (1.0f / XS8)) * __uint_as_float(gv[0]) * sv0; v[1] = gelu_tanh(a1 * su1 * (1.0f / XS8)) * __uint_as_float(gv[1]) * sv1;
        float am = fmaxf(fabsf(v[0]), fabsf(v[1]));
#pragma unroll
        for (int o = 1; o < 64; o <<= 1) am = fmaxf(am, __shfl_xor(am, o));
        const float ts = am > 0.f ? 224.0f / am : 1.0f;
#pragma unroll
        for (int hk = 0; hk < 2; ++hk) { const int k = 2 * lane + hk, r = k & 7, j = k >> 3, gg = r & 3, ga = 2 * (gg & 1) + (r >> 2), half = gg >> 1;
            const int p = __builtin_amdgcn_cvt_pk_fp8_f32(v[hk] * ts, 0.f, 0, false);
            ACT8[(size_t)t * ACT_STRIDE + 32 * ga + 2 * j + half] = (unsigned char)(p & 255); }
        if (lane == 0) *(float*)(ACT8 + (size_t)t * ACT_STRIDE + 128) = 1.0f / ts;
    }
}
__device__ __forceinline__ void peer_vacc(Frame& F) {
    PEER_SETUP()
    bf16* Y = (bf16*)(F.ws + WS_Y);
    const unsigned char* tabs = F.ws + WS_VB6 + (size_t)sl * SLICE_TAB4;
    const unsigned r8 = lane >> 3, co = 16u * (lane & 7);
    unsigned mbase, mstride;
    if (lane < 9) { mbase = (unsigned)WS_ACT + 16u * lane; mstride = (unsigned)ACT_STRIDE; } else { mbase = (unsigned)WS_IDX + 16u * ((lane >= 16 && lane < 48) ? lane - 16 : 0); mstride = 512u; }
    const int sh = 8 * (m & 3), mq = m >> 2;
#define VDMA(mb, ui, su) do { const unsigned e_ = *(const LAS unsigned*)(W + PM_OFF + 1024 * (mb) + 256 + 32 * (ui) + 4 * r8); \
        const unsigned ld_ = (unsigned)__builtin_amdgcn_readfirstlane((int)(ldsW + 1024u * (unsigned)(su))); const unsigned v_ = e_ * (unsigned)P4_ROW + co; PDMA(v_, tabs, ld_, 0); } while (0)
    META(TOKC(0), 0); META(TOKC(1), 1); PWAIT(0);
    int si = 0;
#pragma unroll
    for (int r = 0; r < 11; ++r) { VDMA(0, r, si); ++si; }
    int mb0 = 0, mb1 = 1, mb2 = 2, sc = 0;
#pragma unroll 1
    for (int n = 0; n < NTOK; ++n) {
        const int t = t0 + n * tstep;
        f32x4 d = {0.f, 0.f, 0.f, 0.f};
#pragma unroll
        for (int r = 0; r < 16; ++r) {
            if (r == 4) META(TOKC(n + 2), mb2);
            if (r < 5) VDMA(mb0, r + 11, si); else VDMA(mb1, r - 5, si);
            si = si == PRING - 1 ? 0 : si + 1;
            if (r >= 4 && r <= 14) PWAIT(12); else PWAIT(11);
            const LAS unsigned char* r0 = W + 1024 * sc + (FP4_SPLIT ? 2 * g : g) * P4_ROW + 8 * m;
            const u32x2 b0 = *(const LAS u32x2*)r0, b1 = *(const LAS u32x2*)(r0 + (FP4_SPLIT ? 1 : 4) * P4_ROW);
            const i32x8 b = {(int)b0[0], (int)b0[1], (int)b1[0], (int)b1[1], 0, 0, 0, 0};
            const unsigned pair = *(const LAS unsigned short*)(W + PM_OFF + 1024 * mb0 + 32 * g + 2 * r);
            const int lo = (int)((pair & 255u) << sh), hi = (int)((pair >> 8) << sh);
            const i32x8 a = {mq == 0 ? lo : 0, mq == 1 ? lo : 0, mq == 2 ? lo : 0, mq == 3 ? lo : 0, mq == 0 ? hi : 0, mq == 1 ? hi : 0, mq == 2 ? hi : 0, mq == 3 ? hi : 0};
            d = __builtin_amdgcn_mfma_scale_f32_16x16x128_f8f6f4(a, b, d, 0, 4, 0, 127, 0, 127);
            sc = sc == PRING - 1 ? 0 : sc + 1;
        }
        const float inv = *(const LAS float*)(W + PM_OFF + 1024 * mb0 + 128);
        *(u32x2*)(Y + (size_t)t * DM + 256 * sl + 16 * m + 4 * g) = (u32x2){cvtpk(d[0] * inv, d[1] * inv), cvtpk(d[2] * inv, d[3] * inv)};
        { const int o_ = mb0; mb0 = mb1; mb1 = mb2; mb2 = o_; }
    }
    PWAIT(0);
#undef VDMA
}
#undef META
#undef TOKC
#undef PEER_SETUP

__device__ __forceinline__ void peer_final(Frame& F) {
    const int gw = F.vcu * NWAVES + F.wave, NGW = F.G * NWAVES, lane = F.lane;
    const bf16* Y = (const bf16*)(F.ws + WS_Y); const bf16* X1B = (const bf16*)(F.ws + WS_X1B); const float* norm_final = F.in[17];
    f32x4 gv[8];
#pragma unroll
    for (int q = 0; q < 4; ++q) { gv[2 * q] = *(const f32x4*)(norm_final + 8 * lane + 512 * q); gv[2 * q + 1] = *(const f32x4*)(norm_final + 8 * lane + 512 * q + 4); }
    for (int t = gw; t < T; t += NGW) {
        v4u xa[4], ya[4]; f32x4 v[8]; float ss = 0.f;
#pragma unroll
        for (int q = 0; q < 4; ++q) { xa[q] = *(const v4u*)(X1B + (size_t)t * DM + 8 * lane + 512 * q); ya[q] = *(const v4u*)(Y + (size_t)t * DM + 8 * lane + 512 * q); }
#pragma unroll
        for (int q = 0; q < 4; ++q) {
            v[2 * q] = (f32x4){bflo(xa[q][0]) + bflo(ya[q][0]), bfhi(xa[q][0]) + bfhi(ya[q][0]), bflo(xa[q][1]) + bflo(ya[q][1]), bfhi(xa[q][1]) + bfhi(ya[q][1])};
            v[2 * q + 1] = (f32x4){bflo(xa[q][2]) + bflo(ya[q][2]), bfhi(xa[q][2]) + bfhi(ya[q][2]), bflo(xa[q][3]) + bflo(ya[q][3]), bfhi(xa[q][3]) + bfhi(ya[q][3])}; }
#pragma unroll
        for (int q = 0; q < 8; ++q) ss += (v[q][0] * v[q][0] + v[q][1] * v[q][1]) + (v[q][2] * v[q][2] + v[q][3] * v[q][3]);
        ss = wave_sum(ss);
        const float rf = 1.0f / sqrtf(ss * (1.0f / DM) + EPS);
        float* orow = F.out + (size_t)t * DM + 8 * lane;
#pragma unroll
        for (int q = 0; q < 4; ++q) { *(f32x4*)(orow + 512 * q) = v[2 * q] * rf * gv[2 * q]; *(f32x4*)(orow + 512 * q + 4) = v[2 * q + 1] * rf * gv[2 * q + 1]; }
    }
}

__device__ __forceinline__ unsigned e2m1_code(float x) {
    const float a = fabsf(x); const unsigned c = (unsigned)(a >= 0.25f) + (unsigned)(a >= 0.75f) + (unsigned)(a >= 1.25f) + (unsigned)(a >= 1.75f) + (unsigned)(a >= 2.5f) + (unsigned)(a >= 3.5f) + (unsigned)(a >= 5.0f);
    return c | (x < 0.f ? 8u : 0u); }
__device__ __forceinline__ void p5_expert_cvt(Frame& F) {
    const int gw = F.vcu * NWAVES + F.wave, NGW = F.G * NWAVES, lane = F.lane;
    const float* eu = F.in[15]; const float* ev = F.in[16]; const float* g = F.in[12];
    unsigned char* UB = (unsigned char*)(F.ws + WS_UB); unsigned char* VB = (unsigned char*)(F.ws + WS_VB6); float* SCU = (float*)(F.ws + WS_SCU); float* SCV = (float*)(F.ws + WS_SCV);
    LAS float* row = (LAS float*)(F.lds + RING_OFF + F.wave * 8192);
    f32x4 gv[8];
#pragma unroll
    for (int j = 0; j < 8; ++j) gv[j] = *(const f32x4*)(g + 4 * lane + 256 * j);
    for (int r = gw; r < 2 * NEXP; r += NGW) {
        const bool isv = r >= NEXP; const int e = isv ? r - NEXP : r;
        const GAS f32x4* src = (const GAS f32x4*)((isv ? ev : eu) + (size_t)e * DM) + lane;
        f32x4 v[8]; float ss = 0.f;
#pragma unroll
        for (int j = 0; j < 8; ++j) v[j] = src[64 * j];
#pragma unroll
        for (int j = 0; j < 8; ++j) { if (!isv) v[j] = v[j] * gv[j]; ss += (v[j][0] * v[j][0] + v[j][1] * v[j][1]) + (v[j][2] * v[j][2] + v[j][3] * v[j][3]); }
        ss = wave_sum(ss);
        const float sc = 0.5f * sqrtf(ss * (1.0f / DM)) + 1e-30f, isc = 1.0f / sc;
        if (lane == 0) (isv ? SCV : SCU)[e] = sc;
#pragma unroll
        for (int j = 0; j < 8; ++j) *(LAS f32x4*)(row + 4 * (lane + 64 * j)) = v[j] * isc;
        LDS_WAIT(); asm volatile("" ::: "memory");
        v4u w;
#pragma unroll
        for (int q = 0; q < 4; ++q) { const f32x4 a = *(const LAS f32x4*)(row + 32 * lane + 8 * q), b = *(const LAS f32x4*)(row + 32 * lane + 8 * q + 4);
            w[q] = e2m1_code(a[0]) | (e2m1_code(a[1]) << 4) | (e2m1_code(a[2]) << 8) | (e2m1_code(a[3]) << 12) | (e2m1_code(b[0]) << 16) | (e2m1_code(b[1]) << 20) | (e2m1_code(b[2]) << 24) | (e2m1_code(b[3]) << 28); }
        LDS_WAIT(); asm volatile("" ::: "memory");
        *(v4u*)((isv ? VB : UB) + (size_t)(lane >> 3) * SLICE_TAB4 + (size_t)e * P4_ROW + 16 * (lane & 7)) = w;
    }
}

__device__ __forceinline__ void p7_xquant(Frame& F) {
    const int gw = F.vcu * NWAVES + F.wave, NGW = F.G * NWAVES, lane = F.lane;
    const float* SSQ = (const float*)(F.ws + WS_SSQ); const bf16* X1B = (const bf16*)(F.ws + WS_X1B); unsigned char* X8 = (unsigned char*)(F.ws + WS_X8);
    for (int t = gw; t < T; t += NGW) {
        float ss = lane < 32 ? SSQ[(size_t)t * 32 + lane] : 0.f; ss = wave_sum(ss);
        const float sc = (1.0f / sqrtf(ss * (1.0f / DM) + EPS)) * XS8;
        const bf16* xs = X1B + (size_t)t * DM + 32 * lane; v4u o[2];
#pragma unroll
        for (int q = 0; q < 4; ++q) { const v4u a = *(const v4u*)(xs + 8 * q);
#pragma unroll
            for (int d = 0; d < 2; ++d) { const float f0 = fminf(fmaxf(bflo(a[2 * d]) * sc, -440.f), 440.f), f1 = fminf(fmaxf(bfhi(a[2 * d]) * sc, -440.f), 440.f), f2 = fminf(fmaxf(bflo(a[2 * d + 1]) * sc, -440.f), 440.f), f3 = fminf(fmaxf(bfhi(a[2 * d + 1]) * sc, -440.f), 440.f);
                int p = __builtin_amdgcn_cvt_pk_fp8_f32(f0, f1, 0, false); p = __builtin_amdgcn_cvt_pk_fp8_f32(f2, f3, p, true); o[q >> 1][2 * (q & 1) + d] = (unsigned)p; } }
        *(v4u*)(X8 + (size_t)t * DM + 32 * lane) = o[0]; *(v4u*)(X8 + (size_t)t * DM + 32 * lane + 16) = o[1];
    }
}

#ifndef MK_PER_PHASE
#define MK_PER_PHASE 0
#endif
constexpr int N_PHASES = 12;
struct Args { const float* in[18]; float* out; unsigned char* ws; int ph_lo, ph_hi; };
__global__ void __launch_bounds__(NWAVES * 64, 2) fwd_kernel(Args args) {
    extern __shared__ __attribute__((aligned(16))) unsigned char lds[];
    Frame F;
    F.lds = (LAS unsigned char*)lds;
    F.MISC = (volatile LAS unsigned*)(F.lds + MISC_OFF);
    F.wave = __builtin_amdgcn_readfirstlane((int)(threadIdx.x >> 6)); F.lane = (int)__builtin_amdgcn_mbcnt_hi(~0u, __builtin_amdgcn_mbcnt_lo(~0u, 0u)); F.tid = F.wave * 64 + F.lane;
    F.G = gridDim.x; { const int bx = blockIdx.x; F.vcu = (F.G % 8 == 0) ? (bx % 8) * (F.G / 8) + bx / 8 : bx; }
    F.ws = args.ws; F.ctl = (gu32*)(args.ws + WS_CTL); F.out = args.out;
    F.in = (const float* const*)__builtin_amdgcn_kernarg_segment_ptr();
    for (int u = F.tid; u < (LDS_BYTES - LDSCTL_OFF) / 4; u += NWAVES * 64) ((LAS unsigned*)(F.lds + LDSCTL_OFF))[u] = 0u;
    __syncthreads();
    XcdBarrier bar; bar.bar = (unsigned*)(F.ctl + CW_BAR); bar.x = 0; bar.st = nullptr; bar.w0 = F.wave == 0;
    if (!MK_PER_PHASE) bar = xcd_barrier_post((unsigned*)(F.ctl + CW_BAR), F.MISC + 8, F.wave);
    const int lo = args.ph_lo, hi = args.ph_hi;
#define IN(k) (lo <= (k) && (k) < hi)
    char* gl = (char*)lds + RING_OFF;
#define REFRESH() do { int l_ = (int)__builtin_amdgcn_mbcnt_hi(~0u, __builtin_amdgcn_mbcnt_lo(~0u, 0u)); asm volatile("" : "+v"(l_)); F.lane = l_; F.tid = F.wave * 64 + l_; } while (0)
#define PH0 if (IN(0)) { p0_prep(F); }
#define PH1 if (IN(1)) { \
          \
        { pg8::Gemm g{(const bf16*)(F.ws + WS_XB), (const bf16*)(F.ws + WS_WINB), T, NSENS, DM}; pg8::StaticOrder S; S.init(T, NSENS, F.G, (int)blockIdx.x); \
          pg8::EpiProj E{(bf16*)(F.ws + WS_QA), SEG_STRIDE / 2, (bf16*)(F.ws + WS_GATES), (const float*)(F.ws + WS_RSTD1), 1.0f, 0.125f * LOG2E, 0, (unsigned*)(F.ctl + CW_KMAX)}; \
          pg8::gemm_phase<pg8::EpiProj, pg8::StaticOrder, true, true, false>(F.lds + RING_OFF, g, S, E, F.wave); } \
        REFRESH(); \
        if (F.vcu & 1) p1_ifgates(F); \
        { pg8::Gemm g{(const bf16*)F.out, (const bf16*)(F.ws + WS_WIN), T, NPROJ - NSENS, DM / 2}; pg8::StaticOrder S; S.init(T, NPROJ - NSENS, F.G, (int)blockIdx.x); \
          pg8::EpiProj E{(bf16*)(F.ws + WS_QA), SEG_STRIDE / 2, (bf16*)(F.ws + WS_GATES), nullptr, 1.0f / WIN_SCALE, 0.125f * LOG2E, NSENS / 256, nullptr}; \
          pg8::gemm_phase<pg8::EpiProj, pg8::StaticOrder, true, true, true>(F.lds + RING_OFF, g, S, E, F.wave); } \
        REFRESH(); if (!(F.vcu & 1)) p1_wprep(F); \
        }
  \
#define PH2
#define CONV_PUBLISH() do { asm volatile("s_waitcnt vmcnt(0)" ::: "memory"); __syncthreads(); \
        if (F.tid == 0) { __builtin_amdgcn_fence(__ATOMIC_RELEASE, "agent"); asm volatile("s_waitcnt vmcnt(0)" ::: "memory"); \
            __hip_atomic_fetch_add((unsigned*)(F.ctl + CW_CONVCNT), 1u, __ATOMIC_RELAXED, __HIP_MEMORY_SCOPE_AGENT); } \
        __syncthreads(); } while (0)
#define CONV_WAIT() do { if (F.tid == 0) { unsigned sp_ = 0; while (__hip_atomic_load((unsigned*)(F.ctl + CW_CONVCNT), __ATOMIC_RELAXED, __HIP_MEMORY_SCOPE_AGENT) < (unsigned)CONV_WGS) { __builtin_amdgcn_s_sleep(2); if (++sp_ > (1u << 22)) break; } \
            __builtin_amdgcn_fence(__ATOMIC_ACQUIRE, "agent"); asm volatile("s_waitcnt vmcnt(0)" ::: "memory"); } \
        __syncthreads(); } while (0)
#define PH3(BA_, BB_, QI_) if (IN(3)) { const int v = F.vcu; \
        if (v < CONV_WGS) { p2_conv_scan(F, v, CONV_WGS); CONV_PUBLISH(); CONV_WAIT(); REFRESH(); mlstm_seg_task(F, gl, v >> 2, (2 * v) & 7); REFRESH(); mlstm_seg_task(F, gl, v >> 2, (2 * v + 1) & 7); } \
          \
        _Pragma("unroll 1") for (; (QI_) != 2;) { \
            if (F.tid == 0) F.MISC[16] = __hip_atomic_fetch_add((unsigned*)(F.ctl + CW_QUEUE + 64 * (QI_)), 1u, __ATOMIC_RELAXED, __HIP_MEMORY_SCOPE_AGENT); \
            __syncthreads(); const int q = (int)F.MISC[16]; __syncthreads(); \
            if (q >= 1024) break; \
            REFRESH(); \
            { const int u = 63 - (q >> 4), rem = q & 15; attn_unit(F, gl, rem & 1, 7 - (rem >> 1), u, BA_); } } \
        CONV_WAIT(); REFRESH(); \
        if (v < 256) { const int bh = v >> 4, sj = (v >> 1) & 7, pr = v & 1; mlstm_unit(F, gl, bh, sj, pr, BB_); mlstm_unit(F, gl, bh, sj, 3 - pr, BB_); } }
#define PH4 if (IN(4)) { \
        { pg8::Gemm g{(const bf16*)(F.ws + WS_AB), (const bf16*)(F.ws + WS_WA), T, DM, 2048}; pg8::StaticOrder S; S.init(T, DM, F.G, (int)blockIdx.x); \
          pg8::EpiGate2 E{(bf16*)(F.ws + WS_MERGED), (const bf16*)(F.ws + WS_GATES)}; \
          pg8::gemm_phase<pg8::EpiGate2, pg8::StaticOrder, true, true, false, 16>(F.lds + RING_OFF, g, S, E, F.wave); } }
#define PH5 if (IN(5)) { \
          \
        if (F.vcu & 1) { p5_expert_cvt(F); __syncthreads(); } \
        { pg8::Gemm g{(const bf16*)(F.ws + WS_MERGED), (const bf16*)(F.ws + WS_WOUT), T, DM, DM}; pg8::StaticOrder S; S.init(T, DM, F.G, (int)blockIdx.x); \
          pg8::EpiRes E{(const bf16*)(F.ws + WS_XB), (bf16*)(F.ws + WS_X1B), (float*)(F.ws + WS_SSQ)}; \
          pg8::gemm_phase<pg8::EpiRes, pg8::StaticOrder, true, true>(F.lds + RING_OFF, g, S, E, F.wave); } \
        REFRESH(); if (!(F.vcu & 1)) p5_expert_cvt(F); }
#define PH6 if (IN(6)) { \
        pg8::Gemm g{(const bf16*)(F.ws + WS_X1B), (const bf16*)(F.ws + WS_WQ), T, DM, DM}; pg8::StaticOrder S; S.init(T, DM, F.G, (int)blockIdx.x); \
          \
        { float* R2 = (float*)(F.ws + WS_RSTD2); const float* SSQ = (const float*)(F.ws + WS_SSQ); pg8::Unit uu; \
          for (int i = 0; S.next(i, uu); ++i) if (F.tid < 256) { const int row = uu.pm * 256 + F.tid; const f32x4* sp = (const f32x4*)(SSQ + (size_t)row * 32); float s = 0.f; \
              _Pragma("unroll") for (int q = 0; q < 8; ++q) { const f32x4 t = sp[q]; s += (t[0] + t[1]) + (t[2] + t[3]); } \
              R2[row] = 1.0f / sqrtf(s * (1.0f / 2048.0f) + EPS); } \
          asm volatile("s_waitcnt vmcnt(0)" ::: "memory"); __syncthreads(); } \
        pg8::EpiQ E{(bf16*)(F.ws + WS_QP), (const float*)(F.ws + WS_RSTD2)}; \
        pg8::gemm_phase<pg8::EpiQ, pg8::StaticOrder, true, true>(F.lds + RING_OFF, g, S, E, F.wave); }
#define PH7 if (IN(7)) { const int gw = F.vcu * NWAVES + F.wave, NGW = F.G * NWAVES; \
        for (int it = gw; it < (T / 32) * NH; it += NGW) route_unit(F, gl, (it >> 3) * 32, it & 7); \
        p7_xquant(F); }
#define PH8 if (IN(8)) { REFRESH(); peer_udots(F); }
#define PH9 if (IN(9)) { peer_act(F); }
#define PH10 if (IN(10)) { REFRESH(); peer_vacc(F); }
#define PH11 if (IN(11)) { peer_final(F); }
#define SEAM(k) do { if (IN(k) && IN((k) + 1)) xcd_barrier(bar); } while (0)
#define BAR_ALWAYS() xcd_barrier(bar)
#ifndef DUP
#define DUP -1
#endif
#ifdef ONLY_PH1
    PH1
#else
    PH0 SEAM(0);
#if DUP == 0
    PH0 BAR_ALWAYS();
#endif
    PH1 SEAM(1);
#if DUP == 1
    PH1 BAR_ALWAYS();
#endif
    PH2
#if DUP == 2
    PH2 BAR_ALWAYS();
#endif
#if DUP == 3
    PH3((bf16*)(F.ws + WS_MQ), (bf16*)(F.ws + WS_MK), 1) BAR_ALWAYS();
#endif
#if DUP == 31
    PH3((bf16*)(F.ws + WS_MQ), (bf16*)(F.ws + WS_MK), 2) BAR_ALWAYS();
#endif
    PH3((bf16*)(F.ws + WS_AB), (bf16*)(F.ws + WS_AB) + 1024, 0) SEAM(3);
    PH4 SEAM(4);
#if DUP == 4
    PH4 BAR_ALWAYS();
#endif
    PH5 SEAM(5);
#if DUP == 5
    PH5 BAR_ALWAYS();
#endif
    PH6 SEAM(6);
#if DUP == 6
    PH6 BAR_ALWAYS();
#endif
    PH7 SEAM(7);
#if DUP == 7
    PH7 BAR_ALWAYS();
#endif
    PH8 SEAM(8);
#if DUP == 8
    PH8 BAR_ALWAYS();
#endif
    PH9 SEAM(9);
#if DUP == 9
    PH9 BAR_ALWAYS();
#endif
#if DUP == 10
    PH10 BAR_ALWAYS();
#endif
    PH10 SEAM(10);
    PH11
#if DUP == 11
    BAR_ALWAYS(); PH11
#endif
#endif
#undef IN
#undef SEAM
}

extern "C" void kernel_launch(void* const* d_in, const int* in_sizes, int n_in, void* d_out, int out_size, void* d_ws, size_t ws_size, hipStream_t stream) {
    static int grid = 0;
    if (grid == 0) {
        if (n_in != 18 || in_sizes[0] != T * DM || out_size != T * DM || ws_size < WS_END) { fprintf(stderr, "kernel_launch: unexpected shapes: n_in %d in0 %d out %d ws %zu (need %zu)\n", n_in, n_in > 0 ? in_sizes[0] : -1, out_size, ws_size, (size_t)WS_END); grid = -1; return; }
        int dev = 0, cus = 0, per_cu = 0;
        if (hipGetDevice(&dev) != hipSuccess || hipDeviceGetAttribute(&cus, hipDeviceAttributeMultiprocessorCount, dev) != hipSuccess) { grid = -1; return; }
        if (hipFuncSetAttribute((const void*)fwd_kernel, hipFuncAttributeMaxDynamicSharedMemorySize, LDS_BYTES) != hipSuccess) { fprintf(stderr, "kernel_launch: hipFuncSetAttribute failed\n"); grid = -1; return; }
        if (hipOccupancyMaxActiveBlocksPerMultiprocessor(&per_cu, (const void*)fwd_kernel, NWAVES * 64, LDS_BYTES) != hipSuccess || per_cu < 1) { fprintf(stderr, "kernel_launch: occupancy query says %d\n", per_cu); per_cu = 1; }
        (void)hipGetLastError();
        grid = cus;
    }
    if (grid < 0) return;
    (void)hipMemsetAsync((char*)d_ws + WS_CTL, 0, CTL_ZERO_BYTES, stream);
    Args a{};
    for (int i = 0; i < 18; ++i) a.in[i] = (const float*)d_in[i];
    a.out = (float*)d_out; a.ws = (unsigned char*)d_ws;
#if MK_PER_PHASE
    for (int p = 0; p < N_PHASES; ++p) { a.ph_lo = p; a.ph_hi = p + 1; hipLaunchKernelGGL(fwd_kernel, dim3(grid), dim3(NWAVES * 64), LDS_BYTES, stream, a); }
#else
    a.ph_lo = 0; a.ph_hi = N_PHASES;
    hipLaunchKernelGGL(fwd_kernel, dim3(grid), dim3(NWAVES * 64), LDS_BYTES, stream, a);
#endif
    const hipError_t le = hipPeekAtLastError();
    if (le != hipSuccess) fprintf(stderr, "kernel_launch: launch failed: %s\n", hipGetErrorName(le));
}
```
